# Optimizing an MI355X kernel written in HIP

```python
import jax
import jax.numpy as jnp
from jax import lax
import numpy as np

D_MODEL = 2048
BATCH = 8
SEQ = 2048
DEPTH = 1

CTX_LEN = 256
GRID_W = 64
NORM_EPS = 1e-6
N_DIR = 2
N_BRANCH = 2
HG_WIDTH = 1024
HG_HEAD_DIM = 128
HG_HEADS = HG_WIDTH // HG_HEAD_DIM
HG_CHUNK = 64
RW_WIDTH = 1024
RW_HEAD_DIM = 64
RW_HEADS = RW_WIDTH // RW_HEAD_DIM
RW_DECAY_LORA = 64
RW_A_LORA = 64
RW_GN_EPS = 64e-5
HG_COLS = 5 * HG_WIDTH
RW_SHIFT_COLS = 3 * RW_WIDTH + N_DIR * (RW_DECAY_LORA + RW_A_LORA)
RW_COLS = RW_SHIFT_COLS + RW_WIDTH
GATE_COLS = N_BRANCH * D_MODEL
N_COLS = HG_COLS + RW_COLS + GATE_COLS

kernel_name = "hybrid_hgrn2_rwkv7_prefix_block"


def rmsnorm(x, g):
    x32 = x.astype(jnp.float32)
    return x32 * lax.rsqrt(jnp.mean(x32 * x32, axis=-1, keepdims=True) + NORM_EPS) * g


def ada_modulation(cond, w, b):
    mod = jax.nn.silu(cond.astype(jnp.float32)) @ w + b
    shift, scale, gate = jnp.split(mod, 3, axis=-1)
    return shift[:, None], scale[:, None], gate[:, None]


def grid_shift(p, mu, rows, cols, vertical):
    b, t, ch = p.shape
    p4 = p.reshape(b, rows, cols, ch)
    zc = jnp.zeros_like(p4[:, :, :1])
    left = jnp.concatenate([zc, p4[:, :, :-1]], axis=2)
    right = jnp.concatenate([p4[:, :, 1:], zc], axis=2)
    out = p4 + mu[0] * (left - p4) + mu[1] * (right - p4)
    if vertical:
        zr = jnp.zeros_like(p4[:, :1])
        up = jnp.concatenate([zr, p4[:, :-1]], axis=1)
        down = jnp.concatenate([p4[:, 1:], zr], axis=1)
        out = out + mu[2] * (up - p4) + mu[3] * (down - p4)
    return out.reshape(b, t, ch)


def hgrn2_chunk_scan(q, k, v, g, s0):
    b, t, h, _ = q.shape
    dv = v.shape[-1]
    n = t // HG_CHUNK

    def to_chunks(a):
        return a.reshape(b, n, HG_CHUNK, h, a.shape[-1]).transpose(1, 0, 3, 2, 4)

    tri = jnp.tril(jnp.ones((HG_CHUNK, HG_CHUNK), dtype=bool))

    def step(s, inp):
        qi, ki, vi, gi = inp
        bc = jnp.cumsum(gi, axis=2)
        diff = bc[:, :, :, None, :] - bc[:, :, None, :, :]
        decay = jnp.where(tri[:, :, None], jnp.exp(jnp.minimum(diff, 0.0)), 0.0)
        attn = jnp.einsum('bhtk,bhsk,bhtsk->bhts', qi, ki, decay)
        o = jnp.einsum('bhts,bhsv->bhtv', attn, vi) + jnp.einsum('bhtk,bhkv->bhtv', qi * jnp.exp(bc), s)
        blast = bc[:, :, -1:, :]
        s_new = jnp.exp(blast[:, :, 0, :])[..., None] * s + jnp.einsum('bhsk,bhsv->bhkv', ki * jnp.exp(blast - bc), vi)
        return s_new, o

    s_fin, oc = lax.scan(step, s0, (to_chunks(q), to_chunks(k), to_chunks(v), to_chunks(g)))
    return oc.transpose(1, 0, 3, 2, 4).reshape(b, t, h, dv), s_fin


def hgrn2_mixer(p, lb, norm_g, s0):
    b, t, _ = p.shape
    q_raw, i_in, f_fwd, f_bwd, z = jnp.split(p, 5, axis=-1)
    heads = lambda a: a.reshape(b, t, HG_HEADS, HG_HEAD_DIM)
    flip = lambda a: jnp.flip(a, axis=1)
    q = heads(jax.nn.silu(q_raw))
    v = heads(i_in)
    fg_f = lb[0] + (1.0 - lb[0]) * jax.nn.sigmoid(f_fwd)
    fg_b = lb[1] + (1.0 - lb[1]) * jax.nn.sigmoid(f_bwd)
    o_f, s_f = hgrn2_chunk_scan(q, heads(1.0 - fg_f), v, heads(jnp.log(fg_f)), s0[0])
    o_b, s_b = hgrn2_chunk_scan(flip(q), flip(heads(1.0 - fg_b)), flip(v), flip(heads(jnp.log(fg_b))), s0[1])
    o = o_f + flip(o_b)
    o = o * lax.rsqrt(jnp.mean(o * o, axis=-1, keepdims=True) + NORM_EPS)
    out = o.reshape(b, t, HG_WIDTH) * norm_g * jax.nn.silu(z)
    return out, jnp.stack([s_f, s_b])


def rwkv7_scan(r, w, kk, kb, v, k, s0, reverse):
    tm = lambda a: jnp.moveaxis(a, 1, 0)

    def step(s, inp):
        r_t, w_t, kk_t, b_t, v_t, k_t = inp
        sa = jnp.einsum('bhvk,bhk->bhv', s, kk_t)
        s = s * w_t[:, :, None, :] - sa[..., None] * b_t[:, :, None, :] + v_t[..., None] * k_t[:, :, None, :]
        return s, jnp.einsum('bhvk,bhk->bhv', s, r_t)

    s_fin, y = lax.scan(step, s0, (tm(r), tm(w), tm(kk), tm(kb), tm(v), tm(k)), reverse=reverse)
    return jnp.moveaxis(y, 0, 1), s_fin


def rwkv7_mixer(p, rw, s0, rows, cols, vertical):
    mu, w0, w2, a0, a2, k_k, k_a, r_k, gn_g, gn_b = rw
    b, t, _ = p.shape
    heads = lambda a: a.reshape(b, t, RW_HEADS, RW_HEAD_DIM)
    sh = grid_shift(p[..., :RW_SHIFT_COLS], mu, rows, cols, vertical)
    z = p[..., RW_SHIFT_COLS:]
    r = sh[..., :RW_WIDTH]
    k = sh[..., RW_WIDTH:2 * RW_WIDTH]
    v = sh[..., 2 * RW_WIDTH:3 * RW_WIDTH]
    lora = sh[..., 3 * RW_WIDTH:]
    w_lo = lora[..., :N_DIR * RW_DECAY_LORA].reshape(b, t, N_DIR, RW_DECAY_LORA)
    a_lo = lora[..., N_DIR * RW_DECAY_LORA:].reshape(b, t, N_DIR, RW_A_LORA)
    kk = heads(k * k_k)
    kk = kk * lax.rsqrt(jnp.sum(kk * kk, axis=-1, keepdims=True) + 1e-12)
    y_sum = 0.0
    k_sum = 0.0
    states = []
    for d in range(N_DIR):
        w_log = -jax.nn.softplus(-(w0[d] + jnp.tanh(w_lo[:, :, d]) @ w2[d])) - 0.5
        decay = jnp.exp(-jnp.exp(w_log))
        a = jax.nn.sigmoid(a0[d] + a_lo[:, :, d] @ a2[d])
        k_d = k * (1.0 + (a - 1.0) * k_a)
        y_d, s_d = rwkv7_scan(heads(r), heads(decay), kk, kk * heads(a), heads(v), heads(k_d), s0[d], d == 1)
        y_sum = y_sum + y_d
        k_sum = k_sum + k_d
        states.append(s_d)
    mean = jnp.mean(y_sum, axis=-1, keepdims=True)
    var = jnp.mean(jnp.square(y_sum - mean), axis=-1, keepdims=True)
    y = ((y_sum - mean) * lax.rsqrt(var + RW_GN_EPS)).reshape(b, t, RW_WIDTH) * gn_g + gn_b
    bonus = jnp.sum(heads(r * k_sum * r_k), axis=-1, keepdims=True) * heads(v)
    out = (y + bonus.reshape(b, t, RW_WIDTH)) * jax.nn.silu(z)
    return out, jnp.stack(states)


def mixer_stream(s, cond, ada_w, ada_b, norm_g, w_in, lb, hg_norm_g, rw, hg_s0, rw_s0, rows, cols, vertical):
    shift, scale, gate = ada_modulation(cond, ada_w, ada_b)
    h = rmsnorm(s, norm_g) * (1.0 + scale) + shift
    proj = h @ w_in
    y_hg, hg_s = hgrn2_mixer(proj[..., :HG_COLS], lb, hg_norm_g, hg_s0)
    y_rw, rw_s = rwkv7_mixer(proj[..., HG_COLS:HG_COLS + RW_COLS], rw, rw_s0, rows, cols, vertical)
    return y_hg, y_rw, proj[..., HG_COLS + RW_COLS:], gate, hg_s, rw_s


def merge_branches(gate_p, y_hg, y_rw, w_hg_o, w_rw_o, w_o):
    g_hg, g_rw = jnp.split(gate_p, N_BRANCH, axis=-1)
    merged = jax.nn.sigmoid(g_hg) * (y_hg @ w_hg_o) + jax.nn.sigmoid(g_rw) * (y_rw @ w_rw_o)
    return merged @ w_o


def setup_inputs(seed: int = 0) -> dict:
    key = jax.random.key(seed)
    ks = jax.random.split(key, 26)
    L, D = DEPTH, D_MODEL
    nrm = lambda k, shape, s: jax.random.normal(k, shape, jnp.float32) * s
    return {
        'x': nrm(ks[0], (BATCH, SEQ, D), 1.0),
        'c': nrm(ks[1], (BATCH, D), 1.0),
        'ctx': nrm(ks[2], (BATCH, CTX_LEN, D), 1.0),
        'c_ctx': nrm(ks[3], (D,), 1.0),
        'ada_w': nrm(ks[4], (L, D, 3 * D), 0.5 * D ** -0.5),
        'ada_b': nrm(ks[5], (L, 3 * D), 0.02),
        'norm_g': 1.0 + nrm(ks[6], (L, D), 0.02),
        'w_in': nrm(ks[7], (L, D, N_COLS), D ** -0.5),
        'hg_lb': nrm(ks[8], (N_DIR, L + 1, HG_WIDTH), 1.0),
        'hg_norm_g': 1.0 + nrm(ks[9], (L, HG_WIDTH), 0.02),
        'rw_mu': jax.random.uniform(ks[10], (L, 4, RW_SHIFT_COLS), jnp.float32, 0.0, 0.5),
        'rw_w0': jax.random.uniform(ks[11], (L, N_DIR, RW_WIDTH), jnp.float32, -5.0, 0.0),
        'rw_w2': nrm(ks[12], (L, N_DIR, RW_DECAY_LORA, RW_WIDTH), 0.5 * RW_DECAY_LORA ** -0.5),
        'rw_a0': nrm(ks[13], (L, N_DIR, RW_WIDTH), 0.1),
        'rw_a2': nrm(ks[14], (L, N_DIR, RW_A_LORA, RW_WIDTH), 0.5 * RW_A_LORA ** -0.5),
        'rw_kk': 0.85 + nrm(ks[15], (L, RW_WIDTH), 0.1),
        'rw_ka': 1.0 + nrm(ks[16], (L, RW_WIDTH), 0.1),
        'rw_rk': nrm(ks[17], (L, RW_WIDTH), 0.1),
        'rw_gn_g': 1.0 + nrm(ks[18], (L, RW_WIDTH), 0.02),
        'rw_gn_b': nrm(ks[19], (L, RW_WIDTH), 0.02),
        'w_hg_out': nrm(ks[20], (L, HG_WIDTH, D), HG_WIDTH ** -0.5),
        'w_rw_out': nrm(ks[21], (L, RW_WIDTH, D), RW_WIDTH ** -0.5),
        'w_out': nrm(ks[22], (L, D, D), D ** -0.5),
        'final_g': 1.0 + nrm(ks[23], (D,), 0.02),
    }


def reference(x, c, ctx, c_ctx, ada_w, ada_b, norm_g, w_in, hg_lb, hg_norm_g, rw_mu, rw_w0, rw_w2, rw_a0,
              rw_a2, rw_kk, rw_ka, rw_rk, rw_gn_g, rw_gn_b, w_hg_out, w_rw_out, w_out, final_g):
    out_dtype = x.dtype
    b, seq, _ = x.shape
    ctx_len = ctx.shape[1]
    rows = seq // GRID_W
    x = x.astype(jnp.float32)
    ctx = ctx.astype(jnp.float32)
    lb_all = jnp.cumsum(jax.nn.softmax(hg_lb.astype(jnp.float32), axis=1), axis=1)
    hg_zero = jnp.zeros((N_DIR, b, HG_HEADS, HG_HEAD_DIM, HG_HEAD_DIM), jnp.float32)
    rw_zero = jnp.zeros((N_DIR, b, RW_HEADS, RW_HEAD_DIM, RW_HEAD_DIM), jnp.float32)
    for l in range(DEPTH):
        lb = lb_all[:, l]
        rw = (rw_mu[l], rw_w0[l], rw_w2[l], rw_a0[l], rw_a2[l], rw_kk[l], rw_ka[l], rw_rk[l], rw_gn_g[l], rw_gn_b[l])
        yc_hg, yc_rw, gc, gate_c, hg_s, rw_s = mixer_stream(
            ctx, c_ctx[None], ada_w[l], ada_b[l], norm_g[l], w_in[l], lb, hg_norm_g[l], rw,
            hg_zero, rw_zero, 1, ctx_len, False)
        y_hg, y_rw, gl, gate_x, _, _ = mixer_stream(
            x, c, ada_w[l], ada_b[l], norm_g[l], w_in[l], lb, hg_norm_g[l], rw,
            hg_s, rw_s, rows, GRID_W, True)
        x = x + gate_x * merge_branches(gl, y_hg, y_rw, w_hg_out[l], w_rw_out[l], w_out[l])
        if l < DEPTH - 1:
            ctx = ctx + gate_c * merge_branches(gc, yc_hg, yc_rw, w_hg_out[l], w_rw_out[l], w_out[l])
    return rmsnorm(x, final_g).astype(out_dtype)
```

```cpp
#include <hip/hip_runtime.h>
#include <hip/hip_cooperative_groups.h>
#include <cstdio>
#include <cstdint>
namespace cg = cooperative_groups;
namespace pg8 {
#define PG8_LAS __attribute__((address_space(3)))
typedef unsigned short bf16_t;
typedef short bf16x8 __attribute__((ext_vector_type(8)));
typedef float f32x4 __attribute__((ext_vector_type(4)));
typedef unsigned u32x4 __attribute__((ext_vector_type(4)));
constexpr int BM = 256, BK = 64, HALF = 128, HTB = HALF * BK * 2  , STAGE_BYTES = 8 * HTB, NXCD = 8, WGM = 8;

__host__ __device__ __forceinline__ int lds_byte(int r, int c) { const int st = (r >> 4) * 2 + (c >> 5), rr = r & 15, cc = c & 31, ob = rr * 64 + cc * 2; return st * 1024 + (ob ^ (((ob >> 9) & 1) << 5)); }
__host__ __device__ __forceinline__ void stage_rc(int b, int& R, int& C) { const int st = b / 1024, sb = b % 1024, swz = sb ^ (((sb >> 9) & 1) << 5); R = (st >> 1) * 16 + swz / 64; C = (st & 1) * 32 + (swz % 64) / 2; }
__host__ __device__ __forceinline__ int perm32(int rho) { const int n = rho >> 4, i = rho & 15; return 8 * (i >> 2) + 4 * n + (i & 3); }

struct Unit { int pm, pn; };
struct Gemm { const bf16_t* A; const bf16_t* Bt; int M, N, K; };

struct StaticOrder {
    int nM, nN, nwg, G, c;
    __host__ __device__ void init(int M, int N, int G_, int c_) { nM = M / BM; nN = N / BM; nwg = nM * nN; G = G_; c = c_; }
    __host__ __device__ bool next(int i, Unit& u) const {
        const long L = (long)i * G + c; if (L >= nwg) return false;
        int wgid = (int)L; { const int q = nwg / NXCD, r = nwg % NXCD, xcd = wgid % NXCD, off = wgid / NXCD; wgid = (xcd < r ? xcd * (q + 1) : r * (q + 1) + (xcd - r) * q) + off; }
        const int nig = WGM * nN, gid = wgid / nig, fm = gid * WGM, gsz = (nM - fm) < WGM ? (nM - fm) : WGM;
        u.pm = fm + ((wgid % nig) % gsz); u.pn = (wgid % nig) / gsz; return true;
    }
    __device__ __forceinline__ void a_ready(const Unit&) const {}
    __device__ __forceinline__ void done(const Unit&) const {}
};
typedef float f32x2 __attribute__((ext_vector_type(2)));
typedef __bf16 bf16x2v __attribute__((ext_vector_type(2)));
__device__ __forceinline__ unsigned cvt_pk_bf16(float lo, float hi) { const f32x2 v = {lo, hi}; const bf16x2v b = __builtin_convertvector(v, bf16x2v); return __builtin_bit_cast(unsigned, b); }
template <class Epi, class Sched, bool ALIGN_EPI = false, bool SP2 = false>
__device__ __forceinline__ void gemm_phase(PG8_LAS unsigned char* lds, const Gemm g, const Sched& S, const Epi& E) {
    const int tid = threadIdx.x, wid = __builtin_amdgcn_readfirstlane(tid >> 6), lane = tid & 63, wr = wid >> 2, wc = wid & 3, fr = lane & 15, fq = lane >> 4;
    const int K = g.K, nt = K / BK;
    unsigned voffA[2], voffB[2];
#pragma unroll
    for (int i = 0; i < 2; ++i) { int R, C; stage_rc(tid * 16 + i * 8192, R, C); const int Rb = Epi::PERM ? ((R & ~31) + perm32(R & 31)) : R;
        voffA[i] = (unsigned)(R * K + C) * 2u; voffB[i] = (unsigned)(Rb * K + C) * 2u; }
    const size_t kstep = (size_t)(BK * 2);
    const size_t hstep = (size_t)HALF * K * 2;
    const size_t tstep = 2 * hstep;
    const unsigned ldsw = (unsigned)wid * 1024u;
    const int aoff = lds_byte(wr * 64 + fr, fq * 8), boff = lds_byte(wc * 32 + fr, fq * 8);
#define PG8_SA(b, h) (((b) * 2 + (h)) * HTB)
#define PG8_SB(b, h) ((4 + (b) * 2 + (h)) * HTB)
#define PG8_STAGE(bufoff, gbase, voff) do { _Pragma("unroll") for (int _i = 0; _i < 2; ++_i) \
        __builtin_amdgcn_global_load_lds((const unsigned*)((const char*)(gbase) + (voff)[_i]), (PG8_LAS unsigned*)(lds + (bufoff) + ldsw + _i * 8192), 16, 0, 0); } while (0)
#define PG8_LDA(dst, b, h) do { _Pragma("unroll") for (int m = 0; m < 4; ++m) _Pragma("unroll") for (int k = 0; k < 2; ++k) dst[m][k] = *(const PG8_LAS bf16x8*)(lds + PG8_SA(b, h) + aoff + m * 2048 + k * 1024); } while (0)
#define PG8_LDB(dst, b, h) do { _Pragma("unroll") for (int n = 0; n < 2; ++n) _Pragma("unroll") for (int k = 0; k < 2; ++k) dst[n][k] = *(const PG8_LAS bf16x8*)(lds + PG8_SB(b, h) + boff + n * 2048 + k * 1024); } while (0)
#define PG8_MMA(ai, bj, At, Bt) do { __builtin_amdgcn_s_setprio(1); _Pragma("unroll") for (int m = 0; m < 4; ++m) _Pragma("unroll") for (int n = 0; n < 2; ++n) _Pragma("unroll") for (int k = 0; k < 2; ++k) \
        acc[ai][bj][m][n] = __builtin_amdgcn_mfma_f32_16x16x32_bf16(Bt[n][k], At[m][k], acc[ai][bj][m][n], 0, 0, 0); __builtin_amdgcn_s_setprio(0); } while (0)
#define PG8_WAIT_V(n) asm volatile("s_waitcnt vmcnt(" #n ")" ::: "memory")
#define PG8_WAIT_L(n) asm volatile("s_waitcnt lgkmcnt(" #n ")" ::: "memory")
#define PG8_BAR __builtin_amdgcn_s_barrier()
#define PG8_SCHED __builtin_amdgcn_sched_barrier(0)
    Unit cur, nxt; int ui = 0;
    if (!S.next(0, cur)) return;
    f32x4 acc[2][2][4][2];
#pragma unroll
    for (int a = 0; a < 2; ++a)
#pragma unroll
        for (int b = 0; b < 2; ++b)
#pragma unroll
            for (int m = 0; m < 4; ++m)
#pragma unroll
                for (int n = 0; n < 2; ++n) acc[a][b][m][n] = (f32x4){0.f, 0.f, 0.f, 0.f};
    bf16x8 At[4][2], B0[2][2], B1[2][2];
    const char* cA = (const char*)g.A + (size_t)cur.pm * tstep; const char* cB = (const char*)g.Bt + (size_t)cur.pn * tstep;
    S.a_ready(cur);
    if constexpr (SP2) {
        PG8_STAGE(PG8_SB(0, 0), cB, voffB); PG8_STAGE(PG8_SB(0, 1), cB + hstep, voffB); PG8_STAGE(PG8_SA(0, 0), cA, voffA); PG8_STAGE(PG8_SA(0, 1), cA + hstep, voffA);
        if (wr == 1) PG8_BAR;
        PG8_WAIT_V(2); PG8_BAR;
        PG8_STAGE(PG8_SB(1, 0), cB + kstep, voffB); PG8_STAGE(PG8_SA(1, 0), cA + kstep, voffA); PG8_STAGE(PG8_SB(1, 1), cB + hstep + kstep, voffB);
        PG8_WAIT_V(6); PG8_BAR;
    } else {
        PG8_STAGE(PG8_SB(0, 0), cB, voffB); PG8_STAGE(PG8_SA(0, 0), cA, voffA); PG8_STAGE(PG8_SB(0, 1), cB + hstep, voffB); PG8_STAGE(PG8_SA(0, 1), cA + hstep, voffA);
        if (wr == 1) PG8_BAR;
        PG8_WAIT_V(4); PG8_BAR;
        PG8_STAGE(PG8_SB(1, 0), cB + kstep, voffB); PG8_STAGE(PG8_SA(1, 0), cA + kstep, voffA); PG8_STAGE(PG8_SB(1, 1), cB + hstep + kstep, voffB);
        PG8_WAIT_V(6); PG8_BAR;
    }
    for (;;) {
        const bool has_next = S.next(ui + 1, nxt);
        const char* nA = has_next ? (const char*)g.A + (size_t)nxt.pm * tstep : cA; const char* nB = has_next ? (const char*)g.Bt + (size_t)nxt.pn * tstep : cB;
        for (int t = 0; t < nt; t += 2) {
            const bool last = (t == nt - 2);
            const char* a1 = cA + (size_t)(t + 1) * kstep;
            const char* a2 = last ? nA : cA + (size_t)(t + 2) * kstep; const char* b2 = last ? nB : cB + (size_t)(t + 2) * kstep;
            const char* a3 = a2 + kstep; const char* b3 = b2 + kstep;
            if (last && has_next) S.a_ready(nxt);
            if constexpr (SP2) {
            PG8_LDB(B0, 0, 0); PG8_LDB(B1, 0, 1); PG8_SCHED; PG8_LDA(At, 0, 0); PG8_STAGE(PG8_SA(1, 1), a1 + hstep, voffA);
            PG8_WAIT_V(8); PG8_WAIT_L(0); PG8_BAR; PG8_MMA(0, 0, At, B0); PG8_MMA(0, 1, At, B1); PG8_BAR; PG8_SCHED;
            PG8_LDA(At, 0, 1); PG8_STAGE(PG8_SB(0, 0), b2, voffB); PG8_STAGE(PG8_SB(0, 1), b2 + hstep, voffB); PG8_STAGE(PG8_SA(0, 0), a2, voffA);
            PG8_WAIT_V(8); PG8_WAIT_L(0); PG8_BAR; PG8_MMA(1, 0, At, B0); PG8_MMA(1, 1, At, B1); PG8_BAR; PG8_SCHED;
            PG8_LDB(B0, 1, 0); PG8_LDB(B1, 1, 1); PG8_SCHED; PG8_LDA(At, 1, 0); PG8_STAGE(PG8_SA(0, 1), a2 + hstep, voffA);
            PG8_WAIT_V(8); PG8_WAIT_L(0); PG8_BAR; PG8_MMA(0, 0, At, B0); PG8_MMA(0, 1, At, B1); PG8_BAR; PG8_SCHED;
            PG8_LDA(At, 1, 1); PG8_STAGE(PG8_SB(1, 0), b3, voffB); PG8_STAGE(PG8_SB(1, 1), b3 + hstep, voffB); PG8_STAGE(PG8_SA(1, 0), a3, voffA);
            PG8_WAIT_V(8); PG8_WAIT_L(0); PG8_BAR; PG8_MMA(1, 0, At, B0); PG8_MMA(1, 1, At, B1); PG8_BAR; PG8_SCHED;
            } else {
            PG8_LDB(B0, 0, 0); PG8_SCHED; PG8_LDA(At, 0, 0); PG8_STAGE(PG8_SA(1, 1), a1 + hstep, voffA);
            PG8_WAIT_L(8); PG8_BAR; PG8_WAIT_L(0); PG8_MMA(0, 0, At, B0); PG8_BAR; PG8_SCHED;
            PG8_LDB(B1, 0, 1); PG8_STAGE(PG8_SB(0, 0), b2, voffB);
            PG8_BAR; PG8_WAIT_L(0); PG8_MMA(0, 1, At, B1); PG8_BAR;
            PG8_LDA(At, 0, 1); PG8_STAGE(PG8_SA(0, 0), a2, voffA);
            PG8_BAR; PG8_WAIT_L(0); PG8_MMA(1, 0, At, B0); PG8_BAR; PG8_SCHED;
            PG8_STAGE(PG8_SB(0, 1), b2 + hstep, voffB);
            PG8_WAIT_V(6); PG8_BAR; PG8_MMA(1, 1, At, B1); PG8_BAR;
            PG8_LDB(B0, 1, 0); PG8_SCHED; PG8_LDA(At, 1, 0); PG8_STAGE(PG8_SA(0, 1), a2 + hstep, voffA);
            PG8_WAIT_L(8); PG8_BAR; PG8_WAIT_L(0); PG8_MMA(0, 0, At, B0); PG8_BAR; PG8_SCHED;
            PG8_LDB(B1, 1, 1); PG8_STAGE(PG8_SB(1, 0), b3, voffB);
            PG8_BAR; PG8_WAIT_L(0); PG8_MMA(0, 1, At, B1); PG8_BAR;
            PG8_LDA(At, 1, 1); PG8_STAGE(PG8_SA(1, 0), a3, voffA);
            PG8_BAR; PG8_WAIT_L(0); PG8_MMA(1, 0, At, B0); PG8_BAR; PG8_SCHED;
            PG8_STAGE(PG8_SB(1, 1), b3 + hstep, voffB);
            PG8_WAIT_V(6); PG8_BAR; PG8_MMA(1, 1, At, B1); PG8_BAR;
            }
        }
        if constexpr (ALIGN_EPI) { if (wr == 0) PG8_BAR; }
        bool keep_acc = false;
        if constexpr (Epi::CHAIN) { keep_acc = E.chain(acc, cur, wr, wc, fr, fq); S.done(cur); }
        else if constexpr (!Epi::AFTER_DRAIN) { E(acc, cur, wr, wc, fr, fq); S.done(cur); }
        if (!has_next) break;
        if (!keep_acc)
#pragma unroll
        for (int a = 0; a < 2; ++a)
#pragma unroll
            for (int b = 0; b < 2; ++b)
#pragma unroll
                for (int m = 0; m < 4; ++m)
#pragma unroll
                    for (int n = 0; n < 2; ++n) acc[a][b][m][n] = (f32x4){0.f, 0.f, 0.f, 0.f};
        cur = nxt; cA = nA; cB = nB; ++ui;
        if constexpr (ALIGN_EPI) { if (wr == 1) PG8_BAR; }
    }
    PG8_WAIT_V(0);
    if constexpr (!ALIGN_EPI) { if (wr == 0) PG8_BAR; }
    PG8_BAR;
    if constexpr (Epi::AFTER_DRAIN) { E.fused(acc, cur, wr, wc, fr, fq, lds, wid, lane); S.done(cur); }
#undef PG8_SA
#undef PG8_SB
#undef PG8_STAGE
#undef PG8_LDA
#undef PG8_LDB
#undef PG8_MMA
#undef PG8_WAIT_V
#undef PG8_WAIT_L
#undef PG8_BAR
#undef PG8_SCHED
}
}

namespace mk {
using pg8::bf16_t; using pg8::bf16x8; using pg8::f32x4; using pg8::u32x4; using pg8::Unit; using pg8::cvt_pk_bf16; using pg8::f32x2;
typedef unsigned u32x2 __attribute__((ext_vector_type(2)));
#define LAS __attribute__((address_space(3)))
#define LDS_WAIT() asm volatile("s_waitcnt lgkmcnt(0)" ::: "memory")

constexpr int D = 2048, NB = 8, SEQ = 2048, CTXL = 256;
constexpr int MLAT = NB * SEQ, MCTX = NB * CTXL, MTOT = MLAT + MCTX;
constexpr int NCOLS = 13568, SHC = 3328;
constexpr size_t MiB = (size_t)1 << 20;
constexpr size_t WS_MOD = 0, WS_LB = 256 * 1024, WS_W2T = 512 * 1024, WS_RN = 1 * MiB, WS_BONUS = 2 * MiB + 256 * 1024;
constexpr size_t WS_PQ = 4 * MiB, WS_PI = 40 * MiB, WS_PGF = 76 * MiB, WS_PGB = 112 * MiB, WS_PZ = 148 * MiB, WS_PRW = 184 * MiB, WS_PZRW = 301 * MiB;
constexpr size_t WS_E0 = 337 * MiB, WS_E1 = 373 * MiB, WS_A0 = 409 * MiB, WS_A1 = 445 * MiB;
constexpr size_t WS_WTO1 = 481 * MiB, WS_WTO2 = 489 * MiB;
constexpr size_t WS_YHG = 4 * MiB, WS_YRW = 36 * MiB, WS_H2 = 68 * MiB, WS_WTG = 132 * MiB;
constexpr size_t WS_PGATE = 337 * MiB;
constexpr size_t WS_T1 = 184 * MiB, WS_MERGED = 248 * MiB;
constexpr size_t WS_BAR = 500 * MiB;
constexpr size_t WS_END = 501 * MiB;
constexpr int YRW_PM_OFF = 64;
static_assert((WS_YRW - WS_YHG) == (size_t)YRW_PM_OFF * 256 * 1024 * 2, "y_hg / y_rw spacing");
constexpr int NC1 = 9472;
constexpr size_t DO_H = 0, DO_WTIN = 72 * MiB, DO_O = 0, DO_Y = 64 * MiB;
constexpr int LDS_BYTES = 147456, RW_LDS = 49152;

struct Params {
    const float *x, *c, *ctx, *c_ctx, *ada_w, *ada_b, *norm_g, *w_in, *hg_lb, *hg_norm_g, *rw_mu, *rw_w0, *rw_w2, *rw_a0, *rw_a2, *rw_kk, *rw_ka, *rw_rk, *rw_gn_g, *rw_gn_b,
        *w_hg_out, *w_rw_out, *w_out, *final_g;
    float* out; unsigned char* ws;
};

__device__ __forceinline__ float bflo(unsigned u) { return __uint_as_float(u << 16); }
__device__ __forceinline__ float bfhi(unsigned u) { return __uint_as_float(u & 0xffff0000u); }
__device__ __forceinline__ float bf2f(bf16_t u) { return __uint_as_float(((unsigned)u) << 16); }
__device__ __forceinline__ bf16_t f2bf(float f) { return (bf16_t)(cvt_pk_bf16(f, 0.f) & 0xffffu); }
__device__ __forceinline__ float sigm(float x) { return __builtin_amdgcn_rcpf(1.f + __expf(-x)); }
__device__ __forceinline__ float silu(float x) { return x * sigm(x); }
__device__ __forceinline__ float tanh_(float x) { return 1.f - 2.f * __builtin_amdgcn_rcpf(1.f + __expf(2.f * x)); }
__device__ __forceinline__ float wave_sum(float v) {
#pragma unroll
    for (int o = 1; o < 64; o <<= 1) v += __shfl_xor(v, o);
    return v;
}
template <int CTRL> __device__ __forceinline__ float dpp(float x) { return __int_as_float(__builtin_amdgcn_update_dpp(0, __float_as_int(x), CTRL, 0xf, 0xf, true)); }
__device__ __forceinline__ f32x4 mfma16(bf16x8 a, bf16x8 b, f32x4 c) { return __builtin_amdgcn_mfma_f32_16x16x32_bf16(a, b, c, 0, 0, 0); }

template <int W> __device__ __forceinline__ void ldbf(const bf16_t* p, float (&o)[W]) {
    if constexpr (W == 2) { const unsigned u = *(const unsigned*)p; o[0] = bflo(u); o[1] = bfhi(u); }
    else if constexpr (W == 4) { const u32x2 u = *(const u32x2*)p; o[0] = bflo(u.x); o[1] = bfhi(u.x); o[2] = bflo(u.y); o[3] = bfhi(u.y); }
    else {
#pragma unroll
        for (int i = 0; i < W / 8; ++i) { const u32x4 u = *(const u32x4*)(p + 8 * i);
            o[8 * i + 0] = bflo(u.x); o[8 * i + 1] = bfhi(u.x); o[8 * i + 2] = bflo(u.y); o[8 * i + 3] = bfhi(u.y);
            o[8 * i + 4] = bflo(u.z); o[8 * i + 5] = bfhi(u.z); o[8 * i + 6] = bflo(u.w); o[8 * i + 7] = bfhi(u.w); }
    }
}
template <int W> __device__ __forceinline__ void ldf(const float* p, float (&o)[W]) {
    if constexpr (W == 2) { const f32x2 u = *(const f32x2*)p; o[0] = u.x; o[1] = u.y; }
    else {
#pragma unroll
        for (int i = 0; i < W / 4; ++i) { const f32x4 u = *(const f32x4*)(p + 4 * i); o[4 * i] = u.x; o[4 * i + 1] = u.y; o[4 * i + 2] = u.z; o[4 * i + 3] = u.w; }
    }
}
template <int W> __device__ __forceinline__ void stbf(bf16_t* p, const float (&v)[W]) {
    if constexpr (W == 4) { u32x2 u; u.x = cvt_pk_bf16(v[0], v[1]); u.y = cvt_pk_bf16(v[2], v[3]); *(u32x2*)p = u; }
    else {
#pragma unroll
        for (int i = 0; i < W / 8; ++i) { u32x4 u; u.x = cvt_pk_bf16(v[8 * i], v[8 * i + 1]); u.y = cvt_pk_bf16(v[8 * i + 2], v[8 * i + 3]); u.z = cvt_pk_bf16(v[8 * i + 4], v[8 * i + 5]); u.w = cvt_pk_bf16(v[8 * i + 6], v[8 * i + 7]); *(u32x4*)(p + 8 * i) = u; }
    }
}

struct Nbr { int L, R, U, Dn; bool vert; };
__device__ __forceinline__ Nbr nbr_of(int R) {
    Nbr n;
    if (R < MLAT) { const int t = R & (SEQ - 1), col = t & 63; n.L = col > 0 ? R - 1 : -1; n.R = col < 63 ? R + 1 : -1; n.U = t >= 64 ? R - 64 : -1; n.Dn = t < SEQ - 64 ? R + 64 : -1; n.vert = true; }
    else { const int t = (R - MLAT) & (CTXL - 1); n.L = t > 0 ? R - 1 : -1; n.R = t < CTXL - 1 ? R + 1 : -1; n.U = -1; n.Dn = -1; n.vert = false; }
    return n;
}
template <int W> __device__ __forceinline__ void shifted(const bf16_t* Prw, int R, const Nbr& nb, int col, const float* mu, float (&o)[W]) {
    float p[W], t[W], m[W];
    ldbf<W>(Prw + (size_t)R * SHC + col, p);
#pragma unroll
    for (int i = 0; i < W; ++i) o[i] = p[i];
    ldf<W>(mu + col, m);
    if (nb.L >= 0) ldbf<W>(Prw + (size_t)nb.L * SHC + col, t); else {
#pragma unroll
        for (int i = 0; i < W; ++i) t[i] = 0.f; }
#pragma unroll
    for (int i = 0; i < W; ++i) o[i] += m[i] * (t[i] - p[i]);
    ldf<W>(mu + SHC + col, m);
    if (nb.R >= 0) ldbf<W>(Prw + (size_t)nb.R * SHC + col, t); else {
#pragma unroll
        for (int i = 0; i < W; ++i) t[i] = 0.f; }
#pragma unroll
    for (int i = 0; i < W; ++i) o[i] += m[i] * (t[i] - p[i]);
    if (nb.vert) {
        ldf<W>(mu + 2 * SHC + col, m);
        if (nb.U >= 0) ldbf<W>(Prw + (size_t)nb.U * SHC + col, t); else {
#pragma unroll
            for (int i = 0; i < W; ++i) t[i] = 0.f; }
#pragma unroll
        for (int i = 0; i < W; ++i) o[i] += m[i] * (t[i] - p[i]);
        ldf<W>(mu + 3 * SHC + col, m);
        if (nb.Dn >= 0) ldbf<W>(Prw + (size_t)nb.Dn * SHC + col, t); else {
#pragma unroll
            for (int i = 0; i < W; ++i) t[i] = 0.f; }
#pragma unroll
        for (int i = 0; i < W; ++i) o[i] += m[i] * (t[i] - p[i]);
    }
}

__device__ __forceinline__ void shifted4m(const bf16_t* Prw, int R, const Nbr& nb, int col, const f32x4 (&mu4)[4], float (&o)[4]) {
    float p[4], t[4];
    ldbf<4>(Prw + (size_t)R * SHC + col, p);
#pragma unroll
    for (int i = 0; i < 4; ++i) o[i] = p[i];
#pragma unroll
    for (int d = 0; d < 4; ++d) {
        if (d >= 2 && !nb.vert) break;
        const int nr = d == 0 ? nb.L : (d == 1 ? nb.R : (d == 2 ? nb.U : nb.Dn));
        if (nr >= 0) ldbf<4>(Prw + (size_t)nr * SHC + col, t); else {
#pragma unroll
            for (int i = 0; i < 4; ++i) t[i] = 0.f; }
#pragma unroll
        for (int i = 0; i < 4; ++i) o[i] += mu4[d][i] * (t[i] - p[i]);
    }
}

__device__ __forceinline__ void transpose_item(const float* W, int K, int ldw, int N, bf16_t* WT, LAS float* scr, int item, int lane) {
    const int nblk = N / 32, kb = item / nblk, nb = item % nblk, k0 = 64 * kb, n0 = 32 * nb;
#pragma unroll 8
    for (int i = 0; i < 32; ++i) { const int kk = 2 * i + (lane >> 5); scr[kk * 33 + (lane & 31)] = W[(size_t)(k0 + kk) * ldw + n0 + (lane & 31)]; }
    LDS_WAIT();
    const int c = lane & 7;
#pragma unroll
    for (int j = 0; j < 4; ++j) { const int n = (lane >> 3) + 8 * j; const LAS float* s = scr + (8 * c) * 33 + n;
        u32x4 o; o.x = cvt_pk_bf16(s[0 * 33], s[1 * 33]); o.y = cvt_pk_bf16(s[2 * 33], s[3 * 33]); o.z = cvt_pk_bf16(s[4 * 33], s[5 * 33]); o.w = cvt_pk_bf16(s[6 * 33], s[7 * 33]);
        *(u32x4*)(WT + (size_t)(n0 + n) * K + k0 + 8 * c) = o; }
    LDS_WAIT();
}

__device__ __forceinline__ void phase0(const Params& p, LAS unsigned char* lds, int tid, int wave, int lane) {
    float* mod = (float*)(p.ws + WS_MOD);
    LAS float* sc = (LAS float*)lds;
    for (int i = tid; i < 9 * D; i += 512) { const int r = i >> 11, k = i & (D - 1); const float v = r < 8 ? p.c[r * D + k] : p.c_ctx[k]; sc[i] = silu(v); }
    __syncthreads();
    for (int cb = blockIdx.x; cb < 256; cb += gridDim.x) {
        if (wave < 6) {
            const int n0 = cb * 24 + wave * 4;
            float acc[9][4];
#pragma unroll
            for (int r = 0; r < 9; ++r)
#pragma unroll
                for (int j = 0; j < 4; ++j) acc[r][j] = 0.f;
            for (int i = 0; i < 32; ++i) { const int k = lane + 64 * i; const f32x4 w = *(const f32x4*)(p.ada_w + (size_t)k * (3 * D) + n0);
#pragma unroll
                for (int r = 0; r < 9; ++r) { const float s = sc[r * D + k]; acc[r][0] += s * w.x; acc[r][1] += s * w.y; acc[r][2] += s * w.z; acc[r][3] += s * w.w; } }
#pragma unroll
            for (int r = 0; r < 9; ++r)
#pragma unroll
                for (int j = 0; j < 4; ++j) { const float v = wave_sum(acc[r][j]); if (lane == 0) mod[r * (3 * D) + n0 + j] = v + p.ada_b[n0 + j]; }
        }
    }
    __syncthreads();
    LAS float* scr = (LAS float*)(lds + wave * 8448);
    const int gw = blockIdx.x * 8 + wave, NGW = gridDim.x * 8;
    bf16_t* wt_in = (bf16_t*)((unsigned char*)p.out + DO_WTIN);
    constexpr int I_IN = (D / 64) * (NC1 / 32);
    for (int it = gw; it < I_IN; it += NGW) transpose_item(p.w_in, D, NCOLS, NC1, wt_in, scr, it, lane);
    bf16_t* w2t = (bf16_t*)(p.ws + WS_W2T);
    const int gt = blockIdx.x * 512 + tid, NGT = gridDim.x * 512;
    for (int i = gt; i < 4 * 1024 * 8; i += NGT) { const int mat = i >> 13, n = (i >> 3) & 1023, k8 = i & 7;
        const float* src = (mat < 2 ? p.rw_w2 + (size_t)mat * 64 * 1024 : p.rw_a2 + (size_t)(mat - 2) * 64 * 1024) + n;
        float v[8];
#pragma unroll
        for (int j = 0; j < 8; ++j) v[j] = src[(size_t)(k8 * 8 + j) * 1024];
        stbf<8>(w2t + ((size_t)mat * 1024 + n) * 64 + k8 * 8, v); }
    float* lb = (float*)(p.ws + WS_LB);
    for (int i = gt; i < 2048; i += NGT) { const int d = i >> 10, j = i & 1023; const float a = p.hg_lb[(d * 2 + 0) * 1024 + j], b = p.hg_lb[(d * 2 + 1) * 1024 + j]; lb[i] = 1.f / (1.f + __expf(b - a)); }
}

__device__ __forceinline__ void phase1(const Params& p, bf16_t* H, int nrows, int wave, int lane) {
    const float* mod = (const float*)(p.ws + WS_MOD);
    const int gw = blockIdx.x * 8 + wave, NGW = gridDim.x * 8;
    for (int row = gw; row < nrows; row += NGW) {
        const float* xr = row < MLAT ? p.x + (size_t)row * D : p.ctx + (size_t)(row - MLAT) * D;
        const int mr = row < MLAT ? (row >> 11) : 8;
        const float* shift = mod + mr * (3 * D); const float* scale = shift + D;
        f32x4 v[8]; float ss = 0.f;
#pragma unroll
        for (int j = 0; j < 8; ++j) { v[j] = __builtin_nontemporal_load(&((const f32x4*)xr)[lane + 64 * j]); ss += (v[j].x * v[j].x + v[j].y * v[j].y) + (v[j].z * v[j].z + v[j].w * v[j].w); }
        ss = wave_sum(ss);
        const float rstd = rsqrtf(ss * (1.f / D) + 1e-6f);
#pragma unroll
        for (int j = 0; j < 8; ++j) { const int c = 4 * (lane + 64 * j);
            const f32x4 g = *(const f32x4*)(p.norm_g + c), s1 = *(const f32x4*)(scale + c), s0 = *(const f32x4*)(shift + c);
            float o[4]; o[0] = v[j].x * rstd * g.x * (1.f + s1.x) + s0.x; o[1] = v[j].y * rstd * g.y * (1.f + s1.y) + s0.y; o[2] = v[j].z * rstd * g.z * (1.f + s1.z) + s0.z; o[3] = v[j].w * rstd * g.w * (1.f + s1.w) + s0.w;
            stbf<4>(H + (size_t)row * D + c, o); }
    }
}

struct EpiProj {
    static constexpr bool PERM = true, AFTER_DRAIN = false, CHAIN = false;
    unsigned char* ws;
    template <int ACT> __device__ __forceinline__ void run(const f32x4 (&acc)[2][2][4][2], bf16_t* base, int ld, int row0, int col0, const float* lb) const {
        float lbv[2][8];
        if constexpr (ACT == 3) {
#pragma unroll
            for (int bj = 0; bj < 2; ++bj) ldf<8>(lb + col0 + bj * 128, lbv[bj]); }
#pragma unroll
        for (int ai = 0; ai < 2; ++ai)
#pragma unroll
            for (int m = 0; m < 4; ++m) { bf16_t* rowp = base + (size_t)(row0 + ai * 128 + m * 16) * ld + col0;
#pragma unroll
                for (int bj = 0; bj < 2; ++bj) { float v[8];
#pragma unroll
                    for (int i = 0; i < 4; ++i) { v[i] = acc[ai][bj][m][0][i]; v[4 + i] = acc[ai][bj][m][1][i]; }
#pragma unroll
                    for (int i = 0; i < 8; ++i) {
                        if constexpr (ACT == 1) v[i] = silu(v[i]);
                        if constexpr (ACT == 2) v[i] = sigm(v[i]);
                        if constexpr (ACT == 3) v[i] = __logf(lbv[bj][i] + (1.f - lbv[bj][i]) * sigm(v[i])); }
                    stbf<8>(rowp + bj * 128, v); } }
    }
    __device__ __forceinline__ void operator()(const f32x4 (&acc)[2][2][4][2], const Unit& u, int wr, int wc, int fr, int fq) const {
        const int pn = u.pn; const int row0 = u.pm * 256 + wr * 64 + fr, cw = wc * 32 + 8 * fq;
        const float* lb = (const float*)(ws + WS_LB);
        if (pn < 4) run<1>(acc, (bf16_t*)(ws + WS_PQ), 1024, row0, pn * 256 + cw, lb);
        else if (pn < 8) run<0>(acc, (bf16_t*)(ws + WS_PI), 1024, row0, (pn - 4) * 256 + cw, lb);
        else if (pn < 12) run<3>(acc, (bf16_t*)(ws + WS_PGF), 1024, row0, (pn - 8) * 256 + cw, lb);
        else if (pn < 16) run<3>(acc, (bf16_t*)(ws + WS_PGB), 1024, row0, (pn - 12) * 256 + cw, lb + 1024);
        else if (pn < 20) run<1>(acc, (bf16_t*)(ws + WS_PZ), 1024, row0, (pn - 16) * 256 + cw, lb);
        else if (pn < 33) run<0>(acc, (bf16_t*)(ws + WS_PRW), SHC, row0, (pn - 20) * 256 + cw, lb);
        else run<1>(acc, (bf16_t*)(ws + WS_PZRW), 1024, row0, (pn - 33) * 256 + cw, lb);
    }
};

struct InOrder {
    int G, c;
    __device__ bool next(int i, Unit& u) const {
        const int L = i * G + c;
        if (L < 2368) { pg8::StaticOrder so; so.init(MLAT, NC1, G, c); return so.next(i, u); }
        if (L >= 2368 + 168) return false;
        const int idx = L - 2368, j = idx % 21; u.pm = 64 + idx / 21; u.pn = j < 12 ? 4 + j : 12 + j; return true;
    }
    __device__ __forceinline__ void a_ready(const Unit&) const {}
    __device__ __forceinline__ void done(const Unit&) const {}
};
struct EpiGate {
    static constexpr bool PERM = true, AFTER_DRAIN = false, CHAIN = false;
    unsigned char* ws;
    __device__ __forceinline__ void operator()(const f32x4 (&acc)[2][2][4][2], const Unit& u, int wr, int wc, int fr, int fq) const {
        EpiProj e{ws};
        e.run<2>(acc, (bf16_t*)(ws + WS_PGATE), 4096, u.pm * 256 + wr * 64 + fr, u.pn * 256 + wc * 32 + 8 * fq, nullptr);
    }
};

__device__ __forceinline__ void hg_scan(const Params& p, LAS unsigned char* lds, int tid, int wave, int lane) {
    LAS bf16_t* qd = (LAS bf16_t*)(lds);
    LAS bf16_t* kd = (LAS bf16_t*)(lds + 17408);
    LAS bf16_t* kdT = (LAS bf16_t*)(lds + 34816);
    LAS bf16_t* vT = (LAS bf16_t*)(lds + 53248);
    LAS bf16_t* ST = (LAS bf16_t*)(lds + 62464);
    LAS bf16_t* at = (LAS bf16_t*)(lds + 79872);
    LAS float* tot = (LAS float*)(lds + 89088);
    const bf16_t* Pq = (const bf16_t*)(p.ws + WS_PQ); const bf16_t* Pi = (const bf16_t*)(p.ws + WS_PI);
    bf16_t* Obase = (bf16_t*)((unsigned char*)p.out + DO_O);
    const int l15 = lane & 15, fq = lane >> 4;
    for (int u = blockIdx.x; u < 256; u += gridDim.x) {
        const int b = u >> 5, h = (u >> 2) & 7, dir = (u >> 1) & 1, vh = u & 1;
        const bf16_t* Pg = (const bf16_t*)(p.ws + (dir ? WS_PGB : WS_PGF));
        bf16_t* O = Obase + (size_t)dir * MLAT * 1024;
        const int k0 = 2 * lane, e8 = wave, vs = tid >> 3, vn8 = tid & 7;
        const int sgn = dir ? -1 : 1;
        auto rbase = [&](int c) -> long { if (c < 4) return MLAT + b * CTXL + (dir ? (CTXL - 1 - c * 64) : c * 64); const int t0 = (c - 4) * 64; return b * SEQ + (dir ? (SEQ - 1 - t0) : t0); };
        const long rstep = (long)sgn * 1024;
        f32x4 S[4];
#pragma unroll
        for (int i = 0; i < 4; ++i) S[i] = (f32x4){0.f, 0.f, 0.f, 0.f};
        unsigned gN[8], qN[8]; u32x4 vN;
        { const long rb = rbase(0); const bf16_t* gp = Pg + (rb + sgn * (e8 * 8)) * 1024 + h * 128 + k0; const bf16_t* qp_ = Pq + (rb + sgn * (e8 * 8)) * 1024 + h * 128 + k0;
#pragma unroll
          for (int j = 0; j < 8; ++j) { gN[j] = *(const unsigned*)(gp + j * rstep); qN[j] = *(const unsigned*)(qp_ + j * rstep); }
          vN = *(const u32x4*)(Pi + (rb + sgn * vs) * 1024 + h * 128 + vh * 64 + vn8 * 8); }
        for (int c = 0; c < 36; ++c) {
            unsigned g[8], q[8]; const u32x4 vC = vN;
#pragma unroll
            for (int j = 0; j < 8; ++j) { g[j] = gN[j]; q[j] = qN[j]; }
            if (c + 1 < 36) {
                const long rb1 = rbase(c + 1); const bf16_t* gp = Pg + (rb1 + sgn * (e8 * 8)) * 1024 + h * 128 + k0; const bf16_t* qp_ = Pq + (rb1 + sgn * (e8 * 8)) * 1024 + h * 128 + k0;
#pragma unroll
                for (int j = 0; j < 8; ++j) { gN[j] = *(const unsigned*)(gp + j * rstep); qN[j] = *(const unsigned*)(qp_ + j * rstep); }
                vN = *(const u32x4*)(Pi + (rb1 + sgn * vs) * 1024 + h * 128 + vh * 64 + vn8 * 8);
            }
            float run0 = 0.f, run1 = 0.f;
#pragma unroll
            for (int j = 0; j < 8; ++j) { run0 += bflo(g[j]); run1 += bfhi(g[j]); }
            *(LAS f32x2*)(tot + e8 * 128 + k0) = (f32x2){run0, run1};
            __syncthreads();
            {
                float off0 = 0.f, off1 = 0.f, mid0 = 0.f, mid1 = 0.f;
#pragma unroll
                for (int i = 0; i < 8; ++i) { const f32x2 t = *(const LAS f32x2*)(tot + i * 128 + k0); if (i < e8) { off0 += t.x; off1 += t.y; } if (i < 4) { mid0 += t.x; mid1 += t.y; } }
                unsigned kp0[4], kp1[4]; float bc0 = off0, bc1 = off1;
#pragma unroll
                for (int j = 0; j < 8; j += 2) {
                    float kv0[2], kv1[2];
#pragma unroll
                    for (int e = 0; e < 2; ++e) { const int jj = j + e;
                        bc0 += bflo(g[jj]); bc1 += bfhi(g[jj]);
                        const float E0 = __expf(__builtin_amdgcn_fmed3f(bc0 - mid0, -80.f, 80.f)), E1 = __expf(__builtin_amdgcn_fmed3f(bc1 - mid1, -80.f, 80.f));
                        const float qv0 = bflo(q[jj]) * E0, qv1 = bfhi(q[jj]) * E1;
                        kv0[e] = (1.f - __expf(bflo(g[jj]))) * __builtin_amdgcn_rcpf(E0); kv1[e] = (1.f - __expf(bfhi(g[jj]))) * __builtin_amdgcn_rcpf(E1);
                        const int t = e8 * 8 + jj;
                        *(LAS unsigned*)(qd + t * 136 + k0) = cvt_pk_bf16(qv0, qv1); *(LAS unsigned*)(kd + t * 136 + k0) = cvt_pk_bf16(kv0[e], kv1[e]); }
                    kp0[j >> 1] = cvt_pk_bf16(kv0[0], kv0[1]); kp1[j >> 1] = cvt_pk_bf16(kv1[0], kv1[1]);
                }
                *(LAS u32x4*)(kdT + k0 * 72 + e8 * 8) = (u32x4){kp0[0], kp0[1], kp0[2], kp0[3]};
                *(LAS u32x4*)(kdT + (k0 + 1) * 72 + e8 * 8) = (u32x4){kp1[0], kp1[1], kp1[2], kp1[3]};
                float em[4];
#pragma unroll
                for (int j = 0; j < 4; ++j) { const int kj = 16 * wave + fq * 4 + j; em[j] = __expf((tot[kj] + tot[128 + kj]) + (tot[256 + kj] + tot[384 + kj])); }
#pragma unroll
                for (int nt = 0; nt < 4; ++nt) { u32x2 w; w.x = cvt_pk_bf16(S[nt][0] * em[0], S[nt][1] * em[1]); w.y = cvt_pk_bf16(S[nt][2] * em[2], S[nt][3] * em[3]);
                    *(LAS u32x2*)(ST + (nt * 16 + l15) * 136 + 16 * wave + fq * 4) = w; }
                const unsigned vw[4] = {vC.x, vC.y, vC.z, vC.w};
#pragma unroll
                for (int i = 0; i < 4; ++i) { vT[(vn8 * 8 + 2 * i) * 72 + vs] = (bf16_t)(vw[i] & 0xffffu); vT[(vn8 * 8 + 2 * i + 1) * 72 + vs] = (bf16_t)(vw[i] >> 16); }
            }
            __syncthreads();
            const bool lat = c >= 4;
            if (lat) {
#pragma unroll
                for (int q2 = 0; q2 < 2; ++q2) { const int id = 2 * wave + q2, tt = id >> 2, st = id & 3;
                    f32x4 a = (f32x4){0.f, 0.f, 0.f, 0.f};
                    if (st <= tt) {
#pragma unroll
                        for (int ks = 0; ks < 4; ++ks) { const bf16x8 A = *(const LAS bf16x8*)(kd + (st * 16 + l15) * 136 + ks * 32 + fq * 8); const bf16x8 B = *(const LAS bf16x8*)(qd + (tt * 16 + l15) * 136 + ks * 32 + fq * 8); a = mfma16(A, B, a); } }
                    { const int t = tt * 16 + l15, s0 = st * 16 + fq * 4; u32x2 w; w.x = cvt_pk_bf16(s0 <= t ? a[0] : 0.f, s0 + 1 <= t ? a[1] : 0.f); w.y = cvt_pk_bf16(s0 + 2 <= t ? a[2] : 0.f, s0 + 3 <= t ? a[3] : 0.f);
                      *(LAS u32x2*)(at + t * 72 + s0) = w; } }
            }
            __syncthreads();
            if (lat) {
                const long rb = rbase(c);
#pragma unroll
                for (int q2 = 0; q2 < 2; ++q2) { const int id = 2 * wave + q2, tt = id >> 2, nt = id & 3;
                    f32x4 o = (f32x4){0.f, 0.f, 0.f, 0.f};
#pragma unroll
                    for (int ks = 0; ks < 2; ++ks) { const bf16x8 A = *(const LAS bf16x8*)(vT + (nt * 16 + l15) * 72 + ks * 32 + fq * 8); const bf16x8 B = *(const LAS bf16x8*)(at + (tt * 16 + l15) * 72 + ks * 32 + fq * 8); o = mfma16(A, B, o); }
#pragma unroll
                    for (int ks = 0; ks < 4; ++ks) { const bf16x8 A = *(const LAS bf16x8*)(ST + (nt * 16 + l15) * 136 + ks * 32 + fq * 8); const bf16x8 B = *(const LAS bf16x8*)(qd + (tt * 16 + l15) * 136 + ks * 32 + fq * 8); o = mfma16(A, B, o); }
                    { const long row = rb + sgn * (tt * 16 + l15); u32x2 w; w.x = cvt_pk_bf16(o[0], o[1]); w.y = cvt_pk_bf16(o[2], o[3]);
                      *(u32x2*)(O + row * 1024 + h * 128 + vh * 64 + nt * 16 + fq * 4) = w; } }
            }
            {
                float eb[4], e2[4];
#pragma unroll
                for (int j = 0; j < 4; ++j) { const int kj = 16 * wave + fq * 4 + j; const float m = (tot[kj] + tot[128 + kj]) + (tot[256 + kj] + tot[384 + kj]), bl = m + ((tot[512 + kj] + tot[640 + kj]) + (tot[768 + kj] + tot[896 + kj])); eb[j] = __expf(bl); e2[j] = __expf(bl - m); }
#pragma unroll
                for (int nt = 0; nt < 4; ++nt) { f32x4 tmp = (f32x4){0.f, 0.f, 0.f, 0.f};
#pragma unroll
                    for (int ks = 0; ks < 2; ++ks) { const bf16x8 A = *(const LAS bf16x8*)(kdT + (16 * wave + l15) * 72 + ks * 32 + fq * 8); const bf16x8 B = *(const LAS bf16x8*)(vT + (nt * 16 + l15) * 72 + ks * 32 + fq * 8); tmp = mfma16(A, B, tmp); }
#pragma unroll
                    for (int j = 0; j < 4; ++j) S[nt][j] = eb[j] * S[nt][j] + e2[j] * tmp[j]; }
            }
            __syncthreads();
        }
    }
}

__device__ __forceinline__ void post_hg(const Params& p, int wave, int lane) {
    const bf16_t* O0 = (const bf16_t*)((unsigned char*)p.out + DO_O); const bf16_t* O1 = O0 + (size_t)MLAT * 1024;
    const bf16_t* Pz = (const bf16_t*)(p.ws + WS_PZ); bf16_t* Y = (bf16_t*)(p.ws + WS_YHG);
    const int gw = blockIdx.x * 8 + wave, NGW = gridDim.x * 8, c0 = lane * 16;
    float g[16]; ldf<16>(p.hg_norm_g + c0, g);
    for (int tok = gw; tok < MLAT; tok += NGW) {
        float a[16], bq[16], z[16];
        ldbf<16>(O0 + (size_t)tok * 1024 + c0, a); ldbf<16>(O1 + (size_t)tok * 1024 + c0, bq); ldbf<16>(Pz + (size_t)tok * 1024 + c0, z);
        float ss = 0.f;
#pragma unroll
        for (int i = 0; i < 16; ++i) { a[i] += bq[i]; ss += a[i] * a[i]; }
        ss += __shfl_xor(ss, 1); ss += __shfl_xor(ss, 2); ss += __shfl_xor(ss, 4);
        const float rstd = rsqrtf(ss * (1.f / 128.f) + 1e-6f);
#pragma unroll
        for (int i = 0; i < 16; ++i) a[i] = a[i] * rstd * g[i] * z[i];
        stbf<16>(Y + (size_t)tok * 1024 + c0, a);
    }
}

__device__ __forceinline__ void rw_prep(const Params& p, LAS unsigned char* lds, int wave, int lane) {
    const bf16_t* Prw = (const bf16_t*)(p.ws + WS_PRW); const bf16_t* w2t = (const bf16_t*)(p.ws + WS_W2T);
    bf16_t* E0 = (bf16_t*)(p.ws + WS_E0); bf16_t* E1 = (bf16_t*)(p.ws + WS_E1); bf16_t* A0 = (bf16_t*)(p.ws + WS_A0); bf16_t* A1 = (bf16_t*)(p.ws + WS_A1);
    float* rn = (float*)(p.ws + WS_RN); float* bonus = (float*)(p.ws + WS_BONUS);
    const int l15 = lane & 15, fq = lane >> 4;
    LAS f32x4* cst = (LAS f32x4*)(lds + 8192) + wave * 480;
    for (int idx = lane; idx < 480; idx += 64) { const int nt8 = idx / 60, rem = idx % 60, arr = rem >> 2, fqi = rem & 3, chc = (wave * 2 + (nt8 >> 2)) * 64 + (nt8 & 3) * 16 + fqi * 4;
        const float* sp = arr < 4 ? p.rw_mu + arr * SHC + chc : arr < 8 ? p.rw_mu + (arr - 4) * SHC + 1024 + chc : arr == 8 ? p.rw_w0 + chc : arr == 9 ? p.rw_w0 + 1024 + chc : arr == 10 ? p.rw_a0 + chc : arr == 11 ? p.rw_a0 + 1024 + chc
                        : arr == 12 ? p.rw_kk + chc : arr == 13 ? p.rw_ka + chc : p.rw_rk + chc;
        cst[idx] = *(const f32x4*)sp; }
    for (int tile = blockIdx.x; tile < MTOT / 16; tile += gridDim.x) {
        const int hp = wave, R = tile * 16 + l15;
        const Nbr nb = nbr_of(R);
        { const int mat = wave >> 1, ks = wave & 1; float v[8]; shifted<8>(Prw, R, nb, 3072 + mat * 64 + ks * 32 + fq * 8, p.rw_mu, v);
          if (mat < 2) {
#pragma unroll
              for (int i = 0; i < 8; ++i) v[i] = tanh_(v[i]); }
          u32x4 w; w.x = cvt_pk_bf16(v[0], v[1]); w.y = cvt_pk_bf16(v[2], v[3]); w.z = cvt_pk_bf16(v[4], v[5]); w.w = cvt_pk_bf16(v[6], v[7]);
          *(LAS u32x4*)(lds + (wave * 64 + lane) * 16) = w; }
        __syncthreads();
        bf16x8 Bf[4][2];
#pragma unroll
        for (int mat = 0; mat < 4; ++mat)
#pragma unroll
            for (int ks = 0; ks < 2; ++ks) Bf[mat][ks] = *(const LAS bf16x8*)(lds + ((mat * 2 + ks) * 64 + lane) * 16);
#pragma unroll 1
        for (int hh = 0; hh < 2; ++hh) { const int head = hp * 2 + hh; float skk = 0.f, sb = 0.f;
#pragma unroll 1
            for (int nt = 0; nt < 4; ++nt) { const int n0 = head * 64 + nt * 16, ch = n0 + fq * 4;
                f32x4 acc[4];
#pragma unroll
                for (int mat = 0; mat < 4; ++mat) { acc[mat] = (f32x4){0.f, 0.f, 0.f, 0.f};
#pragma unroll
                    for (int ks = 0; ks < 2; ++ks) { const bf16x8 A = *(const bf16x8*)(w2t + ((size_t)mat * 1024 + n0 + l15) * 64 + ks * 32 + fq * 8); acc[mat] = mfma16(A, Bf[mat][ks], acc[mat]); } }
                const LAS f32x4* cs = cst + (hh * 4 + nt) * 60 + fq;
                const f32x4 mur[4] = {cs[0], cs[4], cs[8], cs[12]}, muk[4] = {cs[16], cs[20], cs[24], cs[28]};
                float rs[4], ks_[4]; shifted4m(Prw, R, nb, ch, mur, rs); shifted4m(Prw, R, nb, 1024 + ch, muk, ks_);
                const f32x4 w00 = cs[32], w01 = cs[36], a00 = cs[40], a01 = cs[44], kkc = cs[48], kac = cs[52], rkc = cs[56];
                float e0[4], e1[4], a0[4], a1[4];
#pragma unroll
                for (int j = 0; j < 4; ++j) { e0[j] = 0.60653066f * sigm(w00[j] + acc[0][j]); e1[j] = 0.60653066f * sigm(w01[j] + acc[1][j]); a0[j] = sigm(a00[j] + acc[2][j]); a1[j] = sigm(a01[j] + acc[3][j]);
                    const float kr = ks_[j] * kkc[j]; skk += kr * kr; sb += rs[j] * ks_[j] * (2.f + (a0[j] + a1[j] - 2.f) * kac[j]) * rkc[j]; }
                stbf<4>(E0 + (size_t)R * 1024 + ch, e0); stbf<4>(E1 + (size_t)R * 1024 + ch, e1); stbf<4>(A0 + (size_t)R * 1024 + ch, a0); stbf<4>(A1 + (size_t)R * 1024 + ch, a1);
            }
            skk += __shfl_xor(skk, 16); skk += __shfl_xor(skk, 32); sb += __shfl_xor(sb, 16); sb += __shfl_xor(sb, 32);
            if (fq == 0) { rn[(size_t)R * 16 + head] = rsqrtf(skk + 1e-12f); if (R < MLAT) bonus[(size_t)R * 16 + head] = sb; }
        }
        __syncthreads();
    }
}

struct RwVec { f32x4 wA, wB, kA, kB, bA, bB, dA, dB, rA, rB; float v; };
template <bool LAT> __device__ __forceinline__ void rw_ldv(const LAS float* bs, int voff, RwVec& V) {
    V.wA = *(const LAS f32x4*)(bs); V.wB = *(const LAS f32x4*)(bs + 4); V.kA = *(const LAS f32x4*)(bs + 64); V.kB = *(const LAS f32x4*)(bs + 68);
    V.bA = *(const LAS f32x4*)(bs + 128); V.bB = *(const LAS f32x4*)(bs + 132); V.dA = *(const LAS f32x4*)(bs + 192); V.dB = *(const LAS f32x4*)(bs + 196);
    if (LAT) { V.rA = *(const LAS f32x4*)(bs + 256); V.rB = *(const LAS f32x4*)(bs + 260); }
    V.v = bs[voff];
}
template <bool LAT> __device__ __forceinline__ void rw_chunk(const LAS float* cb, int voff, int q, f32x2 (&S)[4], float& ylo, float& yhi) {
    RwVec cur, nxt; rw_ldv<LAT>(cb, voff, cur);
#pragma unroll 2
    for (int s = 0; s < 16; ++s) {
        rw_ldv<LAT>(cb + (s < 15 ? s + 1 : 15) * 384, voff, nxt);
        f32x2 d = S[0] * cur.kA.lo; d = S[1] * cur.kA.hi + d; d = S[2] * cur.kB.lo + d; d = S[3] * cur.kB.hi + d;
        float t = d.x + d.y;
        t += dpp<0xB1>(t); t += dpp<0x4E>(t); t += dpp<0x141>(t);
        const f32x2 vv = {cur.v, cur.v}, ns = {-t, -t};
        S[0] = S[0] * cur.wA.lo + (cur.dA.lo * vv + cur.bA.lo * ns); S[1] = S[1] * cur.wA.hi + (cur.dA.hi * vv + cur.bA.hi * ns);
        S[2] = S[2] * cur.wB.lo + (cur.dB.lo * vv + cur.bB.lo * ns); S[3] = S[3] * cur.wB.hi + (cur.dB.hi * vv + cur.bB.hi * ns);
        if (LAT) {
            d = S[0] * cur.rA.lo; d = S[1] * cur.rA.hi + d; d = S[2] * cur.rB.lo + d; d = S[3] * cur.rB.hi + d;
            float y = d.x + d.y;
            y += dpp<0xB1>(y); y += dpp<0x4E>(y); y += dpp<0x141>(y);
            if (s < 8) ylo = (q == (s & 7)) ? y : ylo; else yhi = (q == (s & 7)) ? y : yhi;
        }
        cur = nxt;
    }
}
struct RwRegs { unsigned raw[3][5]; unsigned e, a; float rn; unsigned vmask; };
__device__ __forceinline__ void rw_scan(const Params& p, LAS unsigned char* lds, int tid, int wave, int lane) {
    LAS float* buf = (LAS float*)lds;
    const bf16_t* Prw = (const bf16_t*)(p.ws + WS_PRW); const float* rnp = (const float*)(p.ws + WS_RN);
    bf16_t* Ybase = (bf16_t*)((unsigned char*)p.out + DO_Y);
    for (int u = blockIdx.x; u < 256; u += gridDim.x) {
        const int b = u >> 5, h = (u >> 1) & 15, dir = u & 1;
        const bf16_t* Ed = (const bf16_t*)(p.ws + (dir ? WS_E1 : WS_E0)); const bf16_t* Ad = (const bf16_t*)(p.ws + (dir ? WS_A1 : WS_A0));
        bf16_t* Y = Ybase + (size_t)dir * MLAT * 1024;
        const int ls = tid >> 5, cp = tid & 31, ch = h * 64 + 2 * cp;
        float mu_[3][4][2];
#pragma unroll
        for (int a = 0; a < 3; ++a)
#pragma unroll
            for (int m = 0; m < 4; ++m) { const f32x2 t = *(const f32x2*)(p.rw_mu + m * SHC + a * 1024 + ch); mu_[a][m][0] = t.x; mu_[a][m][1] = t.y; }
        float c0v[3][2], c0h[3][2];
#pragma unroll
        for (int a = 0; a < 3; ++a)
#pragma unroll
            for (int e = 0; e < 2; ++e) { c0h[a][e] = 1.f - (mu_[a][0][e] + mu_[a][1][e]); c0v[a][e] = c0h[a][e] - (mu_[a][2][e] + mu_[a][3][e]); }
        const f32x2 kkc = *(const f32x2*)(p.rw_kk + ch), kac = *(const f32x2*)(p.rw_ka + ch);
        auto rowof = [&](int tau) -> int { if (tau < CTXL) { const int t = dir ? (CTXL - 1 - tau) : tau; return MLAT + b * CTXL + t; } const int t0 = tau - CTXL; const int t = dir ? (SEQ - 1 - t0) : t0; return b * SEQ + t; };
        const char* PrwA[3] = {(const char*)Prw, (const char*)Prw + 2048, (const char*)Prw + 4096};
        const int lsgn = dir ? -ls : ls;
        auto issue = [&](int c, RwRegs& r) { const int R = rowof(c * 16) + lsgn; const bool lat = c >= 16;
            const int t = lat ? (R & (SEQ - 1)) : ((R - MLAT) & (CTXL - 1));
            const bool vL = lat ? (t & 63) > 0 : t > 0, vR = lat ? (t & 63) < 63 : t < CTXL - 1, vU = lat && t >= 64, vD = lat && t < SEQ - 64;
            const unsigned oS = (unsigned)R * (unsigned)(SHC * 2) + (unsigned)(ch * 2);
            const unsigned oL = vL ? oS - SHC * 2 : oS, oR = vR ? oS + SHC * 2 : oS, oU = vU ? oS - 64 * SHC * 2 : oS, oD = vD ? oS + 64 * SHC * 2 : oS;
#pragma unroll
            for (int a = 0; a < 3; ++a) { r.raw[a][0] = *(const unsigned*)(PrwA[a] + oS); r.raw[a][1] = *(const unsigned*)(PrwA[a] + oL); r.raw[a][2] = *(const unsigned*)(PrwA[a] + oR);
                r.raw[a][3] = *(const unsigned*)(PrwA[a] + oU); r.raw[a][4] = *(const unsigned*)(PrwA[a] + oD); }
            r.e = *(const unsigned*)((const char*)Ed + (unsigned)R * 2048u + (unsigned)(ch * 2)); r.a = *(const unsigned*)((const char*)Ad + (unsigned)R * 2048u + (unsigned)(ch * 2)); r.rn = rnp[(unsigned)R * 16u + (unsigned)h];
            r.vmask = (vL ? 1u : 0u) | (vR ? 2u : 0u) | (vU ? 4u : 0u) | (vD ? 8u : 0u); };
        auto stage = [&](int c, const RwRegs& r) { LAS float* bs = buf + ((c & 1) * 16 + ls) * 384 + 2 * cp; const bool vert = c >= 16;
            float sh[3][2];
#pragma unroll
            for (int a = 0; a < 3; ++a) {
                const unsigned rl = (r.vmask & 1u) ? r.raw[a][1] : 0u, rr_ = (r.vmask & 2u) ? r.raw[a][2] : 0u, ru = (r.vmask & 4u) ? r.raw[a][3] : 0u, rd = (r.vmask & 8u) ? r.raw[a][4] : 0u;
#pragma unroll
                for (int e = 0; e < 2; ++e) { const float pv = e ? bfhi(r.raw[a][0]) : bflo(r.raw[a][0]), l = e ? bfhi(rl) : bflo(rl), rr = e ? bfhi(rr_) : bflo(rr_), up = e ? bfhi(ru) : bflo(ru), dn = e ? bfhi(rd) : bflo(rd);
                    const float c0 = vert ? c0v[a][e] : c0h[a][e];
                    sh[a][e] = c0 * pv + mu_[a][0][e] * l + mu_[a][1][e] * rr + mu_[a][2][e] * up + mu_[a][3][e] * dn; } }
            f32x2 w, kk, bb, kd, rr2, vv;
#pragma unroll
            for (int e = 0; e < 2; ++e) { const float ev = e ? bfhi(r.e) : bflo(r.e), av = e ? bfhi(r.a) : bflo(r.a); const float ksh = sh[1][e];
                const float kkv = ksh * kkc[e] * r.rn;
                w[e] = __expf(-ev); kk[e] = kkv; bb[e] = kkv * av; kd[e] = ksh * (1.f + (av - 1.f) * kac[e]); rr2[e] = sh[0][e]; vv[e] = sh[2][e]; }
            *(LAS f32x2*)(bs + 0) = w; *(LAS f32x2*)(bs + 64) = kk; *(LAS f32x2*)(bs + 128) = bb; *(LAS f32x2*)(bs + 192) = kd; *(LAS f32x2*)(bs + 256) = rr2; *(LAS f32x2*)(bs + 320) = vv; };
        const int q = lane & 7, row = wave * 8 + (lane >> 3);
        f32x2 S[4];
#pragma unroll
        for (int i = 0; i < 4; ++i) S[i] = (f32x2){0.f, 0.f};
        RwRegs regs;
        issue(0, regs); stage(0, regs);
        __syncthreads();
        const int voff = 320 - q * 8 + row; const long ysgn = dir ? -1 : 1;
        for (int c = 0; c < 144; ++c) {
            if (c + 1 < 144) issue(c + 1, regs);
            const LAS float* cb = buf + (c & 1) * (16 * 384) + q * 8;
            if (c < 16) { float y0 = 0.f, y1 = 0.f; rw_chunk<false>(cb, voff, q, S, y0, y1); }
            else { float y0 = 0.f, y1 = 0.f; rw_chunk<true>(cb, voff, q, S, y0, y1);
                const long rb = rowof(c * 16);
                bf16_t* yp = Y + (rb + ysgn * q) * 1024 + h * 64 + row;
                yp[0] = f2bf(y0); yp[ysgn * 8 * 1024] = f2bf(y1); }
            if (c + 1 < 144) stage(c + 1, regs);
            __syncthreads();
        }
    }
}

__device__ __forceinline__ void post_rw(const Params& p, LAS unsigned char* lds, int wave, int lane) {
    const bf16_t* Y0 = (const bf16_t*)((unsigned char*)p.out + DO_Y); const bf16_t* Y1 = Y0 + (size_t)MLAT * 1024;
    const bf16_t* Prw = (const bf16_t*)(p.ws + WS_PRW); const bf16_t* Pzrw = (const bf16_t*)(p.ws + WS_PZRW); const float* bonus = (const float*)(p.ws + WS_BONUS);
    bf16_t* Yo = (bf16_t*)(p.ws + WS_YRW);
    const int gw = blockIdx.x * 8 + wave, NGW = gridDim.x * 8, c0 = lane * 16, head = lane >> 2;
    float gg[16], gb[16]; ldf<16>(p.rw_gn_g + c0, gg); ldf<16>(p.rw_gn_b + c0, gb);
    for (int tok = gw; tok < MLAT; tok += NGW) {
        float a[16], bq[16], z[16], vs[16];
        ldbf<16>(Y0 + (size_t)tok * 1024 + c0, a); ldbf<16>(Y1 + (size_t)tok * 1024 + c0, bq); ldbf<16>(Pzrw + (size_t)tok * 1024 + c0, z);
        const Nbr nb = nbr_of(tok);
        shifted<16>(Prw, tok, nb, 2048 + c0, p.rw_mu, vs);
        float s = 0.f;
#pragma unroll
        for (int i = 0; i < 16; ++i) { a[i] += bq[i]; s += a[i]; }
        s += __shfl_xor(s, 1); s += __shfl_xor(s, 2);
        const float mean = s * (1.f / 64.f); float vr = 0.f;
#pragma unroll
        for (int i = 0; i < 16; ++i) { a[i] -= mean; vr += a[i] * a[i]; }
        vr += __shfl_xor(vr, 1); vr += __shfl_xor(vr, 2);
        const float rstd = rsqrtf(vr * (1.f / 64.f) + 64e-5f), bon = bonus[(size_t)tok * 16 + head];
#pragma unroll
        for (int i = 0; i < 16; ++i) a[i] = (a[i] * rstd * gg[i] + gb[i] + bon * vs[i]) * z[i];
        stbf<16>(Yo + (size_t)tok * 1024 + c0, a);
    }
    LAS float* scr = (LAS float*)(lds + wave * 8448);
    bf16_t* wto1 = (bf16_t*)(p.ws + WS_WTO1); bf16_t* wto2 = (bf16_t*)(p.ws + WS_WTO2); bf16_t* wtg = (bf16_t*)(p.ws + WS_WTG);
    constexpr int I_1 = (1024 / 64) * (D / 32), I_2 = (D / 64) * (D / 32), I_G = (D / 64) * (4096 / 32);
    for (int it = gw; it < 2 * I_1 + I_2 + I_G; it += NGW) {
        if (it < I_1) transpose_item(p.w_hg_out, 1024, D, D, wto1, scr, it, lane);
        else if (it < 2 * I_1) transpose_item(p.w_rw_out, 1024, D, D, wto1 + (size_t)D * 1024, scr, it - I_1, lane);
        else if (it < 2 * I_1 + I_2) transpose_item(p.w_out, D, D, D, wto2, scr, it - 2 * I_1, lane);
        else transpose_item(p.w_in + NC1, D, NCOLS, 4096, wtg, scr, it - 2 * I_1 - I_2, lane);
    }
}

struct OrderOut1 {
    int G, c;
    __device__ bool next(int i, Unit& u) const { const int tile = (i >> 1) * G + c, br = i & 1; if (tile >= 512) return false; const int pm = tile >> 3, pn = tile & 7;
        if (br == 0) { u.pm = pm; u.pn = pn; } else { u.pm = pm + YRW_PM_OFF; u.pn = pn + 8; } return true; }
    __device__ __forceinline__ void a_ready(const Unit&) const {}
    __device__ __forceinline__ void done(const Unit&) const {}
};
struct EpiOut1 {
    static constexpr bool PERM = true, AFTER_DRAIN = false, CHAIN = true;
    unsigned char* ws;
    __device__ __forceinline__ bool chain(f32x4 (&acc)[2][2][4][2], const Unit& u, int wr, int wc, int fr, int fq) const {
        const int br = u.pn >> 3, ct = u.pn & 7, rt = u.pm & 63;
        const bf16_t* G = (const bf16_t*)(ws + WS_PGATE); bf16_t* Mg = (bf16_t*)(ws + WS_MERGED);
        const int row0 = rt * 256 + wr * 64 + fr, col0 = ct * 256 + wc * 32 + 8 * fq;
#pragma unroll
        for (int ai = 0; ai < 2; ++ai)
#pragma unroll
            for (int m = 0; m < 4; ++m) { const size_t row = (size_t)(row0 + ai * 128 + m * 16);
#pragma unroll
                for (int bj = 0; bj < 2; ++bj) { const int col = col0 + bj * 128; float g2[8]; ldbf<8>(G + row * 4096 + 2048 + col, g2);
#pragma unroll
                    for (int i = 0; i < 8; ++i) g2[i] = fmaxf(g2[i], 1e-30f);
                    if (br == 0) { float g1[8]; ldbf<8>(G + row * 4096 + col, g1);
#pragma unroll
                        for (int i = 0; i < 4; ++i) { acc[ai][bj][m][0][i] *= g1[i] * __builtin_amdgcn_rcpf(g2[i]); acc[ai][bj][m][1][i] *= g1[4 + i] * __builtin_amdgcn_rcpf(g2[4 + i]); } }
                    else { float v[8];
#pragma unroll
                        for (int i = 0; i < 4; ++i) { v[i] = acc[ai][bj][m][0][i] * g2[i]; v[4 + i] = acc[ai][bj][m][1][i] * g2[4 + i]; }
                        stbf<8>(Mg + row * 2048 + col, v); } } }
        return br == 0;
    }
};
struct EpiOut2 {
    static constexpr bool PERM = false, AFTER_DRAIN = false, CHAIN = false;
    const float* x; const float* mod; float* out;
    __device__ __forceinline__ void operator()(const f32x4 (&acc)[2][2][4][2], const Unit& u, int wr, int wc, int fr, int fq) const {
        const int row0 = u.pm * 256 + wr * 64 + fr, col0 = u.pn * 256 + wc * 32 + 4 * fq;
#pragma unroll
        for (int ai = 0; ai < 2; ++ai)
#pragma unroll
            for (int m = 0; m < 4; ++m) { const int row = row0 + ai * 128 + m * 16; const float* gate = mod + (row >> 11) * (3 * D) + 2 * D;
#pragma unroll
                for (int bj = 0; bj < 2; ++bj)
#pragma unroll
                    for (int n = 0; n < 2; ++n) { const int col = col0 + bj * 128 + n * 16; const f32x4 xv = *(const f32x4*)(x + (size_t)row * D + col), gv = *(const f32x4*)(gate + col);
                        *(f32x4*)(out + (size_t)row * D + col) = xv + gv * acc[ai][bj][m][n]; } }
    }
};
__device__ __forceinline__ void final_norm(const Params& p, int wave, int lane) {
    const int gw = blockIdx.x * 8 + wave, NGW = gridDim.x * 8;
    for (int row = gw; row < MLAT; row += NGW) {
        f32x4* xr = (f32x4*)(p.out + (size_t)row * D);
        f32x4 v[8]; float ss = 0.f;
#pragma unroll
        for (int j = 0; j < 8; ++j) { v[j] = __builtin_nontemporal_load(&xr[lane + 64 * j]); ss += (v[j].x * v[j].x + v[j].y * v[j].y) + (v[j].z * v[j].z + v[j].w * v[j].w); }
        ss = wave_sum(ss);
        const float rstd = rsqrtf(ss * (1.f / D) + 1e-6f);
#pragma unroll
        for (int j = 0; j < 8; ++j) { const f32x4 g = *(const f32x4*)(p.final_g + 4 * (lane + 64 * j)); __builtin_nontemporal_store(v[j] * rstd * g, &xr[lane + 64 * j]); }
    }
}


__device__ __forceinline__ void rw_scan4(const Params& p, LAS unsigned char* lds, int tid, int wave, int lane) {
    LAS float* buf = (LAS float*)lds;
    const bf16_t* Prw = (const bf16_t*)(p.ws + WS_PRW); const float* rnp = (const float*)(p.ws + WS_RN);
    bf16_t* Ybase = (bf16_t*)((unsigned char*)p.out + DO_Y);
    for (int u = blockIdx.x; u < 256; u += gridDim.x) {
        const int b = u >> 5, h = (u >> 1) & 15, dir = u & 1;
        const bf16_t* Ed = (const bf16_t*)(p.ws + (dir ? WS_E1 : WS_E0)); const bf16_t* Ad = (const bf16_t*)(p.ws + (dir ? WS_A1 : WS_A0));
        bf16_t* Y = Ybase + (size_t)dir * MLAT * 1024;
        const int ls0 = tid >> 5, cp = tid & 31, ch = h * 64 + 2 * cp;
        float mu_[3][4][2];
#pragma unroll
        for (int a = 0; a < 3; ++a)
#pragma unroll
            for (int m = 0; m < 4; ++m) { const f32x2 t = *(const f32x2*)(p.rw_mu + m * SHC + a * 1024 + ch); mu_[a][m][0] = t.x; mu_[a][m][1] = t.y; }
        const f32x2 kkc = *(const f32x2*)(p.rw_kk + ch), kac = *(const f32x2*)(p.rw_ka + ch);
        auto rowof = [&](int tau) -> int { if (tau < CTXL) { const int t = dir ? (CTXL - 1 - tau) : tau; return MLAT + b * CTXL + t; } const int t0 = tau - CTXL; const int t = dir ? (SEQ - 1 - t0) : t0; return b * SEQ + t; };
        auto issue = [&](int c, int ls, RwRegs& r) { const int R = rowof(c * 16 + ls); const Nbr nb = nbr_of(R);
#pragma unroll
            for (int a = 0; a < 3; ++a) { const bf16_t* base = Prw + a * 1024 + ch;
                r.raw[a][0] = *(const unsigned*)(base + (size_t)R * SHC);
                r.raw[a][1] = nb.L >= 0 ? *(const unsigned*)(base + (size_t)nb.L * SHC) : 0u;
                r.raw[a][2] = nb.R >= 0 ? *(const unsigned*)(base + (size_t)nb.R * SHC) : 0u;
                r.raw[a][3] = nb.U >= 0 ? *(const unsigned*)(base + (size_t)nb.U * SHC) : 0u;
                r.raw[a][4] = nb.Dn >= 0 ? *(const unsigned*)(base + (size_t)nb.Dn * SHC) : 0u; }
            r.e = *(const unsigned*)(Ed + (size_t)R * 1024 + ch); r.a = *(const unsigned*)(Ad + (size_t)R * 1024 + ch); r.rn = rnp[(size_t)R * 16 + h]; };
        auto stage = [&](int c, int ls, const RwRegs& r) { LAS float* bs = buf + ((c & 1) * 16 + ls) * 384 + 2 * cp; const bool vert = c >= 16;
            float sh[3][2];
#pragma unroll
            for (int a = 0; a < 3; ++a)
#pragma unroll
                for (int e = 0; e < 2; ++e) { const float pv = e ? bfhi(r.raw[a][0]) : bflo(r.raw[a][0]), l = e ? bfhi(r.raw[a][1]) : bflo(r.raw[a][1]), rr = e ? bfhi(r.raw[a][2]) : bflo(r.raw[a][2]),
                                                  up = e ? bfhi(r.raw[a][3]) : bflo(r.raw[a][3]), dn = e ? bfhi(r.raw[a][4]) : bflo(r.raw[a][4]);
                    float o = pv + mu_[a][0][e] * (l - pv) + mu_[a][1][e] * (rr - pv);
                    if (vert) o += mu_[a][2][e] * (up - pv) + mu_[a][3][e] * (dn - pv);
                    sh[a][e] = o; }
            f32x2 w, kk, bb, kd, rr2, vv;
#pragma unroll
            for (int e = 0; e < 2; ++e) { const float ev = e ? bfhi(r.e) : bflo(r.e), av = e ? bfhi(r.a) : bflo(r.a); const float ksh = sh[1][e];
                const float kkv = ksh * kkc[e] * r.rn;
                w[e] = __expf(-ev); kk[e] = kkv; bb[e] = kkv * av; kd[e] = ksh * (1.f + (av - 1.f) * kac[e]); rr2[e] = sh[0][e]; vv[e] = sh[2][e]; }
            *(LAS f32x2*)(bs + 0) = w; *(LAS f32x2*)(bs + 64) = kk; *(LAS f32x2*)(bs + 128) = bb; *(LAS f32x2*)(bs + 192) = kd; *(LAS f32x2*)(bs + 256) = rr2; *(LAS f32x2*)(bs + 320) = vv; };
        const int rg = lane >> 4, q = lane & 15, row0 = wave * 16 + rg * 4; const bool b0 = (q & 1) != 0, b1 = (q & 2) != 0;
        const int myrow = row0 + ((q & 1) << 1) + ((q >> 1) & 1);
        float S[4][4];
#pragma unroll
        for (int i = 0; i < 4; ++i)
#pragma unroll
            for (int j = 0; j < 4; ++j) S[i][j] = 0.f;
        RwRegs ra, rb;
        issue(0, ls0, ra); issue(0, ls0 + 8, rb); stage(0, ls0, ra); stage(0, ls0 + 8, rb);
        __syncthreads();
        for (int c = 0; c < 144; ++c) {
            if (c + 1 < 144) { issue(c + 1, ls0, ra); issue(c + 1, ls0 + 8, rb); }
            const bool lat = c >= 16;
#pragma unroll 2
            for (int s = 0; s < 16; ++s) {
                const LAS float* bs = buf + ((c & 1) * 16 + s) * 384;
                const f32x4 w4 = *(const LAS f32x4*)(bs + q * 4), kk4 = *(const LAS f32x4*)(bs + 64 + q * 4), b4 = *(const LAS f32x4*)(bs + 128 + q * 4), kd4 = *(const LAS f32x4*)(bs + 192 + q * 4), r4 = *(const LAS f32x4*)(bs + 256 + q * 4);
                const f32x4 v4 = *(const LAS f32x4*)(bs + 320 + row0);
                float pp[4];
#pragma unroll
                for (int i = 0; i < 4; ++i) pp[i] = (S[i][0] * kk4[0] + S[i][1] * kk4[1]) + (S[i][2] * kk4[2] + S[i][3] * kk4[3]);
                float ta = (b0 ? pp[2] : pp[0]) + dpp<0xB1>(b0 ? pp[0] : pp[2]);
                float tb = (b0 ? pp[3] : pp[1]) + dpp<0xB1>(b0 ? pp[1] : pp[3]);
                float t = (b1 ? tb : ta) + dpp<0x4E>(b1 ? ta : tb);
                t += dpp<0x124>(t); t += dpp<0x128>(t);
                float sa[4]; sa[0] = dpp<0x00>(t); sa[1] = dpp<0xAA>(t); sa[2] = dpp<0x55>(t); sa[3] = dpp<0xFF>(t);
#pragma unroll
                for (int i = 0; i < 4; ++i)
#pragma unroll
                    for (int j = 0; j < 4; ++j) S[i][j] = S[i][j] * w4[j] + (v4[i] * kd4[j] - sa[i] * b4[j]);
                if (lat) {
#pragma unroll
                    for (int i = 0; i < 4; ++i) pp[i] = (S[i][0] * r4[0] + S[i][1] * r4[1]) + (S[i][2] * r4[2] + S[i][3] * r4[3]);
                    float ya = (b0 ? pp[2] : pp[0]) + dpp<0xB1>(b0 ? pp[0] : pp[2]);
                    float yb = (b0 ? pp[3] : pp[1]) + dpp<0xB1>(b0 ? pp[1] : pp[3]);
                    float y = (b1 ? yb : ya) + dpp<0x4E>(b1 ? ya : yb);
                    y += dpp<0x124>(y); y += dpp<0x128>(y);
                    if (q < 4) Y[(size_t)rowof(c * 16 + s) * 1024 + h * 64 + myrow] = f2bf(y);
                }
            }
            if (c + 1 < 144) { stage(c + 1, ls0, ra); stage(c + 1, ls0 + 8, rb); }
            __syncthreads();
        }
    }
}

__device__ __forceinline__ void hg_scan4(const Params& p, LAS unsigned char* lds, int tid, int wave, int lane) {
    LAS bf16_t* qd = (LAS bf16_t*)(lds);
    LAS bf16_t* kd = (LAS bf16_t*)(lds + 17408);
    LAS bf16_t* kdT = (LAS bf16_t*)(lds + 34816);
    LAS bf16_t* vT = (LAS bf16_t*)(lds + 53248);
    LAS bf16_t* ST = (LAS bf16_t*)(lds + 62464);
    LAS bf16_t* at = (LAS bf16_t*)(lds + 79872);
    LAS float* tot = (LAS float*)(lds + 89088);
    const bf16_t* Pq = (const bf16_t*)(p.ws + WS_PQ); const bf16_t* Pi = (const bf16_t*)(p.ws + WS_PI);
    bf16_t* Obase = (bf16_t*)((unsigned char*)p.out + DO_O);
    const int l15 = lane & 15, fq = lane >> 4;
    for (int u = blockIdx.x; u < 256; u += gridDim.x) {
        const int b = u >> 5, h = (u >> 2) & 7, dir = (u >> 1) & 1, vh = u & 1;
        const bf16_t* Pg = (const bf16_t*)(p.ws + (dir ? WS_PGB : WS_PGF));
        bf16_t* O = Obase + (size_t)dir * MLAT * 1024;
        const int k0 = 2 * lane, qtr = wave, vs = tid >> 2, vq = tid & 3;
        const int sgn = dir ? -1 : 1;
        auto rbase = [&](int c) -> int { if (c < 4) return MLAT + b * CTXL + (dir ? (CTXL - 1 - c * 64) : c * 64); const int t0 = (c - 4) * 64; return b * SEQ + (dir ? (SEQ - 1 - t0) : t0); };
        const long rstep = (long)sgn * 1024;
        f32x4 S[2][4];
#pragma unroll
        for (int a = 0; a < 2; ++a)
#pragma unroll
            for (int i = 0; i < 4; ++i) S[a][i] = (f32x4){0.f, 0.f, 0.f, 0.f};
        unsigned gN[16], qN[16]; u32x4 vN[2];
#pragma unroll
        for (int j = 0; j < 16; ++j) { const long o = ((long)rbase(0) + sgn * (qtr * 16)) * 1024 + h * 128 + k0 + j * rstep; gN[j] = *(const unsigned*)(Pg + o); qN[j] = *(const unsigned*)(Pq + o); }
#pragma unroll
        for (int i = 0; i < 2; ++i) vN[i] = *(const u32x4*)(Pi + ((long)rbase(0) + sgn * vs) * 1024 + h * 128 + vh * 64 + vq * 16 + i * 8);
        __syncthreads();
        for (int c = 0; c < 36; ++c) {
            unsigned g[16], q[16]; const u32x4 vC0 = vN[0], vC1 = vN[1];
#pragma unroll
            for (int j = 0; j < 16; ++j) { g[j] = gN[j]; q[j] = qN[j]; }
            if (c + 1 < 36) {
                const long rb1 = rbase(c + 1);
                const bf16_t* gp = Pg + (rb1 + sgn * (qtr * 16)) * 1024 + h * 128 + k0; const bf16_t* qp_ = Pq + (rb1 + sgn * (qtr * 16)) * 1024 + h * 128 + k0;
#pragma unroll
                for (int j = 0; j < 16; ++j) { gN[j] = *(const unsigned*)(gp + j * rstep); qN[j] = *(const unsigned*)(qp_ + j * rstep); }
#pragma unroll
                for (int i = 0; i < 2; ++i) vN[i] = *(const u32x4*)(Pi + (rb1 + sgn * vs) * 1024 + h * 128 + vh * 64 + vq * 16 + i * 8);
            }
            float run0 = 0.f, run1 = 0.f;
#pragma unroll
            for (int j = 0; j < 16; ++j) { run0 += bflo(g[j]); run1 += bfhi(g[j]); }
            *(LAS f32x2*)(tot + qtr * 128 + k0) = (f32x2){run0, run1};
            __syncthreads();
            {
                const f32x2 t0 = *(const LAS f32x2*)(tot + k0), t1 = *(const LAS f32x2*)(tot + 128 + k0), t2 = *(const LAS f32x2*)(tot + 256 + k0);
                const float mid0 = t0.x + t1.x, mid1 = t0.y + t1.y;
                const float off0 = qtr == 0 ? 0.f : (qtr == 1 ? t0.x : (qtr == 2 ? mid0 : mid0 + t2.x));
                const float off1 = qtr == 0 ? 0.f : (qtr == 1 ? t0.y : (qtr == 2 ? mid1 : mid1 + t2.y));
                unsigned kp0[8], kp1[8]; float bc0 = off0, bc1 = off1;
#pragma unroll
                for (int j = 0; j < 16; j += 2) {
                    float kv0[2], kv1[2];
#pragma unroll
                    for (int e = 0; e < 2; ++e) { const int jj = j + e;
                        bc0 += bflo(g[jj]); bc1 += bfhi(g[jj]);
                        const float qv0 = bflo(q[jj]) * __expf(fminf(bc0 - mid0, 80.f)), qv1 = bfhi(q[jj]) * __expf(fminf(bc1 - mid1, 80.f));
                        kv0[e] = (1.f - __expf(bflo(g[jj]))) * __expf(fminf(mid0 - bc0, 80.f)); kv1[e] = (1.f - __expf(bfhi(g[jj]))) * __expf(fminf(mid1 - bc1, 80.f));
                        const int t = qtr * 16 + jj;
                        *(LAS unsigned*)(qd + t * 136 + k0) = cvt_pk_bf16(qv0, qv1); *(LAS unsigned*)(kd + t * 136 + k0) = cvt_pk_bf16(kv0[e], kv1[e]); }
                    kp0[j >> 1] = cvt_pk_bf16(kv0[0], kv0[1]); kp1[j >> 1] = cvt_pk_bf16(kv1[0], kv1[1]);
                }
                *(LAS u32x4*)(kdT + k0 * 72 + qtr * 16) = (u32x4){kp0[0], kp0[1], kp0[2], kp0[3]};
                *(LAS u32x4*)(kdT + k0 * 72 + qtr * 16 + 8) = (u32x4){kp0[4], kp0[5], kp0[6], kp0[7]};
                *(LAS u32x4*)(kdT + (k0 + 1) * 72 + qtr * 16) = (u32x4){kp1[0], kp1[1], kp1[2], kp1[3]};
                *(LAS u32x4*)(kdT + (k0 + 1) * 72 + qtr * 16 + 8) = (u32x4){kp1[4], kp1[5], kp1[6], kp1[7]};
#pragma unroll
                for (int kt = 0; kt < 2; ++kt) { const int kb = 32 * wave + 16 * kt + fq * 4;
                    float em[4];
#pragma unroll
                    for (int j = 0; j < 4; ++j) em[j] = __expf(tot[kb + j] + tot[128 + kb + j]);
#pragma unroll
                    for (int nt = 0; nt < 4; ++nt) { u32x2 w; w.x = cvt_pk_bf16(S[kt][nt][0] * em[0], S[kt][nt][1] * em[1]); w.y = cvt_pk_bf16(S[kt][nt][2] * em[2], S[kt][nt][3] * em[3]);
                        *(LAS u32x2*)(ST + (nt * 16 + l15) * 136 + kb) = w; } }
                const unsigned vw[8] = {vC0.x, vC0.y, vC0.z, vC0.w, vC1.x, vC1.y, vC1.z, vC1.w};
#pragma unroll
                for (int i = 0; i < 8; ++i) { vT[(vq * 16 + 2 * i) * 72 + vs] = (bf16_t)(vw[i] & 0xffffu); vT[(vq * 16 + 2 * i + 1) * 72 + vs] = (bf16_t)(vw[i] >> 16); }
            }
            __syncthreads();
            const bool lat = c >= 4;
            if (lat) {
                const int tt = wave;
#pragma unroll
                for (int st = 0; st < 4; ++st) {
                    f32x4 a = (f32x4){0.f, 0.f, 0.f, 0.f};
                    if (st <= tt) {
#pragma unroll
                        for (int ks = 0; ks < 4; ++ks) { const bf16x8 A = *(const LAS bf16x8*)(qd + (tt * 16 + l15) * 136 + ks * 32 + fq * 8); const bf16x8 B = *(const LAS bf16x8*)(kd + (st * 16 + l15) * 136 + ks * 32 + fq * 8); a = mfma16(A, B, a); } }
#pragma unroll
                    for (int j = 0; j < 4; ++j) { const int t = tt * 16 + fq * 4 + j, s = st * 16 + l15; at[t * 72 + s] = f2bf(s <= t ? a[j] : 0.f); } }
            }
            __syncthreads();
            if (lat) {
                const int tt = wave;
#pragma unroll
                for (int nt = 0; nt < 4; ++nt) {
                    f32x4 o = (f32x4){0.f, 0.f, 0.f, 0.f};
#pragma unroll
                    for (int ks = 0; ks < 2; ++ks) { const bf16x8 A = *(const LAS bf16x8*)(at + (tt * 16 + l15) * 72 + ks * 32 + fq * 8); const bf16x8 B = *(const LAS bf16x8*)(vT + (nt * 16 + l15) * 72 + ks * 32 + fq * 8); o = mfma16(A, B, o); }
#pragma unroll
                    for (int ks = 0; ks < 4; ++ks) { const bf16x8 A = *(const LAS bf16x8*)(qd + (tt * 16 + l15) * 136 + ks * 32 + fq * 8); const bf16x8 B = *(const LAS bf16x8*)(ST + (nt * 16 + l15) * 136 + ks * 32 + fq * 8); o = mfma16(A, B, o); }
#pragma unroll
                    for (int j = 0; j < 4; ++j) { const long row = (long)rbase(c) + sgn * (tt * 16 + fq * 4 + j); O[row * 1024 + h * 128 + vh * 64 + nt * 16 + l15] = f2bf(o[j]); } }
            }
#pragma unroll
            for (int kt = 0; kt < 2; ++kt) { const int kb = 32 * wave + 16 * kt;
                float eb[4], e2[4];
#pragma unroll
                for (int j = 0; j < 4; ++j) { const int kj = kb + fq * 4 + j; const float m = tot[kj] + tot[128 + kj], bl = m + tot[256 + kj] + tot[384 + kj]; eb[j] = __expf(bl); e2[j] = __expf(bl - m); }
#pragma unroll
                for (int nt = 0; nt < 4; ++nt) { f32x4 tmp = (f32x4){0.f, 0.f, 0.f, 0.f};
#pragma unroll
                    for (int ks = 0; ks < 2; ++ks) { const bf16x8 A = *(const LAS bf16x8*)(kdT + (kb + l15) * 72 + ks * 32 + fq * 8); const bf16x8 B = *(const LAS bf16x8*)(vT + (nt * 16 + l15) * 72 + ks * 32 + fq * 8); tmp = mfma16(A, B, tmp); }
#pragma unroll
                    for (int j = 0; j < 4; ++j) S[kt][nt][j] = eb[j] * S[kt][nt][j] + e2[j] * tmp[j]; } }
            __syncthreads();
        }
    }
}

#define XB_TMO      128
#define XB_XCNT(j)  (256  + 64 * (j))
#define XB_XSUB(j)  (1280 + 64 * (j))
#define XB_XGEN(j)  (2304 + 64 * (j))
#define XB_TOP      3328
#define XB_TOPGEN   3392
#define XCD_BAR_WORDS 3456
#define XB_SPIN_CAP (1u << 18)

__device__ __forceinline__ unsigned xb_ld(unsigned* p)              { return __hip_atomic_load(p, __ATOMIC_RELAXED, __HIP_MEMORY_SCOPE_AGENT); }
__device__ __forceinline__ unsigned xb_add(unsigned* p, unsigned v) { return __hip_atomic_fetch_add(p, v, __ATOMIC_RELAXED, __HIP_MEMORY_SCOPE_AGENT); }
__device__ __forceinline__ unsigned xb_xcc_id() { return (unsigned)__builtin_amdgcn_s_getreg((3 << 11) | 20) & 0xFu; }
#define XB_SPIN(cond, bar) do { unsigned _sp = 0; while (cond) { __builtin_amdgcn_s_sleep(1); \
    if ((++_sp & 255u) == 0u) { if (xb_ld(&(bar)[XB_TMO])) break; if (_sp > XB_SPIN_CAP) { atomicAdd(&(bar)[XB_TMO], 1u); break; } } } } while (0)

struct XcdBarrier {
    unsigned* bar; unsigned x;
    volatile LAS unsigned* st;
};

__device__ __forceinline__ XcdBarrier xcd_barrier_post(unsigned* bar, volatile LAS unsigned* st) {
    XcdBarrier b; b.bar = bar; b.x = xb_xcc_id(); b.st = st;
    if (threadIdx.x == 0) (void)xb_add(&bar[XB_XCNT(b.x)], 1u);
    return b;
}
__device__ __forceinline__ void xcd_barrier_complete(unsigned* bar, unsigned x, unsigned& nloc, unsigned& nx) {
    const unsigned G = gridDim.x * gridDim.y * gridDim.z;
    unsigned sum, cnt, mine, sp = 0u;
    for (;;) {
        sum = 0u; cnt = 0u; mine = 0u;
#pragma unroll
        for (unsigned j = 0; j < 16; ++j) { const unsigned c = xb_ld(&bar[XB_XCNT(j)]); sum += c; cnt += (c > 0u) ? 1u : 0u; mine = (j == x) ? c : mine; }
        if (sum == G) break;
        __builtin_amdgcn_s_sleep(1);
        if ((++sp & 255u) == 0u) { if (xb_ld(&bar[XB_TMO])) break; if (sp > XB_SPIN_CAP) { atomicAdd(&bar[XB_TMO], 1u); break; } }
    }
    nloc = mine > 0u ? mine : 1u; nx = cnt > 0u ? cnt : 1u;
}

__device__ __forceinline__ void xcd_barrier(const XcdBarrier& b) {
    asm volatile("s_waitcnt vmcnt(0)" ::: "memory");
    __syncthreads();
    if (threadIdx.x == 0) {
        unsigned* bar = b.bar;
        __builtin_amdgcn_s_waitcnt(0);
        unsigned nloc = b.st[0], nx = b.st[1];
        if (nloc == 0u) { xcd_barrier_complete(bar, b.x, nloc, nx); b.st[0] = nloc; b.st[1] = nx; }
        const unsigned old = xb_add(&bar[XB_XSUB(b.x)], 1u);
        const unsigned gen = old / nloc;
        if (old + 1u == (gen + 1u) * nloc) {
            __builtin_amdgcn_fence(__ATOMIC_RELEASE, "agent");
            asm volatile("s_waitcnt vmcnt(0)" ::: "memory");
            const unsigned og = xb_add(&bar[XB_TOP], 1u);
            const unsigned tg = og / nx;
            if (og + 1u == (tg + 1u) * nx) xb_add(&bar[XB_TOPGEN], 1u);
            else XB_SPIN(xb_ld(&bar[XB_TOPGEN]) == tg, bar);
            __builtin_amdgcn_fence(__ATOMIC_ACQUIRE, "agent");
            xb_add(&bar[XB_XGEN(b.x)], 1u);
            asm volatile("s_waitcnt vmcnt(0)" ::: "memory");
        } else {
            XB_SPIN(xb_ld(&bar[XB_XGEN(b.x)]) == gen, bar);
            __builtin_amdgcn_fence(__ATOMIC_ACQUIRE, "agent");
            asm volatile("s_waitcnt vmcnt(0)" ::: "memory");
        }
    }
    __syncthreads();
}


#ifndef GA
#define GA true
#endif
#ifndef GS
#define GS true
#endif
#ifndef COMBINED
#define COMBINED 0
#endif

__global__ void __launch_bounds__(512, 2) mega(Params p) {
    extern __shared__ __attribute__((aligned(16))) unsigned char shm[];
    LAS unsigned char* lds = (LAS unsigned char*)shm;
    cg::grid_group grid = cg::this_grid();
    const int tid = threadIdx.x, wave = __builtin_amdgcn_readfirstlane(tid >> 6), lane = tid & 63;
    volatile LAS unsigned* xst = (volatile LAS unsigned*)(lds + 131072);
    if (tid == 0) { xst[0] = 0u; xst[1] = 0u; }
    __syncthreads();
    const XcdBarrier xb = xcd_barrier_post((unsigned*)(p.ws + WS_BAR), xst);
    phase0(p, lds, tid, wave, lane);
    if (p.ws == nullptr) grid.sync();
    xcd_barrier(xb);
    phase1(p, (bf16_t*)((unsigned char*)p.out + DO_H), MTOT, wave, lane);
    xcd_barrier(xb);
    { pg8::Gemm g{(const bf16_t*)((unsigned char*)p.out + DO_H), (const bf16_t*)((unsigned char*)p.out + DO_WTIN), MTOT, NC1, D};
      InOrder S{(int)gridDim.x, (int)blockIdx.x}; EpiProj E{p.ws};
      pg8::gemm_phase<EpiProj, InOrder, GA, GS>(lds, g, S, E); }
    xcd_barrier(xb);
    rw_prep(p, lds, wave, lane);
    xcd_barrier(xb);
#if COMBINED
    if (wave < 4) rw_scan4(p, lds, tid, wave, lane);
    else hg_scan4(p, lds + RW_LDS, tid - 256, wave - 4, lane);
#else
    hg_scan(p, lds, tid, wave, lane);
    rw_scan(p, lds, tid, wave, lane);
#endif
    xcd_barrier(xb);
    post_hg(p, wave, lane);
    post_rw(p, lds, wave, lane);
    phase1(p, (bf16_t*)(p.ws + WS_H2), MLAT, wave, lane);
    xcd_barrier(xb);
    { pg8::Gemm g{(const bf16_t*)(p.ws + WS_H2), (const bf16_t*)(p.ws + WS_WTG), MLAT, 4096, D};
      pg8::StaticOrder S; S.init(MLAT, 4096, (int)gridDim.x, (int)blockIdx.x); EpiGate E{p.ws};
      pg8::gemm_phase<EpiGate, pg8::StaticOrder, GA, GS>(lds, g, S, E); }
    xcd_barrier(xb);
    { pg8::Gemm g{(const bf16_t*)(p.ws + WS_YHG), (const bf16_t*)(p.ws + WS_WTO1), 0, 0, 1024};
      OrderOut1 S{(int)gridDim.x, (int)blockIdx.x}; EpiOut1 E{p.ws};
      pg8::gemm_phase<EpiOut1, OrderOut1, GA, GS>(lds, g, S, E); }
    xcd_barrier(xb);
    { pg8::Gemm g{(const bf16_t*)(p.ws + WS_MERGED), (const bf16_t*)(p.ws + WS_WTO2), MLAT, D, D};
      pg8::StaticOrder S; S.init(MLAT, D, (int)gridDim.x, (int)blockIdx.x); EpiOut2 E{p.x, (const float*)(p.ws + WS_MOD), p.out};
      pg8::gemm_phase<EpiOut2, pg8::StaticOrder, GA, GS>(lds, g, S, E); }
    xcd_barrier(xb);
    final_norm(p, wave, lane);
}
}

extern "C" void kernel_launch(void* const* d_in, const int* in_sizes, int n_in, void* d_out, int out_size, void* d_ws, size_t ws_size, hipStream_t stream) {
    static int grid = 0;
    if (grid == 0) {
        if (n_in != 24 || ws_size < mk::WS_END) { fprintf(stderr, "kernel_launch: unexpected inputs (n_in %d, ws %zu)\n", n_in, ws_size); grid = -1; return; }
        int dev = 0, cus = 0, per_cu = 0;
        (void)hipGetDevice(&dev); (void)hipDeviceGetAttribute(&cus, hipDeviceAttributeMultiprocessorCount, dev);
        if (hipFuncSetAttribute((const void*)mk::mega, hipFuncAttributeMaxDynamicSharedMemorySize, mk::LDS_BYTES) != hipSuccess) { fprintf(stderr, "kernel_launch: hipFuncSetAttribute failed\n"); }
        if (hipOccupancyMaxActiveBlocksPerMultiprocessor(&per_cu, (const void*)mk::mega, 512, mk::LDS_BYTES) != hipSuccess || per_cu < 1) per_cu = 1;
        (void)hipGetLastError();
        grid = cus * (per_cu > 1 ? 1 : per_cu);
        if (grid <= 0) grid = 256;
    }
    if (grid < 0) return;
    mk::Params p{};
    const float** f = (const float**)&p;
    for (int i = 0; i < 24; ++i) f[i] = (const float*)d_in[i];
    p.out = (float*)d_out; p.ws = (unsigned char*)d_ws;
    (void)hipMemsetAsync((unsigned char*)d_ws + mk::WS_BAR, 0, XCD_BAR_WORDS * sizeof(unsigned), stream);
    void* args[] = {&p};
    hipError_t e = hipLaunchCooperativeKernel((const void*)mk::mega, dim3(grid), dim3(512), args, mk::LDS_BYTES, stream);
    if (e != hipSuccess) fprintf(stderr, "cooperative launch failed: %s (grid %d)\n", hipGetErrorString(e), grid);
}
```

```cpp
#include <hip/hip_runtime.h>
#include <hip/hip_cooperative_groups.h>
#include <cstdio>
#include <cstdint>
namespace cg = cooperative_groups;
namespace pg8 {
#define PG8_LAS __attribute__((address_space(3)))
typedef unsigned short bf16_t;
typedef short bf16x8 __attribute__((ext_vector_type(8)));
typedef float f32x4 __attribute__((ext_vector_type(4)));
typedef unsigned u32x4 __attribute__((ext_vector_type(4)));
constexpr int BM = 256, BK = 64, HALF = 128, HTB = HALF * BK * 2  , STAGE_BYTES = 8 * HTB, NXCD = 8, WGM = 2;

__host__ __device__ __forceinline__ int lds_byte(int r, int c) { const int st = (r >> 4) * 2 + (c >> 5), rr = r & 15, cc = c & 31, ob = rr * 64 + cc * 2; return st * 1024 + (ob ^ (((ob >> 9) & 1) << 5)); }
__host__ __device__ __forceinline__ void stage_rc(int b, int& R, int& C) { const int st = b / 1024, sb = b % 1024, swz = sb ^ (((sb >> 9) & 1) << 5); R = (st >> 1) * 16 + swz / 64; C = (st & 1) * 32 + (swz % 64) / 2; }
__host__ __device__ __forceinline__ int perm32(int rho) { const int n = rho >> 4, i = rho & 15; return 8 * (i >> 2) + 4 * n + (i & 3); }

struct Unit { int pm, pn; };
struct Gemm { const bf16_t* A; const bf16_t* Bt; int M, N, K; };

struct StaticOrder {
    int nM, nN, nwg, G, c;
    __host__ __device__ void init(int M, int N, int G_, int c_) { nM = M / BM; nN = N / BM; nwg = nM * nN; G = G_; c = c_; }
    __host__ __device__ bool next(int i, Unit& u) const {
        const long L = (long)i * G + c; if (L >= nwg) return false;
        int wgid = (int)L; { const int q = nwg / NXCD, r = nwg % NXCD, xcd = wgid % NXCD, off = wgid / NXCD; wgid = (xcd < r ? xcd * (q + 1) : r * (q + 1) + (xcd - r) * q) + off; }
        const int nig = WGM * nN, gid = wgid / nig, fm = gid * WGM, gsz = (nM - fm) < WGM ? (nM - fm) : WGM;
        u.pm = fm + ((wgid % nig) % gsz); u.pn = (wgid % nig) / gsz; return true;
    }
    __device__ __forceinline__ void a_ready(const Unit&) const {}
    __device__ __forceinline__ void done(const Unit&) const {}
};
typedef float f32x2 __attribute__((ext_vector_type(2)));
typedef __bf16 bf16x2v __attribute__((ext_vector_type(2)));
__device__ __forceinline__ unsigned cvt_pk_bf16(float lo, float hi) { const f32x2 v = {lo, hi}; const bf16x2v b = __builtin_convertvector(v, bf16x2v); return __builtin_bit_cast(unsigned, b); }
template <class Epi, class Sched, bool ALIGN_EPI = false, bool SP2 = false>
__device__ __forceinline__ void gemm_phase(PG8_LAS unsigned char* lds, const Gemm g, const Sched& S, const Epi& E) {
    const int tid = threadIdx.x, wid = __builtin_amdgcn_readfirstlane(tid >> 6), lane = tid & 63, wr = wid >> 2, wc = wid & 3, fr = lane & 15, fq = lane >> 4;
    const int K = g.K, nt = K / BK;
    unsigned voffA[2], voffB[2];
#pragma unroll
    for (int i = 0; i < 2; ++i) { int R, C; stage_rc(tid * 16 + i * 8192, R, C); const int Rb = Epi::PERM ? ((R & ~31) + perm32(R & 31)) : R;
        voffA[i] = (unsigned)(R * K + C) * 2u; voffB[i] = (unsigned)(Rb * K + C) * 2u; }
    const size_t kstep = (size_t)(BK * 2);
    const size_t hstep = (size_t)HALF * K * 2;
    const size_t tstep = 2 * hstep;
    const unsigned ldsw = (unsigned)wid * 1024u;
    const int aoff = lds_byte(wr * 64 + fr, fq * 8), boff = lds_byte(wc * 32 + fr, fq * 8);
#define PG8_SA(b, h) (((b) * 2 + (h)) * HTB)
#define PG8_SB(b, h) ((4 + (b) * 2 + (h)) * HTB)
#define PG8_STAGE(bufoff, gbase, voff) do { _Pragma("unroll") for (int _i = 0; _i < 2; ++_i) \
        __builtin_amdgcn_global_load_lds((const unsigned*)((const char*)(gbase) + (voff)[_i]), (PG8_LAS unsigned*)(lds + (bufoff) + ldsw + _i * 8192), 16, 0, 0); } while (0)
#define PG8_LDA(dst, b, h) do { _Pragma("unroll") for (int m = 0; m < 4; ++m) _Pragma("unroll") for (int k = 0; k < 2; ++k) dst[m][k] = *(const PG8_LAS bf16x8*)(lds + PG8_SA(b, h) + aoff + m * 2048 + k * 1024); } while (0)
#define PG8_LDB(dst, b, h) do { _Pragma("unroll") for (int n = 0; n < 2; ++n) _Pragma("unroll") for (int k = 0; k < 2; ++k) dst[n][k] = *(const PG8_LAS bf16x8*)(lds + PG8_SB(b, h) + boff + n * 2048 + k * 1024); } while (0)
#define PG8_MMA(ai, bj, At, Bt) do { __builtin_amdgcn_s_setprio(1); _Pragma("unroll") for (int m = 0; m < 4; ++m) _Pragma("unroll") for (int n = 0; n < 2; ++n) _Pragma("unroll") for (int k = 0; k < 2; ++k) \
        acc[ai][bj][m][n] = __builtin_amdgcn_mfma_f32_16x16x32_bf16(Bt[n][k], At[m][k], acc[ai][bj][m][n], 0, 0, 0); __builtin_amdgcn_s_setprio(0); } while (0)
#define PG8_WAIT_V(n) asm volatile("s_waitcnt vmcnt(" #n ")" ::: "memory")
#define PG8_WAIT_L(n) asm volatile("s_waitcnt lgkmcnt(" #n ")" ::: "memory")
#define PG8_BAR __builtin_amdgcn_s_barrier()
#define PG8_SCHED __builtin_amdgcn_sched_barrier(0)
    Unit cur, nxt; int ui = 0;
    if (!S.next(0, cur)) return;
    f32x4 acc[2][2][4][2];
#pragma unroll
    for (int a = 0; a < 2; ++a)
#pragma unroll
        for (int b = 0; b < 2; ++b)
#pragma unroll
            for (int m = 0; m < 4; ++m)
#pragma unroll
                for (int n = 0; n < 2; ++n) acc[a][b][m][n] = (f32x4){0.f, 0.f, 0.f, 0.f};
    bf16x8 At[4][2], B0[2][2], B1[2][2];
    const char* cA = (const char*)g.A + (size_t)cur.pm * tstep; const char* cB = (const char*)g.Bt + (size_t)cur.pn * tstep;
    S.a_ready(cur);
    if constexpr (SP2) {
        PG8_STAGE(PG8_SB(0, 0), cB, voffB); PG8_STAGE(PG8_SB(0, 1), cB + hstep, voffB); PG8_STAGE(PG8_SA(0, 0), cA, voffA); PG8_STAGE(PG8_SA(0, 1), cA + hstep, voffA);
        if (wr == 1) PG8_BAR;
        PG8_WAIT_V(2); PG8_BAR;
        PG8_STAGE(PG8_SB(1, 0), cB + kstep, voffB); PG8_STAGE(PG8_SA(1, 0), cA + kstep, voffA); PG8_STAGE(PG8_SB(1, 1), cB + hstep + kstep, voffB);
        PG8_WAIT_V(6); PG8_BAR;
    } else {
        PG8_STAGE(PG8_SB(0, 0), cB, voffB); PG8_STAGE(PG8_SA(0, 0), cA, voffA); PG8_STAGE(PG8_SB(0, 1), cB + hstep, voffB); PG8_STAGE(PG8_SA(0, 1), cA + hstep, voffA);
        if (wr == 1) PG8_BAR;
        PG8_WAIT_V(4); PG8_BAR;
        PG8_STAGE(PG8_SB(1, 0), cB + kstep, voffB); PG8_STAGE(PG8_SA(1, 0), cA + kstep, voffA); PG8_STAGE(PG8_SB(1, 1), cB + hstep + kstep, voffB);
        PG8_WAIT_V(6); PG8_BAR;
    }
    for (;;) {
        const bool has_next = S.next(ui + 1, nxt);
        const char* nA = has_next ? (const char*)g.A + (size_t)nxt.pm * tstep : cA; const char* nB = has_next ? (const char*)g.Bt + (size_t)nxt.pn * tstep : cB;
        for (int t = 0; t < nt; t += 2) {
            const bool last = (t == nt - 2);
            const char* a1 = cA + (size_t)(t + 1) * kstep;
            const char* a2 = last ? nA : cA + (size_t)(t + 2) * kstep; const char* b2 = last ? nB : cB + (size_t)(t + 2) * kstep;
            const char* a3 = a2 + kstep; const char* b3 = b2 + kstep;
            if (last && has_next) S.a_ready(nxt);
            if constexpr (SP2) {
            PG8_LDB(B0, 0, 0); PG8_LDB(B1, 0, 1); PG8_SCHED; PG8_LDA(At, 0, 0); PG8_STAGE(PG8_SA(1, 1), a1 + hstep, voffA);
            PG8_WAIT_V(8); PG8_WAIT_L(0); PG8_BAR; PG8_MMA(0, 0, At, B0); PG8_MMA(0, 1, At, B1); PG8_BAR; PG8_SCHED;
            PG8_LDA(At, 0, 1); PG8_STAGE(PG8_SB(0, 0), b2, voffB); PG8_STAGE(PG8_SB(0, 1), b2 + hstep, voffB); PG8_STAGE(PG8_SA(0, 0), a2, voffA);
            PG8_WAIT_V(8); PG8_WAIT_L(0); PG8_BAR; PG8_MMA(1, 0, At, B0); PG8_MMA(1, 1, At, B1); PG8_BAR; PG8_SCHED;
            PG8_LDB(B0, 1, 0); PG8_LDB(B1, 1, 1); PG8_SCHED; PG8_LDA(At, 1, 0); PG8_STAGE(PG8_SA(0, 1), a2 + hstep, voffA);
            PG8_WAIT_V(8); PG8_WAIT_L(0); PG8_BAR; PG8_MMA(0, 0, At, B0); PG8_MMA(0, 1, At, B1); PG8_BAR; PG8_SCHED;
            PG8_LDA(At, 1, 1); PG8_STAGE(PG8_SB(1, 0), b3, voffB); PG8_STAGE(PG8_SB(1, 1), b3 + hstep, voffB); PG8_STAGE(PG8_SA(1, 0), a3, voffA);
            PG8_WAIT_V(8); PG8_WAIT_L(0); PG8_BAR; PG8_MMA(1, 0, At, B0); PG8_MMA(1, 1, At, B1); PG8_BAR; PG8_SCHED;
            } else {
            PG8_LDB(B0, 0, 0); PG8_SCHED; PG8_LDA(At, 0, 0); PG8_STAGE(PG8_SA(1, 1), a1 + hstep, voffA);
            PG8_WAIT_L(8); PG8_BAR; PG8_WAIT_L(0); PG8_MMA(0, 0, At, B0); PG8_BAR; PG8_SCHED;
            PG8_LDB(B1, 0, 1); PG8_STAGE(PG8_SB(0, 0), b2, voffB);
            PG8_BAR; PG8_WAIT_L(0); PG8_MMA(0, 1, At, B1); PG8_BAR;
            PG8_LDA(At, 0, 1); PG8_STAGE(PG8_SA(0, 0), a2, voffA);
            PG8_BAR; PG8_WAIT_L(0); PG8_MMA(1, 0, At, B0); PG8_BAR; PG8_SCHED;
            PG8_STAGE(PG8_SB(0, 1), b2 + hstep, voffB);
            PG8_WAIT_V(6); PG8_BAR; PG8_MMA(1, 1, At, B1); PG8_BAR;
            PG8_LDB(B0, 1, 0); PG8_SCHED; PG8_LDA(At, 1, 0); PG8_STAGE(PG8_SA(0, 1), a2 + hstep, voffA);
            PG8_WAIT_L(8); PG8_BAR; PG8_WAIT_L(0); PG8_MMA(0, 0, At, B0); PG8_BAR; PG8_SCHED;
            PG8_LDB(B1, 1, 1); PG8_STAGE(PG8_SB(1, 0), b3, voffB);
            PG8_BAR; PG8_WAIT_L(0); PG8_MMA(0, 1, At, B1); PG8_BAR;
            PG8_LDA(At, 1, 1); PG8_STAGE(PG8_SA(1, 0), a3, voffA);
            PG8_BAR; PG8_WAIT_L(0); PG8_MMA(1, 0, At, B0); PG8_BAR; PG8_SCHED;
            PG8_STAGE(PG8_SB(1, 1), b3 + hstep, voffB);
            PG8_WAIT_V(6); PG8_BAR; PG8_MMA(1, 1, At, B1); PG8_BAR;
            }
        }
        if constexpr (ALIGN_EPI) { if (wr == 0) PG8_BAR; }
        bool keep_acc = false;
        if constexpr (Epi::CHAIN) { keep_acc = E.chain(acc, cur, wr, wc, fr, fq); S.done(cur); }
        else if constexpr (!Epi::AFTER_DRAIN) { E(acc, cur, wr, wc, fr, fq); S.done(cur); }
        if (!has_next) break;
        if (!keep_acc)
#pragma unroll
        for (int a = 0; a < 2; ++a)
#pragma unroll
            for (int b = 0; b < 2; ++b)
#pragma unroll
                for (int m = 0; m < 4; ++m)
#pragma unroll
                    for (int n = 0; n < 2; ++n) acc[a][b][m][n] = (f32x4){0.f, 0.f, 0.f, 0.f};
        cur = nxt; cA = nA; cB = nB; ++ui;
        if constexpr (ALIGN_EPI) { if (wr == 1) PG8_BAR; }
    }
    PG8_WAIT_V(0);
    if constexpr (!ALIGN_EPI) { if (wr == 0) PG8_BAR; }
    PG8_BAR;
    if constexpr (Epi::AFTER_DRAIN) { E.fused(acc, cur, wr, wc, fr, fq, lds, wid, lane); S.done(cur); }
#undef PG8_SA
#undef PG8_SB
#undef PG8_STAGE
#undef PG8_LDA
#undef PG8_LDB
#undef PG8_MMA
#undef PG8_WAIT_V
#undef PG8_WAIT_L
#undef PG8_BAR
#undef PG8_SCHED
}
}

namespace mk {
using pg8::bf16_t; using pg8::bf16x8; using pg8::f32x4; using pg8::u32x4; using pg8::Unit; using pg8::cvt_pk_bf16; using pg8::f32x2;
typedef unsigned u32x2 __attribute__((ext_vector_type(2)));
#define LAS __attribute__((address_space(3)))
#define LDS_WAIT() asm volatile("s_waitcnt lgkmcnt(0)" ::: "memory")

constexpr int D = 2048, NB = 8, SEQ = 2048, CTXL = 256;
constexpr int MLAT = NB * SEQ, MCTX = NB * CTXL, MTOT = MLAT + MCTX;
constexpr int NCOLS = 13568, SHC = 3328;
constexpr size_t MiB = (size_t)1 << 20;
constexpr size_t WS_MOD = 0, WS_LB = 256 * 1024, WS_W2T = 512 * 1024, WS_RN = 1 * MiB, WS_BONUS = 2 * MiB + 256 * 1024;
constexpr size_t WS_PQ = 4 * MiB, WS_PI = 40 * MiB, WS_PGF = 76 * MiB, WS_PGB = 112 * MiB, WS_PZ = 148 * MiB, WS_PRW = 184 * MiB, WS_PZRW = 301 * MiB;
constexpr size_t WS_E0 = 337 * MiB, WS_E1 = 373 * MiB, WS_A0 = 409 * MiB, WS_A1 = 445 * MiB;
constexpr size_t WS_WTO1 = 481 * MiB, WS_WTO2 = 489 * MiB;
constexpr size_t WS_YHG = 4 * MiB, WS_YRW = 36 * MiB, WS_H2 = 68 * MiB, WS_WTG = 132 * MiB;
constexpr size_t WS_PGATE = 337 * MiB;
constexpr size_t WS_T1 = 184 * MiB, WS_MERGED = 248 * MiB;
constexpr size_t WS_BAR = 500 * MiB;
constexpr size_t WS_END = 501 * MiB;
constexpr int YRW_PM_OFF = 64;
static_assert((WS_YRW - WS_YHG) == (size_t)YRW_PM_OFF * 256 * 1024 * 2, "y_hg / y_rw spacing");
constexpr int NC1 = 9472;
constexpr size_t DO_H = 0, DO_WTIN = 72 * MiB, DO_O = 0, DO_Y = 64 * MiB;
constexpr int LDS_BYTES = 147456, RW_LDS = 49152;

struct Params {
    const float *x, *c, *ctx, *c_ctx, *ada_w, *ada_b, *norm_g, *w_in, *hg_lb, *hg_norm_g, *rw_mu, *rw_w0, *rw_w2, *rw_a0, *rw_a2, *rw_kk, *rw_ka, *rw_rk, *rw_gn_g, *rw_gn_b,
        *w_hg_out, *w_rw_out, *w_out, *final_g;
    float* out; unsigned char* ws;
};

__device__ __forceinline__ float bflo(unsigned u) { return __uint_as_float(u << 16); }
__device__ __forceinline__ float bfhi(unsigned u) { return __uint_as_float(u & 0xffff0000u); }
__device__ __forceinline__ float bf2f(bf16_t u) { return __uint_as_float(((unsigned)u) << 16); }
__device__ __forceinline__ bf16_t f2bf(float f) { return (bf16_t)(cvt_pk_bf16(f, 0.f) & 0xffffu); }
__device__ __forceinline__ float sigm(float x) { return __builtin_amdgcn_rcpf(1.f + __expf(-x)); }
__device__ __forceinline__ float silu(float x) { return x * sigm(x); }
__device__ __forceinline__ float tanh_(float x) { return 1.f - 2.f * __builtin_amdgcn_rcpf(1.f + __expf(2.f * x)); }
__device__ __forceinline__ float wave_sum(float v) {
#pragma unroll
    for (int o = 1; o < 64; o <<= 1) v += __shfl_xor(v, o);
    return v;
}
template <int CTRL> __device__ __forceinline__ float dpp(float x) { return __int_as_float(__builtin_amdgcn_update_dpp(0, __float_as_int(x), CTRL, 0xf, 0xf, true)); }
__device__ __forceinline__ f32x4 mfma16(bf16x8 a, bf16x8 b, f32x4 c) { return __builtin_amdgcn_mfma_f32_16x16x32_bf16(a, b, c, 0, 0, 0); }

template <int W> __device__ __forceinline__ void ldbf(const bf16_t* p, float (&o)[W]) {
    if constexpr (W == 2) { const unsigned u = *(const unsigned*)p; o[0] = bflo(u); o[1] = bfhi(u); }
    else if constexpr (W == 4) { const u32x2 u = *(const u32x2*)p; o[0] = bflo(u.x); o[1] = bfhi(u.x); o[2] = bflo(u.y); o[3] = bfhi(u.y); }
    else {
#pragma unroll
        for (int i = 0; i < W / 8; ++i) { const u32x4 u = *(const u32x4*)(p + 8 * i);
            o[8 * i + 0] = bflo(u.x); o[8 * i + 1] = bfhi(u.x); o[8 * i + 2] = bflo(u.y); o[8 * i + 3] = bfhi(u.y);
            o[8 * i + 4] = bflo(u.z); o[8 * i + 5] = bfhi(u.z); o[8 * i + 6] = bflo(u.w); o[8 * i + 7] = bfhi(u.w); }
    }
}
template <int W> __device__ __forceinline__ void ldf(const float* p, float (&o)[W]) {
    if constexpr (W == 2) { const f32x2 u = *(const f32x2*)p; o[0] = u.x; o[1] = u.y; }
    else {
#pragma unroll
        for (int i = 0; i < W / 4; ++i) { const f32x4 u = *(const f32x4*)(p + 4 * i); o[4 * i] = u.x; o[4 * i + 1] = u.y; o[4 * i + 2] = u.z; o[4 * i + 3] = u.w; }
    }
}
template <int W> __device__ __forceinline__ void stbf(bf16_t* p, const float (&v)[W]) {
    if constexpr (W == 4) { u32x2 u; u.x = cvt_pk_bf16(v[0], v[1]); u.y = cvt_pk_bf16(v[2], v[3]); *(u32x2*)p = u; }
    else {
#pragma unroll
        for (int i = 0; i < W / 8; ++i) { u32x4 u; u.x = cvt_pk_bf16(v[8 * i], v[8 * i + 1]); u.y = cvt_pk_bf16(v[8 * i + 2], v[8 * i + 3]); u.z = cvt_pk_bf16(v[8 * i + 4], v[8 * i + 5]); u.w = cvt_pk_bf16(v[8 * i + 6], v[8 * i + 7]); *(u32x4*)(p + 8 * i) = u; }
    }
}

struct Nbr { int L, R, U, Dn; bool vert; };
__device__ __forceinline__ Nbr nbr_of(int R) {
    Nbr n;
    if (R < MLAT) { const int t = R & (SEQ - 1), col = t & 63; n.L = col > 0 ? R - 1 : -1; n.R = col < 63 ? R + 1 : -1; n.U = t >= 64 ? R - 64 : -1; n.Dn = t < SEQ - 64 ? R + 64 : -1; n.vert = true; }
    else { const int t = (R - MLAT) & (CTXL - 1); n.L = t > 0 ? R - 1 : -1; n.R = t < CTXL - 1 ? R + 1 : -1; n.U = -1; n.Dn = -1; n.vert = false; }
    return n;
}
template <int W> __device__ __forceinline__ void shifted(const bf16_t* Prw, int R, const Nbr& nb, int col, const float* mu, float (&o)[W]) {
    float p[W], t[W], m[W];
    ldbf<W>(Prw + (size_t)R * SHC + col, p);
#pragma unroll
    for (int i = 0; i < W; ++i) o[i] = p[i];
    ldf<W>(mu + col, m);
    if (nb.L >= 0) ldbf<W>(Prw + (size_t)nb.L * SHC + col, t); else {
#pragma unroll
        for (int i = 0; i < W; ++i) t[i] = 0.f; }
#pragma unroll
    for (int i = 0; i < W; ++i) o[i] += m[i] * (t[i] - p[i]);
    ldf<W>(mu + SHC + col, m);
    if (nb.R >= 0) ldbf<W>(Prw + (size_t)nb.R * SHC + col, t); else {
#pragma unroll
        for (int i = 0; i < W; ++i) t[i] = 0.f; }
#pragma unroll
    for (int i = 0; i < W; ++i) o[i] += m[i] * (t[i] - p[i]);
    if (nb.vert) {
        ldf<W>(mu + 2 * SHC + col, m);
        if (nb.U >= 0) ldbf<W>(Prw + (size_t)nb.U * SHC + col, t); else {
#pragma unroll
            for (int i = 0; i < W; ++i) t[i] = 0.f; }
#pragma unroll
        for (int i = 0; i < W; ++i) o[i] += m[i] * (t[i] - p[i]);
        ldf<W>(mu + 3 * SHC + col, m);
        if (nb.Dn >= 0) ldbf<W>(Prw + (size_t)nb.Dn * SHC + col, t); else {
#pragma unroll
            for (int i = 0; i < W; ++i) t[i] = 0.f; }
#pragma unroll
        for (int i = 0; i < W; ++i) o[i] += m[i] * (t[i] - p[i]);
    }
}

__device__ __forceinline__ void shifted4m(const bf16_t* Prw, int R, const Nbr& nb, int col, const f32x4 (&mu4)[4], float (&o)[4]) {
    float p[4], t[4];
    ldbf<4>(Prw + (size_t)R * SHC + col, p);
#pragma unroll
    for (int i = 0; i < 4; ++i) o[i] = p[i];
#pragma unroll
    for (int d = 0; d < 4; ++d) {
        if (d >= 2 && !nb.vert) break;
        const int nr = d == 0 ? nb.L : (d == 1 ? nb.R : (d == 2 ? nb.U : nb.Dn));
        if (nr >= 0) ldbf<4>(Prw + (size_t)nr * SHC + col, t); else {
#pragma unroll
            for (int i = 0; i < 4; ++i) t[i] = 0.f; }
#pragma unroll
        for (int i = 0; i < 4; ++i) o[i] += mu4[d][i] * (t[i] - p[i]);
    }
}

__device__ __forceinline__ void transpose_item(const float* W, int K, int ldw, int N, bf16_t* WT, LAS float* scr, int item, int lane) {
    const int nblk = N / 32, kb = item / nblk, nb = item % nblk, k0 = 64 * kb, n0 = 32 * nb;
#pragma unroll 8
    for (int i = 0; i < 32; ++i) { const int kk = 2 * i + (lane >> 5); scr[kk * 33 + (lane & 31)] = W[(size_t)(k0 + kk) * ldw + n0 + (lane & 31)]; }
    LDS_WAIT();
    const int c = lane & 7;
#pragma unroll
    for (int j = 0; j < 4; ++j) { const int n = (lane >> 3) + 8 * j; const LAS float* s = scr + (8 * c) * 33 + n;
        u32x4 o; o.x = cvt_pk_bf16(s[0 * 33], s[1 * 33]); o.y = cvt_pk_bf16(s[2 * 33], s[3 * 33]); o.z = cvt_pk_bf16(s[4 * 33], s[5 * 33]); o.w = cvt_pk_bf16(s[6 * 33], s[7 * 33]);
        *(u32x4*)(WT + (size_t)(n0 + n) * K + k0 + 8 * c) = o; }
    LDS_WAIT();
}

__device__ __forceinline__ void phase0(const Params& p, LAS unsigned char* lds, int tid, int wave, int lane) {
    float* mod = (float*)(p.ws + WS_MOD);
    LAS float* sc = (LAS float*)lds;
    for (int i = tid; i < 9 * D; i += 512) { const int r = i >> 11, k = i & (D - 1); const float v = r < 8 ? p.c[r * D + k] : p.c_ctx[k]; sc[i] = silu(v); }
    __syncthreads();
    for (int cb = blockIdx.x; cb < 256; cb += gridDim.x) {
        if (wave < 6) {
            const int n0 = cb * 24 + wave * 4;
            float acc[9][4];
#pragma unroll
            for (int r = 0; r < 9; ++r)
#pragma unroll
                for (int j = 0; j < 4; ++j) acc[r][j] = 0.f;
            for (int i = 0; i < 32; ++i) { const int k = lane + 64 * i; const f32x4 w = *(const f32x4*)(p.ada_w + (size_t)k * (3 * D) + n0);
#pragma unroll
                for (int r = 0; r < 9; ++r) { const float s = sc[r * D + k]; acc[r][0] += s * w.x; acc[r][1] += s * w.y; acc[r][2] += s * w.z; acc[r][3] += s * w.w; } }
#pragma unroll
            for (int r = 0; r < 9; ++r)
#pragma unroll
                for (int j = 0; j < 4; ++j) { const float v = wave_sum(acc[r][j]); if (lane == 0) mod[r * (3 * D) + n0 + j] = v + p.ada_b[n0 + j]; }
        }
    }
    __syncthreads();
    LAS float* scr = (LAS float*)(lds + wave * 8448);
    const int gw = blockIdx.x * 8 + wave, NGW = gridDim.x * 8;
    bf16_t* wt_in = (bf16_t*)((unsigned char*)p.out + DO_WTIN);
    constexpr int I_IN = (D / 64) * (NC1 / 32);
    for (int it = gw; it < I_IN; it += NGW) transpose_item(p.w_in, D, NCOLS, NC1, wt_in, scr, it, lane);
    bf16_t* w2t = (bf16_t*)(p.ws + WS_W2T);
    const int gt = blockIdx.x * 512 + tid, NGT = gridDim.x * 512;
    for (int i = gt; i < 4 * 1024 * 8; i += NGT) { const int mat = i >> 13, n = (i >> 3) & 1023, k8 = i & 7;
        const float* src = (mat < 2 ? p.rw_w2 + (size_t)mat * 64 * 1024 : p.rw_a2 + (size_t)(mat - 2) * 64 * 1024) + n;
        float v[8];
#pragma unroll
        for (int j = 0; j < 8; ++j) v[j] = src[(size_t)(k8 * 8 + j) * 1024];
        stbf<8>(w2t + ((size_t)mat * 1024 + n) * 64 + k8 * 8, v); }
    float* lb = (float*)(p.ws + WS_LB);
    for (int i = gt; i < 2048; i += NGT) { const int d = i >> 10, j = i & 1023; const float a = p.hg_lb[(d * 2 + 0) * 1024 + j], b = p.hg_lb[(d * 2 + 1) * 1024 + j]; lb[i] = 1.f / (1.f + __expf(b - a)); }
}

__device__ __forceinline__ void phase1(const Params& p, bf16_t* H, int nrows, int wave, int lane) {
    const float* mod = (const float*)(p.ws + WS_MOD);
    const int gw = blockIdx.x * 8 + wave, NGW = gridDim.x * 8;
    for (int row = gw; row < nrows; row += NGW) {
        const float* xr = row < MLAT ? p.x + (size_t)row * D : p.ctx + (size_t)(row - MLAT) * D;
        const int mr = row < MLAT ? (row >> 11) : 8;
        const float* shift = mod + mr * (3 * D); const float* scale = shift + D;
        f32x4 v[8]; float ss = 0.f;
#pragma unroll
        for (int j = 0; j < 8; ++j) { v[j] = ((const f32x4*)xr)[lane + 64 * j]; ss += (v[j].x * v[j].x + v[j].y * v[j].y) + (v[j].z * v[j].z + v[j].w * v[j].w); }
        ss = wave_sum(ss);
        const float rstd = rsqrtf(ss * (1.f / D) + 1e-6f);
#pragma unroll
        for (int j = 0; j < 8; ++j) { const int c = 4 * (lane + 64 * j);
            const f32x4 g = *(const f32x4*)(p.norm_g + c), s1 = *(const f32x4*)(scale + c), s0 = *(const f32x4*)(shift + c);
            float o[4]; o[0] = v[j].x * rstd * g.x * (1.f + s1.x) + s0.x; o[1] = v[j].y * rstd * g.y * (1.f + s1.y) + s0.y; o[2] = v[j].z * rstd * g.z * (1.f + s1.z) + s0.z; o[3] = v[j].w * rstd * g.w * (1.f + s1.w) + s0.w;
            stbf<4>(H + (size_t)row * D + c, o); }
    }
}

struct EpiProj {
    static constexpr bool PERM = true, AFTER_DRAIN = false, CHAIN = false;
    unsigned char* ws;
    template <int ACT> __device__ __forceinline__ void run(const f32x4 (&acc)[2][2][4][2], bf16_t* base, int ld, int row0, int col0, const float* lb) const {
        float lbv[2][8];
        if constexpr (ACT == 3) {
#pragma unroll
            for (int bj = 0; bj < 2; ++bj) ldf<8>(lb + col0 + bj * 128, lbv[bj]); }
#pragma unroll
        for (int ai = 0; ai < 2; ++ai)
#pragma unroll
            for (int m = 0; m < 4; ++m) { bf16_t* rowp = base + (size_t)(row0 + ai * 128 + m * 16) * ld + col0;
#pragma unroll
                for (int bj = 0; bj < 2; ++bj) { float v[8];
#pragma unroll
                    for (int i = 0; i < 4; ++i) { v[i] = acc[ai][bj][m][0][i]; v[4 + i] = acc[ai][bj][m][1][i]; }
#pragma unroll
                    for (int i = 0; i < 8; ++i) {
                        if constexpr (ACT == 1) v[i] = silu(v[i]);
                        if constexpr (ACT == 2) v[i] = sigm(v[i]);
                        if constexpr (ACT == 3) v[i] = __logf(lbv[bj][i] + (1.f - lbv[bj][i]) * sigm(v[i])); }
                    stbf<8>(rowp + bj * 128, v); } }
    }
    __device__ __forceinline__ void operator()(const f32x4 (&acc)[2][2][4][2], const Unit& u, int wr, int wc, int fr, int fq) const {
        const int pn = u.pn; const int row0 = u.pm * 256 + wr * 64 + fr, cw = wc * 32 + 8 * fq;
        const float* lb = (const float*)(ws + WS_LB);
        if (pn < 4) run<1>(acc, (bf16_t*)(ws + WS_PQ), 1024, row0, pn * 256 + cw, lb);
        else if (pn < 8) run<0>(acc, (bf16_t*)(ws + WS_PI), 1024, row0, (pn - 4) * 256 + cw, lb);
        else if (pn < 12) run<3>(acc, (bf16_t*)(ws + WS_PGF), 1024, row0, (pn - 8) * 256 + cw, lb);
        else if (pn < 16) run<3>(acc, (bf16_t*)(ws + WS_PGB), 1024, row0, (pn - 12) * 256 + cw, lb + 1024);
        else if (pn < 20) run<1>(acc, (bf16_t*)(ws + WS_PZ), 1024, row0, (pn - 16) * 256 + cw, lb);
        else if (pn < 33) run<0>(acc, (bf16_t*)(ws + WS_PRW), SHC, row0, (pn - 20) * 256 + cw, lb);
        else run<1>(acc, (bf16_t*)(ws + WS_PZRW), 1024, row0, (pn - 33) * 256 + cw, lb);
    }
};

struct InOrder {
    int G, c;
    __device__ bool next(int i, Unit& u) const {
        const int L = i * G + c;
        if (L < 2368) { pg8::StaticOrder so; so.init(MLAT, NC1, G, c); return so.next(i, u); }
        if (L >= 2368 + 168) return false;
        const int idx = L - 2368, j = idx % 21; u.pm = 64 + idx / 21; u.pn = j < 12 ? 4 + j : 12 + j; return true;
    }
    __device__ __forceinline__ void a_ready(const Unit&) const {}
    __device__ __forceinline__ void done(const Unit&) const {}
};
struct EpiGate {
    static constexpr bool PERM = true, AFTER_DRAIN = false, CHAIN = false;
    unsigned char* ws;
    __device__ __forceinline__ void operator()(const f32x4 (&acc)[2][2][4][2], const Unit& u, int wr, int wc, int fr, int fq) const {
        EpiProj e{ws};
        e.run<2>(acc, (bf16_t*)(ws + WS_PGATE), 4096, u.pm * 256 + wr * 64 + fr, u.pn * 256 + wc * 32 + 8 * fq, nullptr);
    }
};

__device__ __forceinline__ void hg_scan(const Params& p, LAS unsigned char* lds, int tid, int wave, int lane) {
    LAS bf16_t* qd = (LAS bf16_t*)(lds);
    LAS bf16_t* kd = (LAS bf16_t*)(lds + 17408);
    LAS bf16_t* kdT = (LAS bf16_t*)(lds + 34816);
    LAS bf16_t* vT = (LAS bf16_t*)(lds + 53248);
    LAS bf16_t* ST = (LAS bf16_t*)(lds + 62464);
    LAS bf16_t* at = (LAS bf16_t*)(lds + 79872);
    LAS float* tot = (LAS float*)(lds + 89088);
    const bf16_t* Pq = (const bf16_t*)(p.ws + WS_PQ); const bf16_t* Pi = (const bf16_t*)(p.ws + WS_PI);
    bf16_t* Obase = (bf16_t*)((unsigned char*)p.out + DO_O);
    const int l15 = lane & 15, fq = lane >> 4;
    for (int u = blockIdx.x; u < 256; u += gridDim.x) {
        const int b = u >> 5, h = (u >> 2) & 7, dir = (u >> 1) & 1, vh = u & 1;
        const bf16_t* Pg = (const bf16_t*)(p.ws + (dir ? WS_PGB : WS_PGF));
        bf16_t* O = Obase + (size_t)dir * MLAT * 1024;
        const int k0 = 2 * lane, e8 = wave, vs = tid >> 3, vn8 = tid & 7;
        const int sgn = dir ? -1 : 1;
        auto rbase = [&](int c) -> long { if (c < 4) return MLAT + b * CTXL + (dir ? (CTXL - 1 - c * 64) : c * 64); const int t0 = (c - 4) * 64; return b * SEQ + (dir ? (SEQ - 1 - t0) : t0); };
        const long rstep = (long)sgn * 1024;
        f32x4 S[4];
#pragma unroll
        for (int i = 0; i < 4; ++i) S[i] = (f32x4){0.f, 0.f, 0.f, 0.f};
        unsigned gN[8], qN[8]; u32x4 vN;
        { const long rb = rbase(0); const bf16_t* gp = Pg + (rb + sgn * (e8 * 8)) * 1024 + h * 128 + k0; const bf16_t* qp_ = Pq + (rb + sgn * (e8 * 8)) * 1024 + h * 128 + k0;
#pragma unroll
          for (int j = 0; j < 8; ++j) { gN[j] = *(const unsigned*)(gp + j * rstep); qN[j] = *(const unsigned*)(qp_ + j * rstep); }
          vN = *(const u32x4*)(Pi + (rb + sgn * vs) * 1024 + h * 128 + vh * 64 + vn8 * 8); }
        for (int c = 0; c < 36; ++c) {
            unsigned g[8], q[8]; const u32x4 vC = vN;
#pragma unroll
            for (int j = 0; j < 8; ++j) { g[j] = gN[j]; q[j] = qN[j]; }
            if (c + 1 < 36) {
                const long rb1 = rbase(c + 1); const bf16_t* gp = Pg + (rb1 + sgn * (e8 * 8)) * 1024 + h * 128 + k0; const bf16_t* qp_ = Pq + (rb1 + sgn * (e8 * 8)) * 1024 + h * 128 + k0;
#pragma unroll
                for (int j = 0; j < 8; ++j) { gN[j] = *(const unsigned*)(gp + j * rstep); qN[j] = *(const unsigned*)(qp_ + j * rstep); }
                vN = *(const u32x4*)(Pi + (rb1 + sgn * vs) * 1024 + h * 128 + vh * 64 + vn8 * 8);
            }
            float run0 = 0.f, run1 = 0.f;
#pragma unroll
            for (int j = 0; j < 8; ++j) { run0 += bflo(g[j]); run1 += bfhi(g[j]); }
            *(LAS f32x2*)(tot + e8 * 128 + k0) = (f32x2){run0, run1};
            __syncthreads();
            {
                float off0 = 0.f, off1 = 0.f, mid0 = 0.f, mid1 = 0.f;
#pragma unroll
                for (int i = 0; i < 8; ++i) { const f32x2 t = *(const LAS f32x2*)(tot + i * 128 + k0); if (i < e8) { off0 += t.x; off1 += t.y; } if (i < 4) { mid0 += t.x; mid1 += t.y; } }
                unsigned kp0[4], kp1[4]; float bc0 = off0, bc1 = off1;
#pragma unroll
                for (int j = 0; j < 8; j += 2) {
                    float kv0[2], kv1[2];
#pragma unroll
                    for (int e = 0; e < 2; ++e) { const int jj = j + e;
                        bc0 += bflo(g[jj]); bc1 += bfhi(g[jj]);
                        const float E0 = __expf(__builtin_amdgcn_fmed3f(bc0 - mid0, -80.f, 80.f)), E1 = __expf(__builtin_amdgcn_fmed3f(bc1 - mid1, -80.f, 80.f));
                        const float qv0 = bflo(q[jj]) * E0, qv1 = bfhi(q[jj]) * E1;
                        kv0[e] = (1.f - __expf(bflo(g[jj]))) * __builtin_amdgcn_rcpf(E0); kv1[e] = (1.f - __expf(bfhi(g[jj]))) * __builtin_amdgcn_rcpf(E1);
                        const int t = e8 * 8 + jj;
                        *(LAS unsigned*)(qd + t * 136 + k0) = cvt_pk_bf16(qv0, qv1); *(LAS unsigned*)(kd + t * 136 + k0) = cvt_pk_bf16(kv0[e], kv1[e]); }
                    kp0[j >> 1] = cvt_pk_bf16(kv0[0], kv0[1]); kp1[j >> 1] = cvt_pk_bf16(kv1[0], kv1[1]);
                }
                *(LAS u32x4*)(kdT + k0 * 72 + e8 * 8) = (u32x4){kp0[0], kp0[1], kp0[2], kp0[3]};
                *(LAS u32x4*)(kdT + (k0 + 1) * 72 + e8 * 8) = (u32x4){kp1[0], kp1[1], kp1[2], kp1[3]};
                float em[4];
#pragma unroll
                for (int j = 0; j < 4; ++j) { const int kj = 16 * wave + fq * 4 + j; em[j] = __expf((tot[kj] + tot[128 + kj]) + (tot[256 + kj] + tot[384 + kj])); }
#pragma unroll
                for (int nt = 0; nt < 4; ++nt) { u32x2 w; w.x = cvt_pk_bf16(S[nt][0] * em[0], S[nt][1] * em[1]); w.y = cvt_pk_bf16(S[nt][2] * em[2], S[nt][3] * em[3]);
                    *(LAS u32x2*)(ST + (nt * 16 + l15) * 136 + 16 * wave + fq * 4) = w; }
                const unsigned vw[4] = {vC.x, vC.y, vC.z, vC.w};
#pragma unroll
                for (int i = 0; i < 4; ++i) { vT[(vn8 * 8 + 2 * i) * 72 + vs] = (bf16_t)(vw[i] & 0xffffu); vT[(vn8 * 8 + 2 * i + 1) * 72 + vs] = (bf16_t)(vw[i] >> 16); }
            }
            __syncthreads();
            const bool lat = c >= 4;
            if (lat) {
#pragma unroll
                for (int q2 = 0; q2 < 2; ++q2) { const int id = 2 * wave + q2, tt = id >> 2, st = id & 3;
                    f32x4 a = (f32x4){0.f, 0.f, 0.f, 0.f};
                    if (st <= tt) {
#pragma unroll
                        for (int ks = 0; ks < 4; ++ks) { const bf16x8 A = *(const LAS bf16x8*)(kd + (st * 16 + l15) * 136 + ks * 32 + fq * 8); const bf16x8 B = *(const LAS bf16x8*)(qd + (tt * 16 + l15) * 136 + ks * 32 + fq * 8); a = mfma16(A, B, a); } }
                    { const int t = tt * 16 + l15, s0 = st * 16 + fq * 4; u32x2 w; w.x = cvt_pk_bf16(s0 <= t ? a[0] : 0.f, s0 + 1 <= t ? a[1] : 0.f); w.y = cvt_pk_bf16(s0 + 2 <= t ? a[2] : 0.f, s0 + 3 <= t ? a[3] : 0.f);
                      *(LAS u32x2*)(at + t * 72 + s0) = w; } }
            }
            __syncthreads();
            if (lat) {
                const long rb = rbase(c);
#pragma unroll
                for (int q2 = 0; q2 < 2; ++q2) { const int id = 2 * wave + q2, tt = id >> 2, nt = id & 3;
                    f32x4 o = (f32x4){0.f, 0.f, 0.f, 0.f};
#pragma unroll
                    for (int ks = 0; ks < 2; ++ks) { const bf16x8 A = *(const LAS bf16x8*)(vT + (nt * 16 + l15) * 72 + ks * 32 + fq * 8); const bf16x8 B = *(const LAS bf16x8*)(at + (tt * 16 + l15) * 72 + ks * 32 + fq * 8); o = mfma16(A, B, o); }
#pragma unroll
                    for (int ks = 0; ks < 4; ++ks) { const bf16x8 A = *(const LAS bf16x8*)(ST + (nt * 16 + l15) * 136 + ks * 32 + fq * 8); const bf16x8 B = *(const LAS bf16x8*)(qd + (tt * 16 + l15) * 136 + ks * 32 + fq * 8); o = mfma16(A, B, o); }
                    { const long row = rb + sgn * (tt * 16 + l15); u32x2 w; w.x = cvt_pk_bf16(o[0], o[1]); w.y = cvt_pk_bf16(o[2], o[3]);
                      *(u32x2*)(O + row * 1024 + h * 128 + vh * 64 + nt * 16 + fq * 4) = w; } }
            }
            {
                float eb[4], e2[4];
#pragma unroll
                for (int j = 0; j < 4; ++j) { const int kj = 16 * wave + fq * 4 + j; const float m = (tot[kj] + tot[128 + kj]) + (tot[256 + kj] + tot[384 + kj]), bl = m + ((tot[512 + kj] + tot[640 + kj]) + (tot[768 + kj] + tot[896 + kj])); eb[j] = __expf(bl); e2[j] = __expf(bl - m); }
#pragma unroll
                for (int nt = 0; nt < 4; ++nt) { f32x4 tmp = (f32x4){0.f, 0.f, 0.f, 0.f};
#pragma unroll
                    for (int ks = 0; ks < 2; ++ks) { const bf16x8 A = *(const LAS bf16x8*)(kdT + (16 * wave + l15) * 72 + ks * 32 + fq * 8); const bf16x8 B = *(const LAS bf16x8*)(vT + (nt * 16 + l15) * 72 + ks * 32 + fq * 8); tmp = mfma16(A, B, tmp); }
#pragma unroll
                    for (int j = 0; j < 4; ++j) S[nt][j] = eb[j] * S[nt][j] + e2[j] * tmp[j]; }
            }
            __syncthreads();
        }
    }
}

__device__ __forceinline__ void post_hg(const Params& p, int wave, int lane) {
    const bf16_t* O0 = (const bf16_t*)((unsigned char*)p.out + DO_O); const bf16_t* O1 = O0 + (size_t)MLAT * 1024;
    const bf16_t* Pz = (const bf16_t*)(p.ws + WS_PZ); bf16_t* Y = (bf16_t*)(p.ws + WS_YHG);
    const int gw = blockIdx.x * 8 + wave, NGW = gridDim.x * 8, c0 = lane * 16;
    float g[16]; ldf<16>(p.hg_norm_g + c0, g);
    for (int tok = gw; tok < MLAT; tok += NGW) {
        float a[16], bq[16], z[16];
        ldbf<16>(O0 + (size_t)tok * 1024 + c0, a); ldbf<16>(O1 + (size_t)tok * 1024 + c0, bq); ldbf<16>(Pz + (size_t)tok * 1024 + c0, z);
        float ss = 0.f;
#pragma unroll
        for (int i = 0; i < 16; ++i) { a[i] += bq[i]; ss += a[i] * a[i]; }
        ss += __shfl_xor(ss, 1); ss += __shfl_xor(ss, 2); ss += __shfl_xor(ss, 4);
        const float rstd = rsqrtf(ss * (1.f / 128.f) + 1e-6f);
#pragma unroll
        for (int i = 0; i < 16; ++i) a[i] = a[i] * rstd * g[i] * z[i];
        stbf<16>(Y + (size_t)tok * 1024 + c0, a);
    }
}

__device__ __forceinline__ void rw_prep(const Params& p, LAS unsigned char* lds, int wave, int lane) {
    const bf16_t* Prw = (const bf16_t*)(p.ws + WS_PRW); const bf16_t* w2t = (const bf16_t*)(p.ws + WS_W2T);
    bf16_t* E0 = (bf16_t*)(p.ws + WS_E0); bf16_t* E1 = (bf16_t*)(p.ws + WS_E1); bf16_t* A0 = (bf16_t*)(p.ws + WS_A0); bf16_t* A1 = (bf16_t*)(p.ws + WS_A1);
    float* rn = (float*)(p.ws + WS_RN); float* bonus = (float*)(p.ws + WS_BONUS);
    const int l15 = lane & 15, fq = lane >> 4;
    LAS f32x4* cst = (LAS f32x4*)(lds + 8192) + wave * 480;
    for (int idx = lane; idx < 480; idx += 64) { const int nt8 = idx / 60, rem = idx % 60, arr = rem >> 2, fqi = rem & 3, chc = (wave * 2 + (nt8 >> 2)) * 64 + (nt8 & 3) * 16 + fqi * 4;
        const float* sp = arr < 4 ? p.rw_mu + arr * SHC + chc : arr < 8 ? p.rw_mu + (arr - 4) * SHC + 1024 + chc : arr == 8 ? p.rw_w0 + chc : arr == 9 ? p.rw_w0 + 1024 + chc : arr == 10 ? p.rw_a0 + chc : arr == 11 ? p.rw_a0 + 1024 + chc
                        : arr == 12 ? p.rw_kk + chc : arr == 13 ? p.rw_ka + chc : p.rw_rk + chc;
        cst[idx] = *(const f32x4*)sp; }
    for (int tile = blockIdx.x; tile < MTOT / 16; tile += gridDim.x) {
        const int hp = wave, R = tile * 16 + l15;
        const Nbr nb = nbr_of(R);
        { const int mat = wave >> 1, ks = wave & 1; float v[8]; shifted<8>(Prw, R, nb, 3072 + mat * 64 + ks * 32 + fq * 8, p.rw_mu, v);
          if (mat < 2) {
#pragma unroll
              for (int i = 0; i < 8; ++i) v[i] = tanh_(v[i]); }
          u32x4 w; w.x = cvt_pk_bf16(v[0], v[1]); w.y = cvt_pk_bf16(v[2], v[3]); w.z = cvt_pk_bf16(v[4], v[5]); w.w = cvt_pk_bf16(v[6], v[7]);
          *(LAS u32x4*)(lds + (wave * 64 + lane) * 16) = w; }
        __syncthreads();
        bf16x8 Bf[4][2];
#pragma unroll
        for (int mat = 0; mat < 4; ++mat)
#pragma unroll
            for (int ks = 0; ks < 2; ++ks) Bf[mat][ks] = *(const LAS bf16x8*)(lds + ((mat * 2 + ks) * 64 + lane) * 16);
#pragma unroll 1
        for (int hh = 0; hh < 2; ++hh) { const int head = hp * 2 + hh; float skk = 0.f, sb = 0.f;
#pragma unroll 1
            for (int nt = 0; nt < 4; ++nt) { const int n0 = head * 64 + nt * 16, ch = n0 + fq * 4;
                f32x4 acc[4];
#pragma unroll
                for (int mat = 0; mat < 4; ++mat) { acc[mat] = (f32x4){0.f, 0.f, 0.f, 0.f};
#pragma unroll
                    for (int ks = 0; ks < 2; ++ks) { const bf16x8 A = *(const bf16x8*)(w2t + ((size_t)mat * 1024 + n0 + l15) * 64 + ks * 32 + fq * 8); acc[mat] = mfma16(A, Bf[mat][ks], acc[mat]); } }
                const LAS f32x4* cs = cst + (hh * 4 + nt) * 60 + fq;
                const f32x4 mur[4] = {cs[0], cs[4], cs[8], cs[12]}, muk[4] = {cs[16], cs[20], cs[24], cs[28]};
                float rs[4], ks_[4]; shifted4m(Prw, R, nb, ch, mur, rs); shifted4m(Prw, R, nb, 1024 + ch, muk, ks_);
                const f32x4 w00 = cs[32], w01 = cs[36], a00 = cs[40], a01 = cs[44], kkc = cs[48], kac = cs[52], rkc = cs[56];
                float e0[4], e1[4], a0[4], a1[4];
#pragma unroll
                for (int j = 0; j < 4; ++j) { e0[j] = 0.60653066f * sigm(w00[j] + acc[0][j]); e1[j] = 0.60653066f * sigm(w01[j] + acc[1][j]); a0[j] = sigm(a00[j] + acc[2][j]); a1[j] = sigm(a01[j] + acc[3][j]);
                    const float kr = ks_[j] * kkc[j]; skk += kr * kr; sb += rs[j] * ks_[j] * (2.f + (a0[j] + a1[j] - 2.f) * kac[j]) * rkc[j]; }
                stbf<4>(E0 + (size_t)R * 1024 + ch, e0); stbf<4>(E1 + (size_t)R * 1024 + ch, e1); stbf<4>(A0 + (size_t)R * 1024 + ch, a0); stbf<4>(A1 + (size_t)R * 1024 + ch, a1);
            }
            skk += __shfl_xor(skk, 16); skk += __shfl_xor(skk, 32); sb += __shfl_xor(sb, 16); sb += __shfl_xor(sb, 32);
            if (fq == 0) { rn[(size_t)R * 16 + head] = rsqrtf(skk + 1e-12f); if (R < MLAT) bonus[(size_t)R * 16 + head] = sb; }
        }
        __syncthreads();
    }
}

struct RwVec { f32x4 wA, wB, kA, kB, bA, bB, dA, dB, rA, rB; float v; };
template <bool LAT> __device__ __forceinline__ void rw_ldv(const LAS float* bs, int voff, RwVec& V) {
    V.wA = *(const LAS f32x4*)(bs); V.wB = *(const LAS f32x4*)(bs + 4); V.kA = *(const LAS f32x4*)(bs + 64); V.kB = *(const LAS f32x4*)(bs + 68);
    V.bA = *(const LAS f32x4*)(bs + 128); V.bB = *(const LAS f32x4*)(bs + 132); V.dA = *(const LAS f32x4*)(bs + 192); V.dB = *(const LAS f32x4*)(bs + 196);
    if (LAT) { V.rA = *(const LAS f32x4*)(bs + 256); V.rB = *(const LAS f32x4*)(bs + 260); }
    V.v = bs[voff];
}
template <bool LAT> __device__ __forceinline__ void rw_chunk(const LAS float* cb, int voff, int q, f32x2 (&S)[4], float& ylo, float& yhi) {
    RwVec cur, nxt; rw_ldv<LAT>(cb, voff, cur);
#pragma unroll 2
    for (int s = 0; s < 16; ++s) {
        rw_ldv<LAT>(cb + (s < 15 ? s + 1 : 15) * 384, voff, nxt);
        f32x2 d = S[0] * cur.kA.lo; d = S[1] * cur.kA.hi + d; d = S[2] * cur.kB.lo + d; d = S[3] * cur.kB.hi + d;
        float t = d.x + d.y;
        t += dpp<0xB1>(t); t += dpp<0x4E>(t); t += dpp<0x141>(t);
        const f32x2 vv = {cur.v, cur.v}, ns = {-t, -t};
        S[0] = S[0] * cur.wA.lo + (cur.dA.lo * vv + cur.bA.lo * ns); S[1] = S[1] * cur.wA.hi + (cur.dA.hi * vv + cur.bA.hi * ns);
        S[2] = S[2] * cur.wB.lo + (cur.dB.lo * vv + cur.bB.lo * ns); S[3] = S[3] * cur.wB.hi + (cur.dB.hi * vv + cur.bB.hi * ns);
        if (LAT) {
            d = S[0] * cur.rA.lo; d = S[1] * cur.rA.hi + d; d = S[2] * cur.rB.lo + d; d = S[3] * cur.rB.hi + d;
            float y = d.x + d.y;
            y += dpp<0xB1>(y); y += dpp<0x4E>(y); y += dpp<0x141>(y);
            if (s < 8) ylo = (q == (s & 7)) ? y : ylo; else yhi = (q == (s & 7)) ? y : yhi;
        }
        cur = nxt;
    }
}
struct RwRegs { unsigned raw[3][5]; unsigned e, a; float rn; unsigned vmask; };
__device__ __forceinline__ void rw_scan(const Params& p, LAS unsigned char* lds, int tid, int wave, int lane) {
    LAS float* buf = (LAS float*)lds;
    const bf16_t* Prw = (const bf16_t*)(p.ws + WS_PRW); const float* rnp = (const float*)(p.ws + WS_RN);
    bf16_t* Ybase = (bf16_t*)((unsigned char*)p.out + DO_Y);
    for (int u = blockIdx.x; u < 256; u += gridDim.x) {
        const int b = u >> 5, h = (u >> 1) & 15, dir = u & 1;
        const bf16_t* Ed = (const bf16_t*)(p.ws + (dir ? WS_E1 : WS_E0)); const bf16_t* Ad = (const bf16_t*)(p.ws + (dir ? WS_A1 : WS_A0));
        bf16_t* Y = Ybase + (size_t)dir * MLAT * 1024;
        const int ls = tid >> 5, cp = tid & 31, ch = h * 64 + 2 * cp;
        float mu_[3][4][2];
#pragma unroll
        for (int a = 0; a < 3; ++a)
#pragma unroll
            for (int m = 0; m < 4; ++m) { const f32x2 t = *(const f32x2*)(p.rw_mu + m * SHC + a * 1024 + ch); mu_[a][m][0] = t.x; mu_[a][m][1] = t.y; }
        float c0v[3][2], c0h[3][2];
#pragma unroll
        for (int a = 0; a < 3; ++a)
#pragma unroll
            for (int e = 0; e < 2; ++e) { c0h[a][e] = 1.f - (mu_[a][0][e] + mu_[a][1][e]); c0v[a][e] = c0h[a][e] - (mu_[a][2][e] + mu_[a][3][e]); }
        const f32x2 kkc = *(const f32x2*)(p.rw_kk + ch), kac = *(const f32x2*)(p.rw_ka + ch);
        auto rowof = [&](int tau) -> int { if (tau < CTXL) { const int t = dir ? (CTXL - 1 - tau) : tau; return MLAT + b * CTXL + t; } const int t0 = tau - CTXL; const int t = dir ? (SEQ - 1 - t0) : t0; return b * SEQ + t; };
        const char* PrwA[3] = {(const char*)Prw, (const char*)Prw + 2048, (const char*)Prw + 4096};
        const int lsgn = dir ? -ls : ls;
        auto issue = [&](int c, RwRegs& r) { const int R = rowof(c * 16) + lsgn; const bool lat = c >= 16;
            const int t = lat ? (R & (SEQ - 1)) : ((R - MLAT) & (CTXL - 1));
            const bool vL = lat ? (t & 63) > 0 : t > 0, vR = lat ? (t & 63) < 63 : t < CTXL - 1, vU = lat && t >= 64, vD = lat && t < SEQ - 64;
            const unsigned oS = (unsigned)R * (unsigned)(SHC * 2) + (unsigned)(ch * 2);
            const unsigned oL = vL ? oS - SHC * 2 : oS, oR = vR ? oS + SHC * 2 : oS, oU = vU ? oS - 64 * SHC * 2 : oS, oD = vD ? oS + 64 * SHC * 2 : oS;
#pragma unroll
            for (int a = 0; a < 3; ++a) { r.raw[a][0] = *(const unsigned*)(PrwA[a] + oS); r.raw[a][1] = *(const unsigned*)(PrwA[a] + oL); r.raw[a][2] = *(const unsigned*)(PrwA[a] + oR);
                r.raw[a][3] = *(const unsigned*)(PrwA[a] + oU); r.raw[a][4] = *(const unsigned*)(PrwA[a] + oD); }
            r.e = *(const unsigned*)((const char*)Ed + (unsigned)R * 2048u + (unsigned)(ch * 2)); r.a = *(const unsigned*)((const char*)Ad + (unsigned)R * 2048u + (unsigned)(ch * 2)); r.rn = rnp[(unsigned)R * 16u + (unsigned)h];
            r.vmask = (vL ? 1u : 0u) | (vR ? 2u : 0u) | (vU ? 4u : 0u) | (vD ? 8u : 0u); };
        auto stage = [&](int c, const RwRegs& r) { LAS float* bs = buf + ((c & 1) * 16 + ls) * 384 + 2 * cp; const bool vert = c >= 16;
            float sh[3][2];
#pragma unroll
            for (int a = 0; a < 3; ++a) {
                const unsigned rl = (r.vmask & 1u) ? r.raw[a][1] : 0u, rr_ = (r.vmask & 2u) ? r.raw[a][2] : 0u, ru = (r.vmask & 4u) ? r.raw[a][3] : 0u, rd = (r.vmask & 8u) ? r.raw[a][4] : 0u;
#pragma unroll
                for (int e = 0; e < 2; ++e) { const float pv = e ? bfhi(r.raw[a][0]) : bflo(r.raw[a][0]), l = e ? bfhi(rl) : bflo(rl), rr = e ? bfhi(rr_) : bflo(rr_), up = e ? bfhi(ru) : bflo(ru), dn = e ? bfhi(rd) : bflo(rd);
                    const float c0 = vert ? c0v[a][e] : c0h[a][e];
                    sh[a][e] = c0 * pv + mu_[a][0][e] * l + mu_[a][1][e] * rr + mu_[a][2][e] * up + mu_[a][3][e] * dn; } }
            f32x2 w, kk, bb, kd, rr2, vv;
#pragma unroll
            for (int e = 0; e < 2; ++e) { const float ev = e ? bfhi(r.e) : bflo(r.e), av = e ? bfhi(r.a) : bflo(r.a); const float ksh = sh[1][e];
                const float kkv = ksh * kkc[e] * r.rn;
                w[e] = __expf(-ev); kk[e] = kkv; bb[e] = kkv * av; kd[e] = ksh * (1.f + (av - 1.f) * kac[e]); rr2[e] = sh[0][e]; vv[e] = sh[2][e]; }
            *(LAS f32x2*)(bs + 0) = w; *(LAS f32x2*)(bs + 64) = kk; *(LAS f32x2*)(bs + 128) = bb; *(LAS f32x2*)(bs + 192) = kd; *(LAS f32x2*)(bs + 256) = rr2; *(LAS f32x2*)(bs + 320) = vv; };
        const int q = lane & 7, row = wave * 8 + (lane >> 3);
        f32x2 S[4];
#pragma unroll
        for (int i = 0; i < 4; ++i) S[i] = (f32x2){0.f, 0.f};
        RwRegs regs;
        issue(0, regs); stage(0, regs);
        __syncthreads();
        const int voff = 320 - q * 8 + row; const long ysgn = dir ? -1 : 1;
        for (int c = 0; c < 144; ++c) {
            if (c + 1 < 144) issue(c + 1, regs);
            const LAS float* cb = buf + (c & 1) * (16 * 384) + q * 8;
            if (c < 16) { float y0 = 0.f, y1 = 0.f; rw_chunk<false>(cb, voff, q, S, y0, y1); }
            else { float y0 = 0.f, y1 = 0.f; rw_chunk<true>(cb, voff, q, S, y0, y1);
                const long rb = rowof(c * 16);
                bf16_t* yp = Y + (rb + ysgn * q) * 1024 + h * 64 + row;
                yp[0] = f2bf(y0); yp[ysgn * 8 * 1024] = f2bf(y1); }
            if (c + 1 < 144) stage(c + 1, regs);
            __syncthreads();
        }
    }
}

__device__ __forceinline__ void post_rw(const Params& p, LAS unsigned char* lds, int wave, int lane) {
    const bf16_t* Y0 = (const bf16_t*)((unsigned char*)p.out + DO_Y); const bf16_t* Y1 = Y0 + (size_t)MLAT * 1024;
    const bf16_t* Prw = (const bf16_t*)(p.ws + WS_PRW); const bf16_t* Pzrw = (const bf16_t*)(p.ws + WS_PZRW); const float* bonus = (const float*)(p.ws + WS_BONUS);
    bf16_t* Yo = (bf16_t*)(p.ws + WS_YRW);
    const int gw = blockIdx.x * 8 + wave, NGW = gridDim.x * 8, c0 = lane * 16, head = lane >> 2;
    float gg[16], gb[16]; ldf<16>(p.rw_gn_g + c0, gg); ldf<16>(p.rw_gn_b + c0, gb);
    for (int tok = gw; tok < MLAT; tok += NGW) {
        float a[16], bq[16], z[16], vs[16];
        ldbf<16>(Y0 + (size_t)tok * 1024 + c0, a); ldbf<16>(Y1 + (size_t)tok * 1024 + c0, bq); ldbf<16>(Pzrw + (size_t)tok * 1024 + c0, z);
        const Nbr nb = nbr_of(tok);
        shifted<16>(Prw, tok, nb, 2048 + c0, p.rw_mu, vs);
        float s = 0.f;
#pragma unroll
        for (int i = 0; i < 16; ++i) { a[i] += bq[i]; s += a[i]; }
        s += __shfl_xor(s, 1); s += __shfl_xor(s, 2);
        const float mean = s * (1.f / 64.f); float vr = 0.f;
#pragma unroll
        for (int i = 0; i < 16; ++i) { a[i] -= mean; vr += a[i] * a[i]; }
        vr += __shfl_xor(vr, 1); vr += __shfl_xor(vr, 2);
        const float rstd = rsqrtf(vr * (1.f / 64.f) + 64e-5f), bon = bonus[(size_t)tok * 16 + head];
#pragma unroll
        for (int i = 0; i < 16; ++i) a[i] = (a[i] * rstd * gg[i] + gb[i] + bon * vs[i]) * z[i];
        stbf<16>(Yo + (size_t)tok * 1024 + c0, a);
    }
    LAS float* scr = (LAS float*)(lds + wave * 8448);
    bf16_t* wto1 = (bf16_t*)(p.ws + WS_WTO1); bf16_t* wto2 = (bf16_t*)(p.ws + WS_WTO2); bf16_t* wtg = (bf16_t*)(p.ws + WS_WTG);
    constexpr int I_1 = (1024 / 64) * (D / 32), I_2 = (D / 64) * (D / 32), I_G = (D / 64) * (4096 / 32);
    for (int it = gw; it < 2 * I_1 + I_2 + I_G; it += NGW) {
        if (it < I_1) transpose_item(p.w_hg_out, 1024, D, D, wto1, scr, it, lane);
        else if (it < 2 * I_1) transpose_item(p.w_rw_out, 1024, D, D, wto1 + (size_t)D * 1024, scr, it - I_1, lane);
        else if (it < 2 * I_1 + I_2) transpose_item(p.w_out, D, D, D, wto2, scr, it - 2 * I_1, lane);
        else transpose_item(p.w_in + NC1, D, NCOLS, 4096, wtg, scr, it - 2 * I_1 - I_2, lane);
    }
}

struct OrderOut1 {
    int G, c;
    __device__ bool next(int i, Unit& u) const { const int tile = (i >> 1) * G + c, br = i & 1; if (tile >= 512) return false; const int pm = tile >> 3, pn = tile & 7;
        if (br == 0) { u.pm = pm; u.pn = pn; } else { u.pm = pm + YRW_PM_OFF; u.pn = pn + 8; } return true; }
    __device__ __forceinline__ void a_ready(const Unit&) const {}
    __device__ __forceinline__ void done(const Unit&) const {}
};
struct EpiOut1 {
    static constexpr bool PERM = true, AFTER_DRAIN = false, CHAIN = true;
    unsigned char* ws;
    __device__ __forceinline__ bool chain(f32x4 (&acc)[2][2][4][2], const Unit& u, int wr, int wc, int fr, int fq) const {
        const int br = u.pn >> 3, ct = u.pn & 7, rt = u.pm & 63;
        const bf16_t* G = (const bf16_t*)(ws + WS_PGATE); bf16_t* Mg = (bf16_t*)(ws + WS_MERGED);
        const int row0 = rt * 256 + wr * 64 + fr, col0 = ct * 256 + wc * 32 + 8 * fq;
#pragma unroll
        for (int ai = 0; ai < 2; ++ai)
#pragma unroll
            for (int m = 0; m < 4; ++m) { const size_t row = (size_t)(row0 + ai * 128 + m * 16);
#pragma unroll
                for (int bj = 0; bj < 2; ++bj) { const int col = col0 + bj * 128; float g2[8]; ldbf<8>(G + row * 4096 + 2048 + col, g2);
#pragma unroll
                    for (int i = 0; i < 8; ++i) g2[i] = fmaxf(g2[i], 1e-30f);
                    if (br == 0) { float g1[8]; ldbf<8>(G + row * 4096 + col, g1);
#pragma unroll
                        for (int i = 0; i < 4; ++i) { acc[ai][bj][m][0][i] *= g1[i] * __builtin_amdgcn_rcpf(g2[i]); acc[ai][bj][m][1][i] *= g1[4 + i] * __builtin_amdgcn_rcpf(g2[4 + i]); } }
                    else { float v[8];
#pragma unroll
                        for (int i = 0; i < 4; ++i) { v[i] = acc[ai][bj][m][0][i] * g2[i]; v[4 + i] = acc[ai][bj][m][1][i] * g2[4 + i]; }
                        stbf<8>(Mg + row * 2048 + col, v); } } }
        return br == 0;
    }
};
struct EpiOut2 {
    static constexpr bool PERM = false, AFTER_DRAIN = false, CHAIN = false;
    const float* x; const float* mod; float* out;
    __device__ __forceinline__ void operator()(const f32x4 (&acc)[2][2][4][2], const Unit& u, int wr, int wc, int fr, int fq) const {
        const int row0 = u.pm * 256 + wr * 64 + fr, col0 = u.pn * 256 + wc * 32 + 4 * fq;
#pragma unroll
        for (int ai = 0; ai < 2; ++ai)
#pragma unroll
            for (int m = 0; m < 4; ++m) { const int row = row0 + ai * 128 + m * 16; const float* gate = mod + (row >> 11) * (3 * D) + 2 * D;
#pragma unroll
                for (int bj = 0; bj < 2; ++bj)
#pragma unroll
                    for (int n = 0; n < 2; ++n) { const int col = col0 + bj * 128 + n * 16; const f32x4 xv = *(const f32x4*)(x + (size_t)row * D + col), gv = *(const f32x4*)(gate + col);
                        *(f32x4*)(out + (size_t)row * D + col) = xv + gv * acc[ai][bj][m][n]; } }
    }
};
__device__ __forceinline__ void final_norm(const Params& p, int wave, int lane) {
    const int gw = blockIdx.x * 8 + wave, NGW = gridDim.x * 8;
    for (int row = gw; row < MLAT; row += NGW) {
        f32x4* xr = (f32x4*)(p.out + (size_t)row * D);
        f32x4 v[8]; float ss = 0.f;
#pragma unroll
        for (int j = 0; j < 8; ++j) { v[j] = xr[lane + 64 * j]; ss += (v[j].x * v[j].x + v[j].y * v[j].y) + (v[j].z * v[j].z + v[j].w * v[j].w); }
        ss = wave_sum(ss);
        const float rstd = rsqrtf(ss * (1.f / D) + 1e-6f);
#pragma unroll
        for (int j = 0; j < 8; ++j) { const f32x4 g = *(const f32x4*)(p.final_g + 4 * (lane + 64 * j)); xr[lane + 64 * j] = v[j] * rstd * g; }
    }
}


__device__ __forceinline__ void rw_scan4(const Params& p, LAS unsigned char* lds, int tid, int wave, int lane) {
    LAS float* buf = (LAS float*)lds;
    const bf16_t* Prw = (const bf16_t*)(p.ws + WS_PRW); const float* rnp = (const float*)(p.ws + WS_RN);
    bf16_t* Ybase = (bf16_t*)((unsigned char*)p.out + DO_Y);
    for (int u = blockIdx.x; u < 256; u += gridDim.x) {
        const int b = u >> 5, h = (u >> 1) & 15, dir = u & 1;
        const bf16_t* Ed = (const bf16_t*)(p.ws + (dir ? WS_E1 : WS_E0)); const bf16_t* Ad = (const bf16_t*)(p.ws + (dir ? WS_A1 : WS_A0));
        bf16_t* Y = Ybase + (size_t)dir * MLAT * 1024;
        const int ls0 = tid >> 5, cp = tid & 31, ch = h * 64 + 2 * cp;
        float mu_[3][4][2];
#pragma unroll
        for (int a = 0; a < 3; ++a)
#pragma unroll
            for (int m = 0; m < 4; ++m) { const f32x2 t = *(const f32x2*)(p.rw_mu + m * SHC + a * 1024 + ch); mu_[a][m][0] = t.x; mu_[a][m][1] = t.y; }
        const f32x2 kkc = *(const f32x2*)(p.rw_kk + ch), kac = *(const f32x2*)(p.rw_ka + ch);
        auto rowof = [&](int tau) -> int { if (tau < CTXL) { const int t = dir ? (CTXL - 1 - tau) : tau; return MLAT + b * CTXL + t; } const int t0 = tau - CTXL; const int t = dir ? (SEQ - 1 - t0) : t0; return b * SEQ + t; };
        auto issue = [&](int c, int ls, RwRegs& r) { const int R = rowof(c * 16 + ls); const Nbr nb = nbr_of(R);
#pragma unroll
            for (int a = 0; a < 3; ++a) { const bf16_t* base = Prw + a * 1024 + ch;
                r.raw[a][0] = *(const unsigned*)(base + (size_t)R * SHC);
                r.raw[a][1] = nb.L >= 0 ? *(const unsigned*)(base + (size_t)nb.L * SHC) : 0u;
                r.raw[a][2] = nb.R >= 0 ? *(const unsigned*)(base + (size_t)nb.R * SHC) : 0u;
                r.raw[a][3] = nb.U >= 0 ? *(const unsigned*)(base + (size_t)nb.U * SHC) : 0u;
                r.raw[a][4] = nb.Dn >= 0 ? *(const unsigned*)(base + (size_t)nb.Dn * SHC) : 0u; }
            r.e = *(const unsigned*)(Ed + (size_t)R * 1024 + ch); r.a = *(const unsigned*)(Ad + (size_t)R * 1024 + ch); r.rn = rnp[(size_t)R * 16 + h]; };
        auto stage = [&](int c, int ls, const RwRegs& r) { LAS float* bs = buf + ((c & 1) * 16 + ls) * 384 + 2 * cp; const bool vert = c >= 16;
            float sh[3][2];
#pragma unroll
            for (int a = 0; a < 3; ++a)
#pragma unroll
                for (int e = 0; e < 2; ++e) { const float pv = e ? bfhi(r.raw[a][0]) : bflo(r.raw[a][0]), l = e ? bfhi(r.raw[a][1]) : bflo(r.raw[a][1]), rr = e ? bfhi(r.raw[a][2]) : bflo(r.raw[a][2]),
                                                  up = e ? bfhi(r.raw[a][3]) : bflo(r.raw[a][3]), dn = e ? bfhi(r.raw[a][4]) : bflo(r.raw[a][4]);
                    float o = pv + mu_[a][0][e] * (l - pv) + mu_[a][1][e] * (rr - pv);
                    if (vert) o += mu_[a][2][e] * (up - pv) + mu_[a][3][e] * (dn - pv);
                    sh[a][e] = o; }
            f32x2 w, kk, bb, kd, rr2, vv;
#pragma unroll
            for (int e = 0; e < 2; ++e) { const float ev = e ? bfhi(r.e) : bflo(r.e), av = e ? bfhi(r.a) : bflo(r.a); const float ksh = sh[1][e];
                const float kkv = ksh * kkc[e] * r.rn;
                w[e] = __expf(-ev); kk[e] = kkv; bb[e] = kkv * av; kd[e] = ksh * (1.f + (av - 1.f) * kac[e]); rr2[e] = sh[0][e]; vv[e] = sh[2][e]; }
            *(LAS f32x2*)(bs + 0) = w; *(LAS f32x2*)(bs + 64) = kk; *(LAS f32x2*)(bs + 128) = bb; *(LAS f32x2*)(bs + 192) = kd; *(LAS f32x2*)(bs + 256) = rr2; *(LAS f32x2*)(bs + 320) = vv; };
        const int rg = lane >> 4, q = lane & 15, row0 = wave * 16 + rg * 4; const bool b0 = (q & 1) != 0, b1 = (q & 2) != 0;
        const int myrow = row0 + ((q & 1) << 1) + ((q >> 1) & 1);
        float S[4][4];
#pragma unroll
        for (int i = 0; i < 4; ++i)
#pragma unroll
            for (int j = 0; j < 4; ++j) S[i][j] = 0.f;
        RwRegs ra, rb;
        issue(0, ls0, ra); issue(0, ls0 + 8, rb); stage(0, ls0, ra); stage(0, ls0 + 8, rb);
        __syncthreads();
        for (int c = 0; c < 144; ++c) {
            if (c + 1 < 144) { issue(c + 1, ls0, ra); issue(c + 1, ls0 + 8, rb); }
            const bool lat = c >= 16;
#pragma unroll 2
            for (int s = 0; s < 16; ++s) {
                const LAS float* bs = buf + ((c & 1) * 16 + s) * 384;
                const f32x4 w4 = *(const LAS f32x4*)(bs + q * 4), kk4 = *(const LAS f32x4*)(bs + 64 + q * 4), b4 = *(const LAS f32x4*)(bs + 128 + q * 4), kd4 = *(const LAS f32x4*)(bs + 192 + q * 4), r4 = *(const LAS f32x4*)(bs + 256 + q * 4);
                const f32x4 v4 = *(const LAS f32x4*)(bs + 320 + row0);
                float pp[4];
#pragma unroll
                for (int i = 0; i < 4; ++i) pp[i] = (S[i][0] * kk4[0] + S[i][1] * kk4[1]) + (S[i][2] * kk4[2] + S[i][3] * kk4[3]);
                float ta = (b0 ? pp[2] : pp[0]) + dpp<0xB1>(b0 ? pp[0] : pp[2]);
                float tb = (b0 ? pp[3] : pp[1]) + dpp<0xB1>(b0 ? pp[1] : pp[3]);
                float t = (b1 ? tb : ta) + dpp<0x4E>(b1 ? ta : tb);
                t += dpp<0x124>(t); t += dpp<0x128>(t);
                float sa[4]; sa[0] = dpp<0x00>(t); sa[1] = dpp<0xAA>(t); sa[2] = dpp<0x55>(t); sa[3] = dpp<0xFF>(t);
#pragma unroll
                for (int i = 0; i < 4; ++i)
#pragma unroll
                    for (int j = 0; j < 4; ++j) S[i][j] = S[i][j] * w4[j] + (v4[i] * kd4[j] - sa[i] * b4[j]);
                if (lat) {
#pragma unroll
                    for (int i = 0; i < 4; ++i) pp[i] = (S[i][0] * r4[0] + S[i][1] * r4[1]) + (S[i][2] * r4[2] + S[i][3] * r4[3]);
                    float ya = (b0 ? pp[2] : pp[0]) + dpp<0xB1>(b0 ? pp[0] : pp[2]);
                    float yb = (b0 ? pp[3] : pp[1]) + dpp<0xB1>(b0 ? pp[1] : pp[3]);
                    float y = (b1 ? yb : ya) + dpp<0x4E>(b1 ? ya : yb);
                    y += dpp<0x124>(y); y += dpp<0x128>(y);
                    if (q < 4) Y[(size_t)rowof(c * 16 + s) * 1024 + h * 64 + myrow] = f2bf(y);
                }
            }
            if (c + 1 < 144) { stage(c + 1, ls0, ra); stage(c + 1, ls0 + 8, rb); }
            __syncthreads();
        }
    }
}

__device__ __forceinline__ void hg_scan4(const Params& p, LAS unsigned char* lds, int tid, int wave, int lane) {
    LAS bf16_t* qd = (LAS bf16_t*)(lds);
    LAS bf16_t* kd = (LAS bf16_t*)(lds + 17408);
    LAS bf16_t* kdT = (LAS bf16_t*)(lds + 34816);
    LAS bf16_t* vT = (LAS bf16_t*)(lds + 53248);
    LAS bf16_t* ST = (LAS bf16_t*)(lds + 62464);
    LAS bf16_t* at = (LAS bf16_t*)(lds + 79872);
    LAS float* tot = (LAS float*)(lds + 89088);
    const bf16_t* Pq = (const bf16_t*)(p.ws + WS_PQ); const bf16_t* Pi = (const bf16_t*)(p.ws + WS_PI);
    bf16_t* Obase = (bf16_t*)((unsigned char*)p.out + DO_O);
    const int l15 = lane & 15, fq = lane >> 4;
    for (int u = blockIdx.x; u < 256; u += gridDim.x) {
        const int b = u >> 5, h = (u >> 2) & 7, dir = (u >> 1) & 1, vh = u & 1;
        const bf16_t* Pg = (const bf16_t*)(p.ws + (dir ? WS_PGB : WS_PGF));
        bf16_t* O = Obase + (size_t)dir * MLAT * 1024;
        const int k0 = 2 * lane, qtr = wave, vs = tid >> 2, vq = tid & 3;
        const int sgn = dir ? -1 : 1;
        auto rbase = [&](int c) -> int { if (c < 4) return MLAT + b * CTXL + (dir ? (CTXL - 1 - c * 64) : c * 64); const int t0 = (c - 4) * 64; return b * SEQ + (dir ? (SEQ - 1 - t0) : t0); };
        const long rstep = (long)sgn * 1024;
        f32x4 S[2][4];
#pragma unroll
        for (int a = 0; a < 2; ++a)
#pragma unroll
            for (int i = 0; i < 4; ++i) S[a][i] = (f32x4){0.f, 0.f, 0.f, 0.f};
        unsigned gN[16], qN[16]; u32x4 vN[2];
#pragma unroll
        for (int j = 0; j < 16; ++j) { const long o = ((long)rbase(0) + sgn * (qtr * 16)) * 1024 + h * 128 + k0 + j * rstep; gN[j] = *(const unsigned*)(Pg + o); qN[j] = *(const unsigned*)(Pq + o); }
#pragma unroll
        for (int i = 0; i < 2; ++i) vN[i] = *(const u32x4*)(Pi + ((long)rbase(0) + sgn * vs) * 1024 + h * 128 + vh * 64 + vq * 16 + i * 8);
        __syncthreads();
        for (int c = 0; c < 36; ++c) {
            unsigned g[16], q[16]; const u32x4 vC0 = vN[0], vC1 = vN[1];
#pragma unroll
            for (int j = 0; j < 16; ++j) { g[j] = gN[j]; q[j] = qN[j]; }
            if (c + 1 < 36) {
                const long rb1 = rbase(c + 1);
                const bf16_t* gp = Pg + (rb1 + sgn * (qtr * 16)) * 1024 + h * 128 + k0; const bf16_t* qp_ = Pq + (rb1 + sgn * (qtr * 16)) * 1024 + h * 128 + k0;
#pragma unroll
                for (int j = 0; j < 16; ++j) { gN[j] = *(const unsigned*)(gp + j * rstep); qN[j] = *(const unsigned*)(qp_ + j * rstep); }
#pragma unroll
                for (int i = 0; i < 2; ++i) vN[i] = *(const u32x4*)(Pi + (rb1 + sgn * vs) * 1024 + h * 128 + vh * 64 + vq * 16 + i * 8);
            }
            float run0 = 0.f, run1 = 0.f;
#pragma unroll
            for (int j = 0; j < 16; ++j) { run0 += bflo(g[j]); run1 += bfhi(g[j]); }
            *(LAS f32x2*)(tot + qtr * 128 + k0) = (f32x2){run0, run1};
            __syncthreads();
            {
                const f32x2 t0 = *(const LAS f32x2*)(tot + k0), t1 = *(const LAS f32x2*)(tot + 128 + k0), t2 = *(const LAS f32x2*)(tot + 256 + k0);
                const float mid0 = t0.x + t1.x, mid1 = t0.y + t1.y;
                const float off0 = qtr == 0 ? 0.f : (qtr == 1 ? t0.x : (qtr == 2 ? mid0 : mid0 + t2.x));
                const float off1 = qtr == 0 ? 0.f : (qtr == 1 ? t0.y : (qtr == 2 ? mid1 : mid1 + t2.y));
                unsigned kp0[8], kp1[8]; float bc0 = off0, bc1 = off1;
#pragma unroll
                for (int j = 0; j < 16; j += 2) {
                    float kv0[2], kv1[2];
#pragma unroll
                    for (int e = 0; e < 2; ++e) { const int jj = j + e;
                        bc0 += bflo(g[jj]); bc1 += bfhi(g[jj]);
                        const float qv0 = bflo(q[jj]) * __expf(fminf(bc0 - mid0, 80.f)), qv1 = bfhi(q[jj]) * __expf(fminf(bc1 - mid1, 80.f));
                        kv0[e] = (1.f - __expf(bflo(g[jj]))) * __expf(fminf(mid0 - bc0, 80.f)); kv1[e] = (1.f - __expf(bfhi(g[jj]))) * __expf(fminf(mid1 - bc1, 80.f));
                        const int t = qtr * 16 + jj;
                        *(LAS unsigned*)(qd + t * 136 + k0) = cvt_pk_bf16(qv0, qv1); *(LAS unsigned*)(kd + t * 136 + k0) = cvt_pk_bf16(kv0[e], kv1[e]); }
                    kp0[j >> 1] = cvt_pk_bf16(kv0[0], kv0[1]); kp1[j >> 1] = cvt_pk_bf16(kv1[0], kv1[1]);
                }
                *(LAS u32x4*)(kdT + k0 * 72 + qtr * 16) = (u32x4){kp0[0], kp0[1], kp0[2], kp0[3]};
                *(LAS u32x4*)(kdT + k0 * 72 + qtr * 16 + 8) = (u32x4){kp0[4], kp0[5], kp0[6], kp0[7]};
                *(LAS u32x4*)(kdT + (k0 + 1) * 72 + qtr * 16) = (u32x4){kp1[0], kp1[1], kp1[2], kp1[3]};
                *(LAS u32x4*)(kdT + (k0 + 1) * 72 + qtr * 16 + 8) = (u32x4){kp1[4], kp1[5], kp1[6], kp1[7]};
#pragma unroll
                for (int kt = 0; kt < 2; ++kt) { const int kb = 32 * wave + 16 * kt + fq * 4;
                    float em[4];
#pragma unroll
                    for (int j = 0; j < 4; ++j) em[j] = __expf(tot[kb + j] + tot[128 + kb + j]);
#pragma unroll
                    for (int nt = 0; nt < 4; ++nt) { u32x2 w; w.x = cvt_pk_bf16(S[kt][nt][0] * em[0], S[kt][nt][1] * em[1]); w.y = cvt_pk_bf16(S[kt][nt][2] * em[2], S[kt][nt][3] * em[3]);
                        *(LAS u32x2*)(ST + (nt * 16 + l15) * 136 + kb) = w; } }
                const unsigned vw[8] = {vC0.x, vC0.y, vC0.z, vC0.w, vC1.x, vC1.y, vC1.z, vC1.w};
#pragma unroll
                for (int i = 0; i < 8; ++i) { vT[(vq * 16 + 2 * i) * 72 + vs] = (bf16_t)(vw[i] & 0xffffu); vT[(vq * 16 + 2 * i + 1) * 72 + vs] = (bf16_t)(vw[i] >> 16); }
            }
            __syncthreads();
            const bool lat = c >= 4;
            if (lat) {
                const int tt = wave;
#pragma unroll
                for (int st = 0; st < 4; ++st) {
                    f32x4 a = (f32x4){0.f, 0.f, 0.f, 0.f};
                    if (st <= tt) {
#pragma unroll
                        for (int ks = 0; ks < 4; ++ks) { const bf16x8 A = *(const LAS bf16x8*)(qd + (tt * 16 + l15) * 136 + ks * 32 + fq * 8); const bf16x8 B = *(const LAS bf16x8*)(kd + (st * 16 + l15) * 136 + ks * 32 + fq * 8); a = mfma16(A, B, a); } }
#pragma unroll
                    for (int j = 0; j < 4; ++j) { const int t = tt * 16 + fq * 4 + j, s = st * 16 + l15; at[t * 72 + s] = f2bf(s <= t ? a[j] : 0.f); } }
            }
            __syncthreads();
            if (lat) {
                const int tt = wave;
#pragma unroll
                for (int nt = 0; nt < 4; ++nt) {
                    f32x4 o = (f32x4){0.f, 0.f, 0.f, 0.f};
#pragma unroll
                    for (int ks = 0; ks < 2; ++ks) { const bf16x8 A = *(const LAS bf16x8*)(at + (tt * 16 + l15) * 72 + ks * 32 + fq * 8); const bf16x8 B = *(const LAS bf16x8*)(vT + (nt * 16 + l15) * 72 + ks * 32 + fq * 8); o = mfma16(A, B, o); }
#pragma unroll
                    for (int ks = 0; ks < 4; ++ks) { const bf16x8 A = *(const LAS bf16x8*)(qd + (tt * 16 + l15) * 136 + ks * 32 + fq * 8); const bf16x8 B = *(const LAS bf16x8*)(ST + (nt * 16 + l15) * 136 + ks * 32 + fq * 8); o = mfma16(A, B, o); }
#pragma unroll
                    for (int j = 0; j < 4; ++j) { const long row = (long)rbase(c) + sgn * (tt * 16 + fq * 4 + j); O[row * 1024 + h * 128 + vh * 64 + nt * 16 + l15] = f2bf(o[j]); } }
            }
#pragma unroll
            for (int kt = 0; kt < 2; ++kt) { const int kb = 32 * wave + 16 * kt;
                float eb[4], e2[4];
#pragma unroll
                for (int j = 0; j < 4; ++j) { const int kj = kb + fq * 4 + j; const float m = tot[kj] + tot[128 + kj], bl = m + tot[256 + kj] + tot[384 + kj]; eb[j] = __expf(bl); e2[j] = __expf(bl - m); }
#pragma unroll
                for (int nt = 0; nt < 4; ++nt) { f32x4 tmp = (f32x4){0.f, 0.f, 0.f, 0.f};
#pragma unroll
                    for (int ks = 0; ks < 2; ++ks) { const bf16x8 A = *(const LAS bf16x8*)(kdT + (kb + l15) * 72 + ks * 32 + fq * 8); const bf16x8 B = *(const LAS bf16x8*)(vT + (nt * 16 + l15) * 72 + ks * 32 + fq * 8); tmp = mfma16(A, B, tmp); }
#pragma unroll
                    for (int j = 0; j < 4; ++j) S[kt][nt][j] = eb[j] * S[kt][nt][j] + e2[j] * tmp[j]; } }
            __syncthreads();
        }
    }
}

#define XB_TMO      128
#define XB_XCNT(j)  (256  + 64 * (j))
#define XB_XSUB(j)  (1280 + 64 * (j))
#define XB_XGEN(j)  (2304 + 64 * (j))
#define XB_TOP      3328
#define XB_TOPGEN   3392
#define XCD_BAR_WORDS 3456
#define XB_SPIN_CAP (1u << 18)

__device__ __forceinline__ unsigned xb_ld(unsigned* p)              { return __hip_atomic_load(p, __ATOMIC_RELAXED, __HIP_MEMORY_SCOPE_AGENT); }
__device__ __forceinline__ unsigned xb_add(unsigned* p, unsigned v) { return __hip_atomic_fetch_add(p, v, __ATOMIC_RELAXED, __HIP_MEMORY_SCOPE_AGENT); }
__device__ __forceinline__ unsigned xb_xcc_id() { return (unsigned)__builtin_amdgcn_s_getreg((3 << 11) | 20) & 0xFu; }
#define XB_SPIN(cond, bar) do { unsigned _sp = 0; while (cond) { __builtin_amdgcn_s_sleep(1); \
    if ((++_sp & 255u) == 0u) { if (xb_ld(&(bar)[XB_TMO])) break; if (_sp > XB_SPIN_CAP) { atomicAdd(&(bar)[XB_TMO], 1u); break; } } } } while (0)

struct XcdBarrier {
    unsigned* bar; unsigned x;
    volatile LAS unsigned* st;
};

__device__ __forceinline__ XcdBarrier xcd_barrier_post(unsigned* bar, volatile LAS unsigned* st) {
    XcdBarrier b; b.bar = bar; b.x = xb_xcc_id(); b.st = st;
    if (threadIdx.x == 0) (void)xb_add(&bar[XB_XCNT(b.x)], 1u);
    return b;
}
__device__ __forceinline__ void xcd_barrier_complete(unsigned* bar, unsigned x, unsigned& nloc, unsigned& nx) {
    const unsigned G = gridDim.x * gridDim.y * gridDim.z;
    unsigned sum, cnt, mine, sp = 0u;
    for (;;) {
        sum = 0u; cnt = 0u; mine = 0u;
#pragma unroll
        for (unsigned j = 0; j < 16; ++j) { const unsigned c = xb_ld(&bar[XB_XCNT(j)]); sum += c; cnt += (c > 0u) ? 1u : 0u; mine = (j == x) ? c : mine; }
        if (sum == G) break;
        __builtin_amdgcn_s_sleep(1);
        if ((++sp & 255u) == 0u) { if (xb_ld(&bar[XB_TMO])) break; if (sp > XB_SPIN_CAP) { atomicAdd(&bar[XB_TMO], 1u); break; } }
    }
    nloc = mine > 0u ? mine : 1u; nx = cnt > 0u ? cnt : 1u;
}

__device__ __forceinline__ void xcd_barrier(const XcdBarrier& b) {
    asm volatile("s_waitcnt vmcnt(0)" ::: "memory");
    __syncthreads();
    if (threadIdx.x == 0) {
        unsigned* bar = b.bar;
        __builtin_amdgcn_s_waitcnt(0);
        unsigned nloc = b.st[0], nx = b.st[1];
        if (nloc == 0u) { xcd_barrier_complete(bar, b.x, nloc, nx); b.st[0] = nloc; b.st[1] = nx; }
        const unsigned old = xb_add(&bar[XB_XSUB(b.x)], 1u);
        const unsigned gen = old / nloc;
        if (old + 1u == (gen + 1u) * nloc) {
            __builtin_amdgcn_fence(__ATOMIC_RELEASE, "agent");
            asm volatile("s_waitcnt vmcnt(0)" ::: "memory");
            const unsigned og = xb_add(&bar[XB_TOP], 1u);
            const unsigned tg = og / nx;
            if (og + 1u == (tg + 1u) * nx) xb_add(&bar[XB_TOPGEN], 1u);
            else XB_SPIN(xb_ld(&bar[XB_TOPGEN]) == tg, bar);
            __builtin_amdgcn_fence(__ATOMIC_ACQUIRE, "agent");
            xb_add(&bar[XB_XGEN(b.x)], 1u);
            asm volatile("s_waitcnt vmcnt(0)" ::: "memory");
        } else {
            XB_SPIN(xb_ld(&bar[XB_XGEN(b.x)]) == gen, bar);
            __builtin_amdgcn_fence(__ATOMIC_ACQUIRE, "agent");
            asm volatile("s_waitcnt vmcnt(0)" ::: "memory");
        }
    }
    __syncthreads();
}


#ifndef GA
#define GA true
#endif
#ifndef GS
#define GS true
#endif
#ifndef COMBINED
#define COMBINED 0
#endif

__global__ void __launch_bounds__(512, 2) mega(Params p) {
    extern __shared__ __attribute__((aligned(16))) unsigned char shm[];
    LAS unsigned char* lds = (LAS unsigned char*)shm;
    cg::grid_group grid = cg::this_grid();
    const int tid = threadIdx.x, wave = __builtin_amdgcn_readfirstlane(tid >> 6), lane = tid & 63;
    volatile LAS unsigned* xst = (volatile LAS unsigned*)(lds + 131072);
    if (tid == 0) { xst[0] = 0u; xst[1] = 0u; }
    __syncthreads();
    const XcdBarrier xb = xcd_barrier_post((unsigned*)(p.ws + WS_BAR), xst);
    phase0(p, lds, tid, wave, lane);
    if (p.ws == nullptr) grid.sync();
    xcd_barrier(xb);
    phase1(p, (bf16_t*)((unsigned char*)p.out + DO_H), MTOT, wave, lane);
    xcd_barrier(xb);
    { pg8::Gemm g{(const bf16_t*)((unsigned char*)p.out + DO_H), (const bf16_t*)((unsigned char*)p.out + DO_WTIN), MTOT, NC1, D};
      InOrder S{(int)gridDim.x, (int)blockIdx.x}; EpiProj E{p.ws};
      pg8::gemm_phase<EpiProj, InOrder, GA, GS>(lds, g, S, E); }
    xcd_barrier(xb);
    rw_prep(p, lds, wave, lane);
    xcd_barrier(xb);
#if COMBINED
    if (wave < 4) rw_scan4(p, lds, tid, wave, lane);
    else hg_scan4(p, lds + RW_LDS, tid - 256, wave - 4, lane);
#else
    hg_scan(p, lds, tid, wave, lane);
    rw_scan(p, lds, tid, wave, lane);
#endif
    xcd_barrier(xb);
    post_hg(p, wave, lane);
    post_rw(p, lds, wave, lane);
    phase1(p, (bf16_t*)(p.ws + WS_H2), MLAT, wave, lane);
    xcd_barrier(xb);
    { pg8::Gemm g{(const bf16_t*)(p.ws + WS_H2), (const bf16_t*)(p.ws + WS_WTG), MLAT, 4096, D};
      pg8::StaticOrder S; S.init(MLAT, 4096, (int)gridDim.x, (int)blockIdx.x); EpiGate E{p.ws};
      pg8::gemm_phase<EpiGate, pg8::StaticOrder, GA, GS>(lds, g, S, E); }
    xcd_barrier(xb);
    { pg8::Gemm g{(const bf16_t*)(p.ws + WS_YHG), (const bf16_t*)(p.ws + WS_WTO1), 0, 0, 1024};
      OrderOut1 S{(int)gridDim.x, (int)blockIdx.x}; EpiOut1 E{p.ws};
      pg8::gemm_phase<EpiOut1, OrderOut1, GA, GS>(lds, g, S, E); }
    xcd_barrier(xb);
    { pg8::Gemm g{(const bf16_t*)(p.ws + WS_MERGED), (const bf16_t*)(p.ws + WS_WTO2), MLAT, D, D};
      pg8::StaticOrder S; S.init(MLAT, D, (int)gridDim.x, (int)blockIdx.x); EpiOut2 E{p.x, (const float*)(p.ws + WS_MOD), p.out};
      pg8::gemm_phase<EpiOut2, pg8::StaticOrder, GA, GS>(lds, g, S, E); }
    xcd_barrier(xb);
    final_norm(p, wave, lane);
}
}

extern "C" void kernel_launch(void* const* d_in, const int* in_sizes, int n_in, void* d_out, int out_size, void* d_ws, size_t ws_size, hipStream_t stream) {
    static int grid = 0;
    if (grid == 0) {
        if (n_in != 24 || ws_size < mk::WS_END) { fprintf(stderr, "kernel_launch: unexpected inputs (n_in %d, ws %zu)\n", n_in, ws_size); grid = -1; return; }
        int dev = 0, cus = 0, per_cu = 0;
        (void)hipGetDevice(&dev); (void)hipDeviceGetAttribute(&cus, hipDeviceAttributeMultiprocessorCount, dev);
        if (hipFuncSetAttribute((const void*)mk::mega, hipFuncAttributeMaxDynamicSharedMemorySize, mk::LDS_BYTES) != hipSuccess) { fprintf(stderr, "kernel_launch: hipFuncSetAttribute failed\n"); }
        if (hipOccupancyMaxActiveBlocksPerMultiprocessor(&per_cu, (const void*)mk::mega, 512, mk::LDS_BYTES) != hipSuccess || per_cu < 1) per_cu = 1;
        (void)hipGetLastError();
        grid = cus * (per_cu > 1 ? 1 : per_cu);
        if (grid <= 0) grid = 256;
    }
    if (grid < 0) return;
    mk::Params p{};
    const float** f = (const float**)&p;
    for (int i = 0; i < 24; ++i) f[i] = (const float*)d_in[i];
    p.out = (float*)d_out; p.ws = (unsigned char*)d_ws;
    (void)hipMemsetAsync((unsigned char*)d_ws + mk::WS_BAR, 0, XCD_BAR_WORDS * sizeof(unsigned), stream);
    void* args[] = {&p};
    hipError_t e = hipLaunchCooperativeKernel((const void*)mk::mega, dim3(grid), dim3(512), args, mk::LDS_BYTES, stream);
    if (e != hipSuccess) fprintf(stderr, "cooperative launch failed: %s (grid %d)\n", hipGetErrorString(e), grid);
}
```

```cpp
#include <hip/hip_runtime.h>
#include <hip/hip_cooperative_groups.h>
#include <cstdio>
#include <cstdint>
namespace cg = cooperative_groups;
namespace pg8 {
#define PG8_LAS __attribute__((address_space(3)))
typedef unsigned short bf16_t;
typedef short bf16x8 __attribute__((ext_vector_type(8)));
typedef float f32x4 __attribute__((ext_vector_type(4)));
typedef unsigned u32x4 __attribute__((ext_vector_type(4)));
constexpr int BM = 256, BK = 64, HALF = 128, HTB = HALF * BK * 2  , STAGE_BYTES = 8 * HTB, NXCD = 8, WGM = 4;

__host__ __device__ __forceinline__ int lds_byte(int r, int c) { const int st = (r >> 4) * 2 + (c >> 5), rr = r & 15, cc = c & 31, ob = rr * 64 + cc * 2; return st * 1024 + (ob ^ (((ob >> 9) & 1) << 5)); }
__host__ __device__ __forceinline__ void stage_rc(int b, int& R, int& C) { const int st = b / 1024, sb = b % 1024, swz = sb ^ (((sb >> 9) & 1) << 5); R = (st >> 1) * 16 + swz / 64; C = (st & 1) * 32 + (swz % 64) / 2; }
__host__ __device__ __forceinline__ int perm32(int rho) { const int n = rho >> 4, i = rho & 15; return 8 * (i >> 2) + 4 * n + (i & 3); }

struct Unit { int pm, pn; };
struct Gemm { const bf16_t* A; const bf16_t* Bt; int M, N, K; };

struct StaticOrder {
    int nM, nN, nwg, G, c;
    __host__ __device__ void init(int M, int N, int G_, int c_) { nM = M / BM; nN = N / BM; nwg = nM * nN; G = G_; c = c_; }
    __host__ __device__ bool next(int i, Unit& u) const {
        const long L = (long)i * G + c; if (L >= nwg) return false;
        int wgid = (int)L; { const int q = nwg / NXCD, r = nwg % NXCD, xcd = wgid % NXCD, off = wgid / NXCD; wgid = (xcd < r ? xcd * (q + 1) : r * (q + 1) + (xcd - r) * q) + off; }
        const int nig = WGM * nN, gid = wgid / nig, fm = gid * WGM, gsz = (nM - fm) < WGM ? (nM - fm) : WGM;
        u.pm = fm + ((wgid % nig) % gsz); u.pn = (wgid % nig) / gsz; return true;
    }
    __device__ __forceinline__ void a_ready(const Unit&) const {}
    __device__ __forceinline__ void done(const Unit&) const {}
};
typedef float f32x2 __attribute__((ext_vector_type(2)));
typedef __bf16 bf16x2v __attribute__((ext_vector_type(2)));
__device__ __forceinline__ unsigned cvt_pk_bf16(float lo, float hi) { const f32x2 v = {lo, hi}; const bf16x2v b = __builtin_convertvector(v, bf16x2v); return __builtin_bit_cast(unsigned, b); }
template <class Epi, class Sched, bool ALIGN_EPI = false, bool SP2 = false>
__device__ __forceinline__ void gemm_phase(PG8_LAS unsigned char* lds, const Gemm g, const Sched& S, const Epi& E) {
    const int tid = threadIdx.x, wid = __builtin_amdgcn_readfirstlane(tid >> 6), lane = tid & 63, wr = wid >> 2, wc = wid & 3, fr = lane & 15, fq = lane >> 4;
    const int K = g.K, nt = K / BK;
    unsigned voffA[2], voffB[2];
#pragma unroll
    for (int i = 0; i < 2; ++i) { int R, C; stage_rc(tid * 16 + i * 8192, R, C); const int Rb = Epi::PERM ? ((R & ~31) + perm32(R & 31)) : R;
        voffA[i] = (unsigned)(R * K + C) * 2u; voffB[i] = (unsigned)(Rb * K + C) * 2u; }
    const size_t kstep = (size_t)(BK * 2);
    const size_t hstep = (size_t)HALF * K * 2;
    const size_t tstep = 2 * hstep;
    const unsigned ldsw = (unsigned)wid * 1024u;
    const int aoff = lds_byte(wr * 64 + fr, fq * 8), boff = lds_byte(wc * 32 + fr, fq * 8);
#define PG8_SA(b, h) (((b) * 2 + (h)) * HTB)
#define PG8_SB(b, h) ((4 + (b) * 2 + (h)) * HTB)
#define PG8_STAGE(bufoff, gbase, voff) do { _Pragma("unroll") for (int _i = 0; _i < 2; ++_i) \
        __builtin_amdgcn_global_load_lds((const unsigned*)((const char*)(gbase) + (voff)[_i]), (PG8_LAS unsigned*)(lds + (bufoff) + ldsw + _i * 8192), 16, 0, 0); } while (0)
#define PG8_LDA(dst, b, h) do { _Pragma("unroll") for (int m = 0; m < 4; ++m) _Pragma("unroll") for (int k = 0; k < 2; ++k) dst[m][k] = *(const PG8_LAS bf16x8*)(lds + PG8_SA(b, h) + aoff + m * 2048 + k * 1024); } while (0)
#define PG8_LDB(dst, b, h) do { _Pragma("unroll") for (int n = 0; n < 2; ++n) _Pragma("unroll") for (int k = 0; k < 2; ++k) dst[n][k] = *(const PG8_LAS bf16x8*)(lds + PG8_SB(b, h) + boff + n * 2048 + k * 1024); } while (0)
#define PG8_MMA(ai, bj, At, Bt) do { __builtin_amdgcn_s_setprio(1); _Pragma("unroll") for (int m = 0; m < 4; ++m) _Pragma("unroll") for (int n = 0; n < 2; ++n) _Pragma("unroll") for (int k = 0; k < 2; ++k) \
        acc[ai][bj][m][n] = __builtin_amdgcn_mfma_f32_16x16x32_bf16(Bt[n][k], At[m][k], acc[ai][bj][m][n], 0, 0, 0); __builtin_amdgcn_s_setprio(0); } while (0)
#define PG8_WAIT_V(n) asm volatile("s_waitcnt vmcnt(" #n ")" ::: "memory")
#define PG8_WAIT_L(n) asm volatile("s_waitcnt lgkmcnt(" #n ")" ::: "memory")
#define PG8_BAR __builtin_amdgcn_s_barrier()
#define PG8_SCHED __builtin_amdgcn_sched_barrier(0)
    Unit cur, nxt; int ui = 0;
    if (!S.next(0, cur)) return;
    f32x4 acc[2][2][4][2];
#pragma unroll
    for (int a = 0; a < 2; ++a)
#pragma unroll
        for (int b = 0; b < 2; ++b)
#pragma unroll
            for (int m = 0; m < 4; ++m)
#pragma unroll
                for (int n = 0; n < 2; ++n) acc[a][b][m][n] = (f32x4){0.f, 0.f, 0.f, 0.f};
    bf16x8 At[4][2], B0[2][2], B1[2][2];
    const char* cA = (const char*)g.A + (size_t)cur.pm * tstep; const char* cB = (const char*)g.Bt + (size_t)cur.pn * tstep;
    S.a_ready(cur);
    if constexpr (SP2) {
        PG8_STAGE(PG8_SB(0, 0), cB, voffB); PG8_STAGE(PG8_SB(0, 1), cB + hstep, voffB); PG8_STAGE(PG8_SA(0, 0), cA, voffA); PG8_STAGE(PG8_SA(0, 1), cA + hstep, voffA);
        if (wr == 1) PG8_BAR;
        PG8_WAIT_V(2); PG8_BAR;
        PG8_STAGE(PG8_SB(1, 0), cB + kstep, voffB); PG8_STAGE(PG8_SA(1, 0), cA + kstep, voffA); PG8_STAGE(PG8_SB(1, 1), cB + hstep + kstep, voffB);
        PG8_WAIT_V(6); PG8_BAR;
    } else {
        PG8_STAGE(PG8_SB(0, 0), cB, voffB); PG8_STAGE(PG8_SA(0, 0), cA, voffA); PG8_STAGE(PG8_SB(0, 1), cB + hstep, voffB); PG8_STAGE(PG8_SA(0, 1), cA + hstep, voffA);
        if (wr == 1) PG8_BAR;
        PG8_WAIT_V(4); PG8_BAR;
        PG8_STAGE(PG8_SB(1, 0), cB + kstep, voffB); PG8_STAGE(PG8_SA(1, 0), cA + kstep, voffA); PG8_STAGE(PG8_SB(1, 1), cB + hstep + kstep, voffB);
        PG8_WAIT_V(6); PG8_BAR;
    }
    for (;;) {
        const bool has_next = S.next(ui + 1, nxt);
        const char* nA = has_next ? (const char*)g.A + (size_t)nxt.pm * tstep : cA; const char* nB = has_next ? (const char*)g.Bt + (size_t)nxt.pn * tstep : cB;
        for (int t = 0; t < nt; t += 2) {
            const bool last = (t == nt - 2);
            const char* a1 = cA + (size_t)(t + 1) * kstep;
            const char* a2 = last ? nA : cA + (size_t)(t + 2) * kstep; const char* b2 = last ? nB : cB + (size_t)(t + 2) * kstep;
            const char* a3 = a2 + kstep; const char* b3 = b2 + kstep;
            if (last && has_next) S.a_ready(nxt);
            if constexpr (SP2) {
            PG8_LDB(B0, 0, 0); PG8_LDB(B1, 0, 1); PG8_SCHED; PG8_LDA(At, 0, 0); PG8_STAGE(PG8_SA(1, 1), a1 + hstep, voffA);
            PG8_WAIT_V(8); PG8_WAIT_L(0); PG8_BAR; PG8_MMA(0, 0, At, B0); PG8_MMA(0, 1, At, B1); PG8_BAR; PG8_SCHED;
            PG8_LDA(At, 0, 1); PG8_STAGE(PG8_SB(0, 0), b2, voffB); PG8_STAGE(PG8_SB(0, 1), b2 + hstep, voffB); PG8_STAGE(PG8_SA(0, 0), a2, voffA);
            PG8_WAIT_V(8); PG8_WAIT_L(0); PG8_BAR; PG8_MMA(1, 0, At, B0); PG8_MMA(1, 1, At, B1); PG8_BAR; PG8_SCHED;
            PG8_LDB(B0, 1, 0); PG8_LDB(B1, 1, 1); PG8_SCHED; PG8_LDA(At, 1, 0); PG8_STAGE(PG8_SA(0, 1), a2 + hstep, voffA);
            PG8_WAIT_V(8); PG8_WAIT_L(0); PG8_BAR; PG8_MMA(0, 0, At, B0); PG8_MMA(0, 1, At, B1); PG8_BAR; PG8_SCHED;
            PG8_LDA(At, 1, 1); PG8_STAGE(PG8_SB(1, 0), b3, voffB); PG8_STAGE(PG8_SB(1, 1), b3 + hstep, voffB); PG8_STAGE(PG8_SA(1, 0), a3, voffA);
            PG8_WAIT_V(8); PG8_WAIT_L(0); PG8_BAR; PG8_MMA(1, 0, At, B0); PG8_MMA(1, 1, At, B1); PG8_BAR; PG8_SCHED;
            } else {
            PG8_LDB(B0, 0, 0); PG8_SCHED; PG8_LDA(At, 0, 0); PG8_STAGE(PG8_SA(1, 1), a1 + hstep, voffA);
            PG8_WAIT_L(8); PG8_BAR; PG8_WAIT_L(0); PG8_MMA(0, 0, At, B0); PG8_BAR; PG8_SCHED;
            PG8_LDB(B1, 0, 1); PG8_STAGE(PG8_SB(0, 0), b2, voffB);
            PG8_BAR; PG8_WAIT_L(0); PG8_MMA(0, 1, At, B1); PG8_BAR;
            PG8_LDA(At, 0, 1); PG8_STAGE(PG8_SA(0, 0), a2, voffA);
            PG8_BAR; PG8_WAIT_L(0); PG8_MMA(1, 0, At, B0); PG8_BAR; PG8_SCHED;
            PG8_STAGE(PG8_SB(0, 1), b2 + hstep, voffB);
            PG8_WAIT_V(6); PG8_BAR; PG8_MMA(1, 1, At, B1); PG8_BAR;
            PG8_LDB(B0, 1, 0); PG8_SCHED; PG8_LDA(At, 1, 0); PG8_STAGE(PG8_SA(0, 1), a2 + hstep, voffA);
            PG8_WAIT_L(8); PG8_BAR; PG8_WAIT_L(0); PG8_MMA(0, 0, At, B0); PG8_BAR; PG8_SCHED;
            PG8_LDB(B1, 1, 1); PG8_STAGE(PG8_SB(1, 0), b3, voffB);
            PG8_BAR; PG8_WAIT_L(0); PG8_MMA(0, 1, At, B1); PG8_BAR;
            PG8_LDA(At, 1, 1); PG8_STAGE(PG8_SA(1, 0), a3, voffA);
            PG8_BAR; PG8_WAIT_L(0); PG8_MMA(1, 0, At, B0); PG8_BAR; PG8_SCHED;
            PG8_STAGE(PG8_SB(1, 1), b3 + hstep, voffB);
            PG8_WAIT_V(6); PG8_BAR; PG8_MMA(1, 1, At, B1); PG8_BAR;
            }
        }
        if constexpr (ALIGN_EPI) { if (wr == 0) PG8_BAR; }
        bool keep_acc = false;
        if constexpr (Epi::CHAIN) { keep_acc = E.chain(acc, cur, wr, wc, fr, fq); S.done(cur); }
        else if constexpr (!Epi::AFTER_DRAIN) { E(acc, cur, wr, wc, fr, fq); S.done(cur); }
        if (!has_next) break;
        if (!keep_acc)
#pragma unroll
        for (int a = 0; a < 2; ++a)
#pragma unroll
            for (int b = 0; b < 2; ++b)
#pragma unroll
                for (int m = 0; m < 4; ++m)
#pragma unroll
                    for (int n = 0; n < 2; ++n) acc[a][b][m][n] = (f32x4){0.f, 0.f, 0.f, 0.f};
        cur = nxt; cA = nA; cB = nB; ++ui;
        if constexpr (ALIGN_EPI) { if (wr == 1) PG8_BAR; }
    }
    PG8_WAIT_V(0);
    if constexpr (!ALIGN_EPI) { if (wr == 0) PG8_BAR; }
    PG8_BAR;
    if constexpr (Epi::AFTER_DRAIN) { E.fused(acc, cur, wr, wc, fr, fq, lds, wid, lane); S.done(cur); }
#undef PG8_SA
#undef PG8_SB
#undef PG8_STAGE
#undef PG8_LDA
#undef PG8_LDB
#undef PG8_MMA
#undef PG8_WAIT_V
#undef PG8_WAIT_L
#undef PG8_BAR
#undef PG8_SCHED
}
}

namespace mk {
using pg8::bf16_t; using pg8::bf16x8; using pg8::f32x4; using pg8::u32x4; using pg8::Unit; using pg8::cvt_pk_bf16; using pg8::f32x2;
typedef unsigned u32x2 __attribute__((ext_vector_type(2)));
#define LAS __attribute__((address_space(3)))
#define LDS_WAIT() asm volatile("s_waitcnt lgkmcnt(0)" ::: "memory")

constexpr int D = 2048, NB = 8, SEQ = 2048, CTXL = 256;
constexpr int MLAT = NB * SEQ, MCTX = NB * CTXL, MTOT = MLAT + MCTX;
constexpr int NCOLS = 13568, SHC = 3328;
constexpr size_t MiB = (size_t)1 << 20;
constexpr size_t WS_MOD = 0, WS_LB = 256 * 1024, WS_W2T = 512 * 1024, WS_RN = 1 * MiB, WS_BONUS = 2 * MiB + 256 * 1024;
constexpr size_t WS_PQ = 4 * MiB, WS_PI = 40 * MiB, WS_PGF = 76 * MiB, WS_PGB = 112 * MiB, WS_PZ = 148 * MiB, WS_PRW = 184 * MiB, WS_PZRW = 301 * MiB;
constexpr size_t WS_E0 = 337 * MiB, WS_E1 = 373 * MiB, WS_A0 = 409 * MiB, WS_A1 = 445 * MiB;
constexpr size_t WS_WTO1 = 481 * MiB, WS_WTO2 = 489 * MiB;
constexpr size_t WS_YHG = 4 * MiB, WS_YRW = 36 * MiB, WS_H2 = 68 * MiB, WS_WTG = 132 * MiB;
constexpr size_t WS_PGATE = 337 * MiB;
constexpr size_t WS_T1 = 184 * MiB, WS_MERGED = 248 * MiB;
constexpr size_t WS_BAR = 500 * MiB;
constexpr size_t WS_END = 501 * MiB;
constexpr int YRW_PM_OFF = 64;
static_assert((WS_YRW - WS_YHG) == (size_t)YRW_PM_OFF * 256 * 1024 * 2, "y_hg / y_rw spacing");
constexpr int NC1 = 9472;
constexpr size_t DO_H = 0, DO_WTIN = 72 * MiB, DO_O = 0, DO_Y = 64 * MiB;
constexpr int LDS_BYTES = 147456, RW_LDS = 49152;

struct Params {
    const float *x, *c, *ctx, *c_ctx, *ada_w, *ada_b, *norm_g, *w_in, *hg_lb, *hg_norm_g, *rw_mu, *rw_w0, *rw_w2, *rw_a0, *rw_a2, *rw_kk, *rw_ka, *rw_rk, *rw_gn_g, *rw_gn_b,
        *w_hg_out, *w_rw_out, *w_out, *final_g;
    float* out; unsigned char* ws;
};

__device__ __forceinline__ float bflo(unsigned u) { return __uint_as_float(u << 16); }
__device__ __forceinline__ float bfhi(unsigned u) { return __uint_as_float(u & 0xffff0000u); }
__device__ __forceinline__ float bf2f(bf16_t u) { return __uint_as_float(((unsigned)u) << 16); }
__device__ __forceinline__ bf16_t f2bf(float f) { return (bf16_t)(cvt_pk_bf16(f, 0.f) & 0xffffu); }
__device__ __forceinline__ float sigm(float x) { return __builtin_amdgcn_rcpf(1.f + __expf(-x)); }
__device__ __forceinline__ float silu(float x) { return x * sigm(x); }
__device__ __forceinline__ float tanh_(float x) { return 1.f - 2.f * __builtin_amdgcn_rcpf(1.f + __expf(2.f * x)); }
__device__ __forceinline__ float wave_sum(float v) {
#pragma unroll
    for (int o = 1; o < 64; o <<= 1) v += __shfl_xor(v, o);
    return v;
}
template <int CTRL> __device__ __forceinline__ float dpp(float x) { return __int_as_float(__builtin_amdgcn_update_dpp(0, __float_as_int(x), CTRL, 0xf, 0xf, true)); }
__device__ __forceinline__ f32x4 mfma16(bf16x8 a, bf16x8 b, f32x4 c) { return __builtin_amdgcn_mfma_f32_16x16x32_bf16(a, b, c, 0, 0, 0); }

template <int W> __device__ __forceinline__ void ldbf(const bf16_t* p, float (&o)[W]) {
    if constexpr (W == 2) { const unsigned u = *(const unsigned*)p; o[0] = bflo(u); o[1] = bfhi(u); }
    else if constexpr (W == 4) { const u32x2 u = *(const u32x2*)p; o[0] = bflo(u.x); o[1] = bfhi(u.x); o[2] = bflo(u.y); o[3] = bfhi(u.y); }
    else {
#pragma unroll
        for (int i = 0; i < W / 8; ++i) { const u32x4 u = *(const u32x4*)(p + 8 * i);
            o[8 * i + 0] = bflo(u.x); o[8 * i + 1] = bfhi(u.x); o[8 * i + 2] = bflo(u.y); o[8 * i + 3] = bfhi(u.y);
            o[8 * i + 4] = bflo(u.z); o[8 * i + 5] = bfhi(u.z); o[8 * i + 6] = bflo(u.w); o[8 * i + 7] = bfhi(u.w); }
    }
}
template <int W> __device__ __forceinline__ void ldf(const float* p, float (&o)[W]) {
    if constexpr (W == 2) { const f32x2 u = *(const f32x2*)p; o[0] = u.x; o[1] = u.y; }
    else {
#pragma unroll
        for (int i = 0; i < W / 4; ++i) { const f32x4 u = *(const f32x4*)(p + 4 * i); o[4 * i] = u.x; o[4 * i + 1] = u.y; o[4 * i + 2] = u.z; o[4 * i + 3] = u.w; }
    }
}
template <int W> __device__ __forceinline__ void stbf(bf16_t* p, const float (&v)[W]) {
    if constexpr (W == 4) { u32x2 u; u.x = cvt_pk_bf16(v[0], v[1]); u.y = cvt_pk_bf16(v[2], v[3]); *(u32x2*)p = u; }
    else {
#pragma unroll
        for (int i = 0; i < W / 8; ++i) { u32x4 u; u.x = cvt_pk_bf16(v[8 * i], v[8 * i + 1]); u.y = cvt_pk_bf16(v[8 * i + 2], v[8 * i + 3]); u.z = cvt_pk_bf16(v[8 * i + 4], v[8 * i + 5]); u.w = cvt_pk_bf16(v[8 * i + 6], v[8 * i + 7]); *(u32x4*)(p + 8 * i) = u; }
    }
}

struct Nbr { int L, R, U, Dn; bool vert; };
__device__ __forceinline__ Nbr nbr_of(int R) {
    Nbr n;
    if (R < MLAT) { const int t = R & (SEQ - 1), col = t & 63; n.L = col > 0 ? R - 1 : -1; n.R = col < 63 ? R + 1 : -1; n.U = t >= 64 ? R - 64 : -1; n.Dn = t < SEQ - 64 ? R + 64 : -1; n.vert = true; }
    else { const int t = (R - MLAT) & (CTXL - 1); n.L = t > 0 ? R - 1 : -1; n.R = t < CTXL - 1 ? R + 1 : -1; n.U = -1; n.Dn = -1; n.vert = false; }
    return n;
}
template <int W> __device__ __forceinline__ void shifted(const bf16_t* Prw, int R, const Nbr& nb, int col, const float* mu, float (&o)[W]) {
    float p[W], t[W], m[W];
    ldbf<W>(Prw + (size_t)R * SHC + col, p);
#pragma unroll
    for (int i = 0; i < W; ++i) o[i] = p[i];
    ldf<W>(mu + col, m);
    if (nb.L >= 0) ldbf<W>(Prw + (size_t)nb.L * SHC + col, t); else {
#pragma unroll
        for (int i = 0; i < W; ++i) t[i] = 0.f; }
#pragma unroll
    for (int i = 0; i < W; ++i) o[i] += m[i] * (t[i] - p[i]);
    ldf<W>(mu + SHC + col, m);
    if (nb.R >= 0) ldbf<W>(Prw + (size_t)nb.R * SHC + col, t); else {
#pragma unroll
        for (int i = 0; i < W; ++i) t[i] = 0.f; }
#pragma unroll
    for (int i = 0; i < W; ++i) o[i] += m[i] * (t[i] - p[i]);
    if (nb.vert) {
        ldf<W>(mu + 2 * SHC + col, m);
        if (nb.U >= 0) ldbf<W>(Prw + (size_t)nb.U * SHC + col, t); else {
#pragma unroll
            for (int i = 0; i < W; ++i) t[i] = 0.f; }
#pragma unroll
        for (int i = 0; i < W; ++i) o[i] += m[i] * (t[i] - p[i]);
        ldf<W>(mu + 3 * SHC + col, m);
        if (nb.Dn >= 0) ldbf<W>(Prw + (size_t)nb.Dn * SHC + col, t); else {
#pragma unroll
            for (int i = 0; i < W; ++i) t[i] = 0.f; }
#pragma unroll
        for (int i = 0; i < W; ++i) o[i] += m[i] * (t[i] - p[i]);
    }
}

__device__ __forceinline__ void shifted4m(const bf16_t* Prw, int R, const Nbr& nb, int col, const f32x4 (&mu4)[4], float (&o)[4]) {
    float p[4], t[4];
    ldbf<4>(Prw + (size_t)R * SHC + col, p);
#pragma unroll
    for (int i = 0; i < 4; ++i) o[i] = p[i];
#pragma unroll
    for (int d = 0; d < 4; ++d) {
        if (d >= 2 && !nb.vert) break;
        const int nr = d == 0 ? nb.L : (d == 1 ? nb.R : (d == 2 ? nb.U : nb.Dn));
        if (nr >= 0) ldbf<4>(Prw + (size_t)nr * SHC + col, t); else {
#pragma unroll
            for (int i = 0; i < 4; ++i) t[i] = 0.f; }
#pragma unroll
        for (int i = 0; i < 4; ++i) o[i] += mu4[d][i] * (t[i] - p[i]);
    }
}

__device__ __forceinline__ void transpose_item(const float* W, int K, int ldw, int N, bf16_t* WT, LAS float* scr, int item, int lane) {
    const int nblk = N / 32, kb = item / nblk, nb = item % nblk, k0 = 64 * kb, n0 = 32 * nb;
#pragma unroll 8
    for (int i = 0; i < 32; ++i) { const int kk = 2 * i + (lane >> 5); scr[kk * 33 + (lane & 31)] = W[(size_t)(k0 + kk) * ldw + n0 + (lane & 31)]; }
    LDS_WAIT();
    const int c = lane & 7;
#pragma unroll
    for (int j = 0; j < 4; ++j) { const int n = (lane >> 3) + 8 * j; const LAS float* s = scr + (8 * c) * 33 + n;
        u32x4 o; o.x = cvt_pk_bf16(s[0 * 33], s[1 * 33]); o.y = cvt_pk_bf16(s[2 * 33], s[3 * 33]); o.z = cvt_pk_bf16(s[4 * 33], s[5 * 33]); o.w = cvt_pk_bf16(s[6 * 33], s[7 * 33]);
        *(u32x4*)(WT + (size_t)(n0 + n) * K + k0 + 8 * c) = o; }
    LDS_WAIT();
}

__device__ __forceinline__ void phase0(const Params& p, LAS unsigned char* lds, int tid, int wave, int lane) {
    float* mod = (float*)(p.ws + WS_MOD);
    LAS float* sc = (LAS float*)lds;
    for (int i = tid; i < 9 * D; i += 512) { const int r = i >> 11, k = i & (D - 1); const float v = r < 8 ? p.c[r * D + k] : p.c_ctx[k]; sc[i] = silu(v); }
    __syncthreads();
    for (int cb = blockIdx.x; cb < 256; cb += gridDim.x) {
        if (wave < 6) {
            const int n0 = cb * 24 + wave * 4;
            float acc[9][4];
#pragma unroll
            for (int r = 0; r < 9; ++r)
#pragma unroll
                for (int j = 0; j < 4; ++j) acc[r][j] = 0.f;
            for (int i = 0; i < 32; ++i) { const int k = lane + 64 * i; const f32x4 w = *(const f32x4*)(p.ada_w + (size_t)k * (3 * D) + n0);
#pragma unroll
                for (int r = 0; r < 9; ++r) { const float s = sc[r * D + k]; acc[r][0] += s * w.x; acc[r][1] += s * w.y; acc[r][2] += s * w.z; acc[r][3] += s * w.w; } }
#pragma unroll
            for (int r = 0; r < 9; ++r)
#pragma unroll
                for (int j = 0; j < 4; ++j) { const float v = wave_sum(acc[r][j]); if (lane == 0) mod[r * (3 * D) + n0 + j] = v + p.ada_b[n0 + j]; }
        }
    }
    __syncthreads();
    LAS float* scr = (LAS float*)(lds + wave * 8448);
    const int gw = blockIdx.x * 8 + wave, NGW = gridDim.x * 8;
    bf16_t* wt_in = (bf16_t*)((unsigned char*)p.out + DO_WTIN);
    constexpr int I_IN = (D / 64) * (NC1 / 32);
    for (int it = gw; it < I_IN; it += NGW) transpose_item(p.w_in, D, NCOLS, NC1, wt_in, scr, it, lane);
    bf16_t* w2t = (bf16_t*)(p.ws + WS_W2T);
    const int gt = blockIdx.x * 512 + tid, NGT = gridDim.x * 512;
    for (int i = gt; i < 4 * 1024 * 8; i += NGT) { const int mat = i >> 13, n = (i >> 3) & 1023, k8 = i & 7;
        const float* src = (mat < 2 ? p.rw_w2 + (size_t)mat * 64 * 1024 : p.rw_a2 + (size_t)(mat - 2) * 64 * 1024) + n;
        float v[8];
#pragma unroll
        for (int j = 0; j < 8; ++j) v[j] = src[(size_t)(k8 * 8 + j) * 1024];
        stbf<8>(w2t + ((size_t)mat * 1024 + n) * 64 + k8 * 8, v); }
    float* lb = (float*)(p.ws + WS_LB);
    for (int i = gt; i < 2048; i += NGT) { const int d = i >> 10, j = i & 1023; const float a = p.hg_lb[(d * 2 + 0) * 1024 + j], b = p.hg_lb[(d * 2 + 1) * 1024 + j]; lb[i] = 1.f / (1.f + __expf(b - a)); }
}

__device__ __forceinline__ void phase1(const Params& p, bf16_t* H, int nrows, int wave, int lane) {
    const float* mod = (const float*)(p.ws + WS_MOD);
    const int gw = blockIdx.x * 8 + wave, NGW = gridDim.x * 8;
    for (int row = gw; row < nrows; row += NGW) {
        const float* xr = row < MLAT ? p.x + (size_t)row * D : p.ctx + (size_t)(row - MLAT) * D;
        const int mr = row < MLAT ? (row >> 11) : 8;
        const float* shift = mod + mr * (3 * D); const float* scale = shift + D;
        f32x4 v[8]; float ss = 0.f;
#pragma unroll
        for (int j = 0; j < 8; ++j) { v[j] = ((const f32x4*)xr)[lane + 64 * j]; ss += (v[j].x * v[j].x + v[j].y * v[j].y) + (v[j].z * v[j].z + v[j].w * v[j].w); }
        ss = wave_sum(ss);
        const float rstd = rsqrtf(ss * (1.f / D) + 1e-6f);
#pragma unroll
        for (int j = 0; j < 8; ++j) { const int c = 4 * (lane + 64 * j);
            const f32x4 g = *(const f32x4*)(p.norm_g + c), s1 = *(const f32x4*)(scale + c), s0 = *(const f32x4*)(shift + c);
            float o[4]; o[0] = v[j].x * rstd * g.x * (1.f + s1.x) + s0.x; o[1] = v[j].y * rstd * g.y * (1.f + s1.y) + s0.y; o[2] = v[j].z * rstd * g.z * (1.f + s1.z) + s0.z; o[3] = v[j].w * rstd * g.w * (1.f + s1.w) + s0.w;
            stbf<4>(H + (size_t)row * D + c, o); }
    }
}

struct EpiProj {
    static constexpr bool PERM = true, AFTER_DRAIN = false, CHAIN = false;
    unsigned char* ws;
    template <int ACT> __device__ __forceinline__ void run(const f32x4 (&acc)[2][2][4][2], bf16_t* base, int ld, int row0, int col0, const float* lb) const {
        float lbv[2][8];
        if constexpr (ACT == 3) {
#pragma unroll
            for (int bj = 0; bj < 2; ++bj) ldf<8>(lb + col0 + bj * 128, lbv[bj]); }
#pragma unroll
        for (int ai = 0; ai < 2; ++ai)
#pragma unroll
            for (int m = 0; m < 4; ++m) { bf16_t* rowp = base + (size_t)(row0 + ai * 128 + m * 16) * ld + col0;
#pragma unroll
                for (int bj = 0; bj < 2; ++bj) { float v[8];
#pragma unroll
                    for (int i = 0; i < 4; ++i) { v[i] = acc[ai][bj][m][0][i]; v[4 + i] = acc[ai][bj][m][1][i]; }
#pragma unroll
                    for (int i = 0; i < 8; ++i) {
                        if constexpr (ACT == 1) v[i] = silu(v[i]);
                        if constexpr (ACT == 2) v[i] = sigm(v[i]);
                        if constexpr (ACT == 3) v[i] = __logf(lbv[bj][i] + (1.f - lbv[bj][i]) * sigm(v[i])); }
                    stbf<8>(rowp + bj * 128, v); } }
    }
    __device__ __forceinline__ void operator()(const f32x4 (&acc)[2][2][4][2], const Unit& u, int wr, int wc, int fr, int fq) const {
        const int pn = u.pn; const int row0 = u.pm * 256 + wr * 64 + fr, cw = wc * 32 + 8 * fq;
        const float* lb = (const float*)(ws + WS_LB);
        if (pn < 4) run<1>(acc, (bf16_t*)(ws + WS_PQ), 1024, row0, pn * 256 + cw, lb);
        else if (pn < 8) run<0>(acc, (bf16_t*)(ws + WS_PI), 1024, row0, (pn - 4) * 256 + cw, lb);
        else if (pn < 12) run<3>(acc, (bf16_t*)(ws + WS_PGF), 1024, row0, (pn - 8) * 256 + cw, lb);
        else if (pn < 16) run<3>(acc, (bf16_t*)(ws + WS_PGB), 1024, row0, (pn - 12) * 256 + cw, lb + 1024);
        else if (pn < 20) run<1>(acc, (bf16_t*)(ws + WS_PZ), 1024, row0, (pn - 16) * 256 + cw, lb);
        else if (pn < 33) run<0>(acc, (bf16_t*)(ws + WS_PRW), SHC, row0, (pn - 20) * 256 + cw, lb);
        else run<1>(acc, (bf16_t*)(ws + WS_PZRW), 1024, row0, (pn - 33) * 256 + cw, lb);
    }
};

struct InOrder {
    int G, c;
    __device__ bool next(int i, Unit& u) const {
        const int L = i * G + c;
        if (L < 2368) { pg8::StaticOrder so; so.init(MLAT, NC1, G, c); return so.next(i, u); }
        if (L >= 2368 + 168) return false;
        const int idx = L - 2368, j = idx % 21; u.pm = 64 + idx / 21; u.pn = j < 12 ? 4 + j : 12 + j; return true;
    }
    __device__ __forceinline__ void a_ready(const Unit&) const {}
    __device__ __forceinline__ void done(const Unit&) const {}
};
struct EpiGate {
    static constexpr bool PERM = true, AFTER_DRAIN = false, CHAIN = false;
    unsigned char* ws;
    __device__ __forceinline__ void operator()(const f32x4 (&acc)[2][2][4][2], const Unit& u, int wr, int wc, int fr, int fq) const {
        EpiProj e{ws};
        e.run<2>(acc, (bf16_t*)(ws + WS_PGATE), 4096, u.pm * 256 + wr * 64 + fr, u.pn * 256 + wc * 32 + 8 * fq, nullptr);
    }
};

__device__ __forceinline__ void hg_scan(const Params& p, LAS unsigned char* lds, int tid, int wave, int lane) {
    LAS bf16_t* qd = (LAS bf16_t*)(lds);
    LAS bf16_t* kd = (LAS bf16_t*)(lds + 17408);
    LAS bf16_t* kdT = (LAS bf16_t*)(lds + 34816);
    LAS bf16_t* vT = (LAS bf16_t*)(lds + 53248);
    LAS bf16_t* ST = (LAS bf16_t*)(lds + 62464);
    LAS bf16_t* at = (LAS bf16_t*)(lds + 79872);
    LAS float* tot = (LAS float*)(lds + 89088);
    const bf16_t* Pq = (const bf16_t*)(p.ws + WS_PQ); const bf16_t* Pi = (const bf16_t*)(p.ws + WS_PI);
    bf16_t* Obase = (bf16_t*)((unsigned char*)p.out + DO_O);
    const int l15 = lane & 15, fq = lane >> 4;
    for (int u = blockIdx.x; u < 256; u += gridDim.x) {
        const int b = u >> 5, h = (u >> 2) & 7, dir = (u >> 1) & 1, vh = u & 1;
        const bf16_t* Pg = (const bf16_t*)(p.ws + (dir ? WS_PGB : WS_PGF));
        bf16_t* O = Obase + (size_t)dir * MLAT * 1024;
        const int k0 = 2 * lane, e8 = wave, vs = tid >> 3, vn8 = tid & 7;
        const int sgn = dir ? -1 : 1;
        auto rbase = [&](int c) -> long { if (c < 4) return MLAT + b * CTXL + (dir ? (CTXL - 1 - c * 64) : c * 64); const int t0 = (c - 4) * 64; return b * SEQ + (dir ? (SEQ - 1 - t0) : t0); };
        const long rstep = (long)sgn * 1024;
        f32x4 S[4];
#pragma unroll
        for (int i = 0; i < 4; ++i) S[i] = (f32x4){0.f, 0.f, 0.f, 0.f};
        unsigned gN[8], qN[8]; u32x4 vN;
        { const long rb = rbase(0); const bf16_t* gp = Pg + (rb + sgn * (e8 * 8)) * 1024 + h * 128 + k0; const bf16_t* qp_ = Pq + (rb + sgn * (e8 * 8)) * 1024 + h * 128 + k0;
#pragma unroll
          for (int j = 0; j < 8; ++j) { gN[j] = *(const unsigned*)(gp + j * rstep); qN[j] = *(const unsigned*)(qp_ + j * rstep); }
          vN = *(const u32x4*)(Pi + (rb + sgn * vs) * 1024 + h * 128 + vh * 64 + vn8 * 8); }
        for (int c = 0; c < 36; ++c) {
            unsigned g[8], q[8]; const u32x4 vC = vN;
#pragma unroll
            for (int j = 0; j < 8; ++j) { g[j] = gN[j]; q[j] = qN[j]; }
            if (c + 1 < 36) {
                const long rb1 = rbase(c + 1); const bf16_t* gp = Pg + (rb1 + sgn * (e8 * 8)) * 1024 + h * 128 + k0; const bf16_t* qp_ = Pq + (rb1 + sgn * (e8 * 8)) * 1024 + h * 128 + k0;
#pragma unroll
                for (int j = 0; j < 8; ++j) { gN[j] = *(const unsigned*)(gp + j * rstep); qN[j] = *(const unsigned*)(qp_ + j * rstep); }
                vN = *(const u32x4*)(Pi + (rb1 + sgn * vs) * 1024 + h * 128 + vh * 64 + vn8 * 8);
            }
            float run0 = 0.f, run1 = 0.f;
#pragma unroll
            for (int j = 0; j < 8; ++j) { run0 += bflo(g[j]); run1 += bfhi(g[j]); }
            *(LAS f32x2*)(tot + e8 * 128 + k0) = (f32x2){run0, run1};
            __syncthreads();
            {
                float off0 = 0.f, off1 = 0.f, mid0 = 0.f, mid1 = 0.f;
#pragma unroll
                for (int i = 0; i < 8; ++i) { const f32x2 t = *(const LAS f32x2*)(tot + i * 128 + k0); if (i < e8) { off0 += t.x; off1 += t.y; } if (i < 4) { mid0 += t.x; mid1 += t.y; } }
                unsigned kp0[4], kp1[4]; float bc0 = off0, bc1 = off1;
#pragma unroll
                for (int j = 0; j < 8; j += 2) {
                    float kv0[2], kv1[2];
#pragma unroll
                    for (int e = 0; e < 2; ++e) { const int jj = j + e;
                        bc0 += bflo(g[jj]); bc1 += bfhi(g[jj]);
                        const float E0 = __expf(__builtin_amdgcn_fmed3f(bc0 - mid0, -80.f, 80.f)), E1 = __expf(__builtin_amdgcn_fmed3f(bc1 - mid1, -80.f, 80.f));
                        const float qv0 = bflo(q[jj]) * E0, qv1 = bfhi(q[jj]) * E1;
                        kv0[e] = (1.f - __expf(bflo(g[jj]))) * __builtin_amdgcn_rcpf(E0); kv1[e] = (1.f - __expf(bfhi(g[jj]))) * __builtin_amdgcn_rcpf(E1);
                        const int t = e8 * 8 + jj;
                        *(LAS unsigned*)(qd + t * 136 + k0) = cvt_pk_bf16(qv0, qv1); *(LAS unsigned*)(kd + t * 136 + k0) = cvt_pk_bf16(kv0[e], kv1[e]); }
                    kp0[j >> 1] = cvt_pk_bf16(kv0[0], kv0[1]); kp1[j >> 1] = cvt_pk_bf16(kv1[0], kv1[1]);
                }
                *(LAS u32x4*)(kdT + k0 * 72 + e8 * 8) = (u32x4){kp0[0], kp0[1], kp0[2], kp0[3]};
                *(LAS u32x4*)(kdT + (k0 + 1) * 72 + e8 * 8) = (u32x4){kp1[0], kp1[1], kp1[2], kp1[3]};
                float em[4];
#pragma unroll
                for (int j = 0; j < 4; ++j) { const int kj = 16 * wave + fq * 4 + j; em[j] = __expf((tot[kj] + tot[128 + kj]) + (tot[256 + kj] + tot[384 + kj])); }
#pragma unroll
                for (int nt = 0; nt < 4; ++nt) { u32x2 w; w.x = cvt_pk_bf16(S[nt][0] * em[0], S[nt][1] * em[1]); w.y = cvt_pk_bf16(S[nt][2] * em[2], S[nt][3] * em[3]);
                    *(LAS u32x2*)(ST + (nt * 16 + l15) * 136 + 16 * wave + fq * 4) = w; }
                const unsigned vw[4] = {vC.x, vC.y, vC.z, vC.w};
#pragma unroll
                for (int i = 0; i < 4; ++i) { vT[(vn8 * 8 + 2 * i) * 72 + vs] = (bf16_t)(vw[i] & 0xffffu); vT[(vn8 * 8 + 2 * i + 1) * 72 + vs] = (bf16_t)(vw[i] >> 16); }
            }
            __syncthreads();
            const bool lat = c >= 4;
            if (lat) {
#pragma unroll
                for (int q2 = 0; q2 < 2; ++q2) { const int id = 2 * wave + q2, tt = id >> 2, st = id & 3;
                    f32x4 a = (f32x4){0.f, 0.f, 0.f, 0.f};
                    if (st <= tt) {
#pragma unroll
                        for (int ks = 0; ks < 4; ++ks) { const bf16x8 A = *(const LAS bf16x8*)(kd + (st * 16 + l15) * 136 + ks * 32 + fq * 8); const bf16x8 B = *(const LAS bf16x8*)(qd + (tt * 16 + l15) * 136 + ks * 32 + fq * 8); a = mfma16(A, B, a); } }
                    { const int t = tt * 16 + l15, s0 = st * 16 + fq * 4; u32x2 w; w.x = cvt_pk_bf16(s0 <= t ? a[0] : 0.f, s0 + 1 <= t ? a[1] : 0.f); w.y = cvt_pk_bf16(s0 + 2 <= t ? a[2] : 0.f, s0 + 3 <= t ? a[3] : 0.f);
                      *(LAS u32x2*)(at + t * 72 + s0) = w; } }
            }
            __syncthreads();
            if (lat) {
                const long rb = rbase(c);
#pragma unroll
                for (int q2 = 0; q2 < 2; ++q2) { const int id = 2 * wave + q2, tt = id >> 2, nt = id & 3;
                    f32x4 o = (f32x4){0.f, 0.f, 0.f, 0.f};
#pragma unroll
                    for (int ks = 0; ks < 2; ++ks) { const bf16x8 A = *(const LAS bf16x8*)(vT + (nt * 16 + l15) * 72 + ks * 32 + fq * 8); const bf16x8 B = *(const LAS bf16x8*)(at + (tt * 16 + l15) * 72 + ks * 32 + fq * 8); o = mfma16(A, B, o); }
#pragma unroll
                    for (int ks = 0; ks < 4; ++ks) { const bf16x8 A = *(const LAS bf16x8*)(ST + (nt * 16 + l15) * 136 + ks * 32 + fq * 8); const bf16x8 B = *(const LAS bf16x8*)(qd + (tt * 16 + l15) * 136 + ks * 32 + fq * 8); o = mfma16(A, B, o); }
                    { const long row = rb + sgn * (tt * 16 + l15); u32x2 w; w.x = cvt_pk_bf16(o[0], o[1]); w.y = cvt_pk_bf16(o[2], o[3]);
                      *(u32x2*)(O + row * 1024 + h * 128 + vh * 64 + nt * 16 + fq * 4) = w; } }
            }
            {
                float eb[4], e2[4];
#pragma unroll
                for (int j = 0; j < 4; ++j) { const int kj = 16 * wave + fq * 4 + j; const float m = (tot[kj] + tot[128 + kj]) + (tot[256 + kj] + tot[384 + kj]), bl = m + ((tot[512 + kj] + tot[640 + kj]) + (tot[768 + kj] + tot[896 + kj])); eb[j] = __expf(bl); e2[j] = __expf(bl - m); }
#pragma unroll
                for (int nt = 0; nt < 4; ++nt) { f32x4 tmp = (f32x4){0.f, 0.f, 0.f, 0.f};
#pragma unroll
                    for (int ks = 0; ks < 2; ++ks) { const bf16x8 A = *(const LAS bf16x8*)(kdT + (16 * wave + l15) * 72 + ks * 32 + fq * 8); const bf16x8 B = *(const LAS bf16x8*)(vT + (nt * 16 + l15) * 72 + ks * 32 + fq * 8); tmp = mfma16(A, B, tmp); }
#pragma unroll
                    for (int j = 0; j < 4; ++j) S[nt][j] = eb[j] * S[nt][j] + e2[j] * tmp[j]; }
            }
            __syncthreads();
        }
    }
}

__device__ __forceinline__ void post_hg(const Params& p, int wave, int lane) {
    const bf16_t* O0 = (const bf16_t*)((unsigned char*)p.out + DO_O); const bf16_t* O1 = O0 + (size_t)MLAT * 1024;
    const bf16_t* Pz = (const bf16_t*)(p.ws + WS_PZ); bf16_t* Y = (bf16_t*)(p.ws + WS_YHG);
    const int gw = blockIdx.x * 8 + wave, NGW = gridDim.x * 8, c0 = lane * 16;
    float g[16]; ldf<16>(p.hg_norm_g + c0, g);
    for (int tok = gw; tok < MLAT; tok += NGW) {
        float a[16], bq[16], z[16];
        ldbf<16>(O0 + (size_t)tok * 1024 + c0, a); ldbf<16>(O1 + (size_t)tok * 1024 + c0, bq); ldbf<16>(Pz + (size_t)tok * 1024 + c0, z);
        float ss = 0.f;
#pragma unroll
        for (int i = 0; i < 16; ++i) { a[i] += bq[i]; ss += a[i] * a[i]; }
        ss += __shfl_xor(ss, 1); ss += __shfl_xor(ss, 2); ss += __shfl_xor(ss, 4);
        const float rstd = rsqrtf(ss * (1.f / 128.f) + 1e-6f);
#pragma unroll
        for (int i = 0; i < 16; ++i) a[i] = a[i] * rstd * g[i] * z[i];
        stbf<16>(Y + (size_t)tok * 1024 + c0, a);
    }
}

__device__ __forceinline__ void rw_prep(const Params& p, LAS unsigned char* lds, int wave, int lane) {
    const bf16_t* Prw = (const bf16_t*)(p.ws + WS_PRW); const bf16_t* w2t = (const bf16_t*)(p.ws + WS_W2T);
    bf16_t* E0 = (bf16_t*)(p.ws + WS_E0); bf16_t* E1 = (bf16_t*)(p.ws + WS_E1); bf16_t* A0 = (bf16_t*)(p.ws + WS_A0); bf16_t* A1 = (bf16_t*)(p.ws + WS_A1);
    float* rn = (float*)(p.ws + WS_RN); float* bonus = (float*)(p.ws + WS_BONUS);
    const int l15 = lane & 15, fq = lane >> 4;
    LAS f32x4* cst = (LAS f32x4*)(lds + 8192) + wave * 480;
    for (int idx = lane; idx < 480; idx += 64) { const int nt8 = idx / 60, rem = idx % 60, arr = rem >> 2, fqi = rem & 3, chc = (wave * 2 + (nt8 >> 2)) * 64 + (nt8 & 3) * 16 + fqi * 4;
        const float* sp = arr < 4 ? p.rw_mu + arr * SHC + chc : arr < 8 ? p.rw_mu + (arr - 4) * SHC + 1024 + chc : arr == 8 ? p.rw_w0 + chc : arr == 9 ? p.rw_w0 + 1024 + chc : arr == 10 ? p.rw_a0 + chc : arr == 11 ? p.rw_a0 + 1024 + chc
                        : arr == 12 ? p.rw_kk + chc : arr == 13 ? p.rw_ka + chc : p.rw_rk + chc;
        cst[idx] = *(const f32x4*)sp; }
    const bool xmap = gridDim.x == 256; const int nmine = xmap ? (blockIdx.x < 128 ? 5 : 4) : ((MTOT / 16 - 1 - (int)blockIdx.x) / (int)gridDim.x + 1);
    const int rgrow = ((int)(blockIdx.x & 7) * 32 + (int)(blockIdx.x >> 3)) * 4;
    for (int it = 0; it < nmine; ++it) {
        const int tile = xmap ? (it < 4 ? rgrow + it : 1024 + (int)blockIdx.x) : ((int)blockIdx.x + it * (int)gridDim.x);
        const int hp = wave, R = tile * 16 + l15;
        const Nbr nb = nbr_of(R);
        { const int mat = wave >> 1, ks = wave & 1; float v[8]; shifted<8>(Prw, R, nb, 3072 + mat * 64 + ks * 32 + fq * 8, p.rw_mu, v);
          if (mat < 2) {
#pragma unroll
              for (int i = 0; i < 8; ++i) v[i] = tanh_(v[i]); }
          u32x4 w; w.x = cvt_pk_bf16(v[0], v[1]); w.y = cvt_pk_bf16(v[2], v[3]); w.z = cvt_pk_bf16(v[4], v[5]); w.w = cvt_pk_bf16(v[6], v[7]);
          *(LAS u32x4*)(lds + (wave * 64 + lane) * 16) = w; }
        __syncthreads();
        bf16x8 Bf[4][2];
#pragma unroll
        for (int mat = 0; mat < 4; ++mat)
#pragma unroll
            for (int ks = 0; ks < 2; ++ks) Bf[mat][ks] = *(const LAS bf16x8*)(lds + ((mat * 2 + ks) * 64 + lane) * 16);
#pragma unroll 1
        for (int hh = 0; hh < 2; ++hh) { const int head = hp * 2 + hh; float skk = 0.f, sb = 0.f;
#pragma unroll 1
            for (int nt = 0; nt < 4; ++nt) { const int n0 = head * 64 + nt * 16, ch = n0 + fq * 4;
                f32x4 acc[4];
#pragma unroll
                for (int mat = 0; mat < 4; ++mat) { acc[mat] = (f32x4){0.f, 0.f, 0.f, 0.f};
#pragma unroll
                    for (int ks = 0; ks < 2; ++ks) { const bf16x8 A = *(const bf16x8*)(w2t + ((size_t)mat * 1024 + n0 + l15) * 64 + ks * 32 + fq * 8); acc[mat] = mfma16(A, Bf[mat][ks], acc[mat]); } }
                const LAS f32x4* cs = cst + (hh * 4 + nt) * 60 + fq;
                const f32x4 mur[4] = {cs[0], cs[4], cs[8], cs[12]}, muk[4] = {cs[16], cs[20], cs[24], cs[28]};
                float rs[4], ks_[4]; shifted4m(Prw, R, nb, ch, mur, rs); shifted4m(Prw, R, nb, 1024 + ch, muk, ks_);
                const f32x4 w00 = cs[32], w01 = cs[36], a00 = cs[40], a01 = cs[44], kkc = cs[48], kac = cs[52], rkc = cs[56];
                float e0[4], e1[4], a0[4], a1[4];
#pragma unroll
                for (int j = 0; j < 4; ++j) { e0[j] = 0.60653066f * sigm(w00[j] + acc[0][j]); e1[j] = 0.60653066f * sigm(w01[j] + acc[1][j]); a0[j] = sigm(a00[j] + acc[2][j]); a1[j] = sigm(a01[j] + acc[3][j]);
                    const float kr = ks_[j] * kkc[j]; skk += kr * kr; sb += rs[j] * ks_[j] * (2.f + (a0[j] + a1[j] - 2.f) * kac[j]) * rkc[j]; }
                stbf<4>(E0 + (size_t)R * 1024 + ch, e0); stbf<4>(E1 + (size_t)R * 1024 + ch, e1); stbf<4>(A0 + (size_t)R * 1024 + ch, a0); stbf<4>(A1 + (size_t)R * 1024 + ch, a1);
            }
            skk += __shfl_xor(skk, 16); skk += __shfl_xor(skk, 32); sb += __shfl_xor(sb, 16); sb += __shfl_xor(sb, 32);
            if (fq == 0) { rn[(size_t)R * 16 + head] = rsqrtf(skk + 1e-12f); if (R < MLAT) bonus[(size_t)R * 16 + head] = sb; }
        }
        __syncthreads();
    }
}

struct RwVec { f32x4 wA, wB, kA, kB, bA, bB, dA, dB, rA, rB; float v; };
template <bool LAT> __device__ __forceinline__ void rw_ldv(const LAS float* bs, int voff, RwVec& V) {
    V.wA = *(const LAS f32x4*)(bs); V.wB = *(const LAS f32x4*)(bs + 4); V.kA = *(const LAS f32x4*)(bs + 64); V.kB = *(const LAS f32x4*)(bs + 68);
    V.bA = *(const LAS f32x4*)(bs + 128); V.bB = *(const LAS f32x4*)(bs + 132); V.dA = *(const LAS f32x4*)(bs + 192); V.dB = *(const LAS f32x4*)(bs + 196);
    if (LAT) { V.rA = *(const LAS f32x4*)(bs + 256); V.rB = *(const LAS f32x4*)(bs + 260); }
    V.v = bs[voff];
}
template <bool LAT> __device__ __forceinline__ void rw_chunk(const LAS float* cb, int voff, int q, f32x2 (&S)[4], float& ylo, float& yhi) {
    RwVec cur, nxt; rw_ldv<LAT>(cb, voff, cur);
#pragma unroll 2
    for (int s = 0; s < 16; ++s) {
        rw_ldv<LAT>(cb + (s < 15 ? s + 1 : 15) * 384, voff, nxt);
        f32x2 d = S[0] * cur.kA.lo; d = S[1] * cur.kA.hi + d; d = S[2] * cur.kB.lo + d; d = S[3] * cur.kB.hi + d;
        float t = d.x + d.y;
        t += dpp<0xB1>(t); t += dpp<0x4E>(t); t += dpp<0x141>(t);
        const f32x2 vv = {cur.v, cur.v}, ns = {-t, -t};
        S[0] = S[0] * cur.wA.lo + (cur.dA.lo * vv + cur.bA.lo * ns); S[1] = S[1] * cur.wA.hi + (cur.dA.hi * vv + cur.bA.hi * ns);
        S[2] = S[2] * cur.wB.lo + (cur.dB.lo * vv + cur.bB.lo * ns); S[3] = S[3] * cur.wB.hi + (cur.dB.hi * vv + cur.bB.hi * ns);
        if (LAT) {
            d = S[0] * cur.rA.lo; d = S[1] * cur.rA.hi + d; d = S[2] * cur.rB.lo + d; d = S[3] * cur.rB.hi + d;
            float y = d.x + d.y;
            y += dpp<0xB1>(y); y += dpp<0x4E>(y); y += dpp<0x141>(y);
            if (s < 8) ylo = (q == (s & 7)) ? y : ylo; else yhi = (q == (s & 7)) ? y : yhi;
        }
        cur = nxt;
    }
}
struct RwRegs { unsigned raw[3][5]; unsigned e, a; float rn; unsigned vmask; };
__device__ __forceinline__ void rw_scan(const Params& p, LAS unsigned char* lds, int tid, int wave, int lane) {
    LAS float* buf = (LAS float*)lds;
    const bf16_t* Prw = (const bf16_t*)(p.ws + WS_PRW); const float* rnp = (const float*)(p.ws + WS_RN);
    bf16_t* Ybase = (bf16_t*)((unsigned char*)p.out + DO_Y);
    for (int u = blockIdx.x; u < 256; u += gridDim.x) {
        const int b = u >> 5, h = (u >> 1) & 15, dir = u & 1;
        const bf16_t* Ed = (const bf16_t*)(p.ws + (dir ? WS_E1 : WS_E0)); const bf16_t* Ad = (const bf16_t*)(p.ws + (dir ? WS_A1 : WS_A0));
        bf16_t* Y = Ybase + (size_t)dir * MLAT * 1024;
        const int ls = tid >> 5, cp = tid & 31, ch = h * 64 + 2 * cp;
        float mu_[3][4][2];
#pragma unroll
        for (int a = 0; a < 3; ++a)
#pragma unroll
            for (int m = 0; m < 4; ++m) { const f32x2 t = *(const f32x2*)(p.rw_mu + m * SHC + a * 1024 + ch); mu_[a][m][0] = t.x; mu_[a][m][1] = t.y; }
        float c0v[3][2], c0h[3][2];
#pragma unroll
        for (int a = 0; a < 3; ++a)
#pragma unroll
            for (int e = 0; e < 2; ++e) { c0h[a][e] = 1.f - (mu_[a][0][e] + mu_[a][1][e]); c0v[a][e] = c0h[a][e] - (mu_[a][2][e] + mu_[a][3][e]); }
        const f32x2 kkc = *(const f32x2*)(p.rw_kk + ch), kac = *(const f32x2*)(p.rw_ka + ch);
        auto rowof = [&](int tau) -> int { if (tau < CTXL) { const int t = dir ? (CTXL - 1 - tau) : tau; return MLAT + b * CTXL + t; } const int t0 = tau - CTXL; const int t = dir ? (SEQ - 1 - t0) : t0; return b * SEQ + t; };
        const char* PrwA[3] = {(const char*)Prw, (const char*)Prw + 2048, (const char*)Prw + 4096};
        const int lsgn = dir ? -ls : ls;
        auto issue = [&](int c, RwRegs& r) { const int R = rowof(c * 16) + lsgn; const bool lat = c >= 16;
            const int t = lat ? (R & (SEQ - 1)) : ((R - MLAT) & (CTXL - 1));
            const bool vL = lat ? (t & 63) > 0 : t > 0, vR = lat ? (t & 63) < 63 : t < CTXL - 1, vU = lat && t >= 64, vD = lat && t < SEQ - 64;
            const unsigned oS = (unsigned)R * (unsigned)(SHC * 2) + (unsigned)(ch * 2);
            const unsigned oL = vL ? oS - SHC * 2 : oS, oR = vR ? oS + SHC * 2 : oS, oU = vU ? oS - 64 * SHC * 2 : oS, oD = vD ? oS + 64 * SHC * 2 : oS;
#pragma unroll
            for (int a = 0; a < 3; ++a) { r.raw[a][0] = *(const unsigned*)(PrwA[a] + oS); r.raw[a][1] = *(const unsigned*)(PrwA[a] + oL); r.raw[a][2] = *(const unsigned*)(PrwA[a] + oR);
                r.raw[a][3] = *(const unsigned*)(PrwA[a] + oU); r.raw[a][4] = *(const unsigned*)(PrwA[a] + oD); }
            r.e = *(const unsigned*)((const char*)Ed + (unsigned)R * 2048u + (unsigned)(ch * 2)); r.a = *(const unsigned*)((const char*)Ad + (unsigned)R * 2048u + (unsigned)(ch * 2)); r.rn = rnp[(unsigned)R * 16u + (unsigned)h];
            r.vmask = (vL ? 1u : 0u) | (vR ? 2u : 0u) | (vU ? 4u : 0u) | (vD ? 8u : 0u); };
        auto stage = [&](int c, const RwRegs& r) { LAS float* bs = buf + ((c & 1) * 16 + ls) * 384 + 2 * cp; const bool vert = c >= 16;
            float sh[3][2];
#pragma unroll
            for (int a = 0; a < 3; ++a) {
                const unsigned rl = (r.vmask & 1u) ? r.raw[a][1] : 0u, rr_ = (r.vmask & 2u) ? r.raw[a][2] : 0u, ru = (r.vmask & 4u) ? r.raw[a][3] : 0u, rd = (r.vmask & 8u) ? r.raw[a][4] : 0u;
#pragma unroll
                for (int e = 0; e < 2; ++e) { const float pv = e ? bfhi(r.raw[a][0]) : bflo(r.raw[a][0]), l = e ? bfhi(rl) : bflo(rl), rr = e ? bfhi(rr_) : bflo(rr_), up = e ? bfhi(ru) : bflo(ru), dn = e ? bfhi(rd) : bflo(rd);
                    const float c0 = vert ? c0v[a][e] : c0h[a][e];
                    sh[a][e] = c0 * pv + mu_[a][0][e] * l + mu_[a][1][e] * rr + mu_[a][2][e] * up + mu_[a][3][e] * dn; } }
            f32x2 w, kk, bb, kd, rr2, vv;
#pragma unroll
            for (int e = 0; e < 2; ++e) { const float ev = e ? bfhi(r.e) : bflo(r.e), av = e ? bfhi(r.a) : bflo(r.a); const float ksh = sh[1][e];
                const float kkv = ksh * kkc[e] * r.rn;
                w[e] = __expf(-ev); kk[e] = kkv; bb[e] = kkv * av; kd[e] = ksh * (1.f + (av - 1.f) * kac[e]); rr2[e] = sh[0][e]; vv[e] = sh[2][e]; }
            *(LAS f32x2*)(bs + 0) = w; *(LAS f32x2*)(bs + 64) = kk; *(LAS f32x2*)(bs + 128) = bb; *(LAS f32x2*)(bs + 192) = kd; *(LAS f32x2*)(bs + 256) = rr2; *(LAS f32x2*)(bs + 320) = vv; };
        const int q = lane & 7, row = wave * 8 + (lane >> 3);
        f32x2 S[4];
#pragma unroll
        for (int i = 0; i < 4; ++i) S[i] = (f32x2){0.f, 0.f};
        RwRegs regs;
        issue(0, regs); stage(0, regs);
        __syncthreads();
        const int voff = 320 - q * 8 + row; const long ysgn = dir ? -1 : 1;
        for (int c = 0; c < 144; ++c) {
            if (c + 1 < 144) issue(c + 1, regs);
            const LAS float* cb = buf + (c & 1) * (16 * 384) + q * 8;
            if (c < 16) { float y0 = 0.f, y1 = 0.f; rw_chunk<false>(cb, voff, q, S, y0, y1); }
            else { float y0 = 0.f, y1 = 0.f; rw_chunk<true>(cb, voff, q, S, y0, y1);
                const long rb = rowof(c * 16);
                bf16_t* yp = Y + (rb + ysgn * q) * 1024 + h * 64 + row;
                yp[0] = f2bf(y0); yp[ysgn * 8 * 1024] = f2bf(y1); }
            if (c + 1 < 144) stage(c + 1, regs);
            __syncthreads();
        }
    }
}

__device__ __forceinline__ void post_rw(const Params& p, LAS unsigned char* lds, int wave, int lane) {
    const bf16_t* Y0 = (const bf16_t*)((unsigned char*)p.out + DO_Y); const bf16_t* Y1 = Y0 + (size_t)MLAT * 1024;
    const bf16_t* Prw = (const bf16_t*)(p.ws + WS_PRW); const bf16_t* Pzrw = (const bf16_t*)(p.ws + WS_PZRW); const float* bonus = (const float*)(p.ws + WS_BONUS);
    bf16_t* Yo = (bf16_t*)(p.ws + WS_YRW);
    const int gw = blockIdx.x * 8 + wave, NGW = gridDim.x * 8, c0 = lane * 16, head = lane >> 2;
    float gg[16], gb[16]; ldf<16>(p.rw_gn_g + c0, gg); ldf<16>(p.rw_gn_b + c0, gb);
    for (int tok = gw; tok < MLAT; tok += NGW) {
        float a[16], bq[16], z[16], vs[16];
        ldbf<16>(Y0 + (size_t)tok * 1024 + c0, a); ldbf<16>(Y1 + (size_t)tok * 1024 + c0, bq); ldbf<16>(Pzrw + (size_t)tok * 1024 + c0, z);
        const Nbr nb = nbr_of(tok);
        shifted<16>(Prw, tok, nb, 2048 + c0, p.rw_mu, vs);
        float s = 0.f;
#pragma unroll
        for (int i = 0; i < 16; ++i) { a[i] += bq[i]; s += a[i]; }
        s += __shfl_xor(s, 1); s += __shfl_xor(s, 2);
        const float mean = s * (1.f / 64.f); float vr = 0.f;
#pragma unroll
        for (int i = 0; i < 16; ++i) { a[i] -= mean; vr += a[i] * a[i]; }
        vr += __shfl_xor(vr, 1); vr += __shfl_xor(vr, 2);
        const float rstd = rsqrtf(vr * (1.f / 64.f) + 64e-5f), bon = bonus[(size_t)tok * 16 + head];
#pragma unroll
        for (int i = 0; i < 16; ++i) a[i] = (a[i] * rstd * gg[i] + gb[i] + bon * vs[i]) * z[i];
        stbf<16>(Yo + (size_t)tok * 1024 + c0, a);
    }
    LAS float* scr = (LAS float*)(lds + wave * 8448);
    bf16_t* wto1 = (bf16_t*)(p.ws + WS_WTO1); bf16_t* wto2 = (bf16_t*)(p.ws + WS_WTO2); bf16_t* wtg = (bf16_t*)(p.ws + WS_WTG);
    constexpr int I_1 = (1024 / 64) * (D / 32), I_2 = (D / 64) * (D / 32), I_G = (D / 64) * (4096 / 32);
    for (int it = gw; it < 2 * I_1 + I_2 + I_G; it += NGW) {
        if (it < I_1) transpose_item(p.w_hg_out, 1024, D, D, wto1, scr, it, lane);
        else if (it < 2 * I_1) transpose_item(p.w_rw_out, 1024, D, D, wto1 + (size_t)D * 1024, scr, it - I_1, lane);
        else if (it < 2 * I_1 + I_2) transpose_item(p.w_out, D, D, D, wto2, scr, it - 2 * I_1, lane);
        else transpose_item(p.w_in + NC1, D, NCOLS, 4096, wtg, scr, it - 2 * I_1 - I_2, lane);
    }
}

struct OrderOut1 {
    int G, c;
    __device__ bool next(int i, Unit& u) const { const int tile = (i >> 1) * G + c, br = i & 1; if (tile >= 512) return false; const int pm = tile >> 3, pn = tile & 7;
        if (br == 0) { u.pm = pm; u.pn = pn; } else { u.pm = pm + YRW_PM_OFF; u.pn = pn + 8; } return true; }
    __device__ __forceinline__ void a_ready(const Unit&) const {}
    __device__ __forceinline__ void done(const Unit&) const {}
};
struct EpiOut1 {
    static constexpr bool PERM = true, AFTER_DRAIN = false, CHAIN = true;
    unsigned char* ws;
    __device__ __forceinline__ bool chain(f32x4 (&acc)[2][2][4][2], const Unit& u, int wr, int wc, int fr, int fq) const {
        const int br = u.pn >> 3, ct = u.pn & 7, rt = u.pm & 63;
        const bf16_t* G = (const bf16_t*)(ws + WS_PGATE); bf16_t* Mg = (bf16_t*)(ws + WS_MERGED);
        const int row0 = rt * 256 + wr * 64 + fr, col0 = ct * 256 + wc * 32 + 8 * fq;
#pragma unroll
        for (int ai = 0; ai < 2; ++ai)
#pragma unroll
            for (int m = 0; m < 4; ++m) { const size_t row = (size_t)(row0 + ai * 128 + m * 16);
#pragma unroll
                for (int bj = 0; bj < 2; ++bj) { const int col = col0 + bj * 128; float g2[8]; ldbf<8>(G + row * 4096 + 2048 + col, g2);
#pragma unroll
                    for (int i = 0; i < 8; ++i) g2[i] = fmaxf(g2[i], 1e-30f);
                    if (br == 0) { float g1[8]; ldbf<8>(G + row * 4096 + col, g1);
#pragma unroll
                        for (int i = 0; i < 4; ++i) { acc[ai][bj][m][0][i] *= g1[i] * __builtin_amdgcn_rcpf(g2[i]); acc[ai][bj][m][1][i] *= g1[4 + i] * __builtin_amdgcn_rcpf(g2[4 + i]); } }
                    else { float v[8];
#pragma unroll
                        for (int i = 0; i < 4; ++i) { v[i] = acc[ai][bj][m][0][i] * g2[i]; v[4 + i] = acc[ai][bj][m][1][i] * g2[4 + i]; }
                        stbf<8>(Mg + row * 2048 + col, v); } } }
        return br == 0;
    }
};
struct EpiOut2 {
    static constexpr bool PERM = false, AFTER_DRAIN = false, CHAIN = false;
    const float* x; const float* mod; float* out;
    __device__ __forceinline__ void operator()(const f32x4 (&acc)[2][2][4][2], const Unit& u, int wr, int wc, int fr, int fq) const {
        const int row0 = u.pm * 256 + wr * 64 + fr, col0 = u.pn * 256 + wc * 32 + 4 * fq;
#pragma unroll
        for (int ai = 0; ai < 2; ++ai)
#pragma unroll
            for (int m = 0; m < 4; ++m) { const int row = row0 + ai * 128 + m * 16; const float* gate = mod + (row >> 11) * (3 * D) + 2 * D;
#pragma unroll
                for (int bj = 0; bj < 2; ++bj)
#pragma unroll
                    for (int n = 0; n < 2; ++n) { const int col = col0 + bj * 128 + n * 16; const f32x4 xv = *(const f32x4*)(x + (size_t)row * D + col), gv = *(const f32x4*)(gate + col);
                        *(f32x4*)(out + (size_t)row * D + col) = xv + gv * acc[ai][bj][m][n]; } }
    }
};
__device__ __forceinline__ void final_norm(const Params& p, int wave, int lane) {
    const int gw = blockIdx.x * 8 + wave, NGW = gridDim.x * 8;
    for (int row = gw; row < MLAT; row += NGW) {
        f32x4* xr = (f32x4*)(p.out + (size_t)row * D);
        f32x4 v[8]; float ss = 0.f;
#pragma unroll
        for (int j = 0; j < 8; ++j) { v[j] = xr[lane + 64 * j]; ss += (v[j].x * v[j].x + v[j].y * v[j].y) + (v[j].z * v[j].z + v[j].w * v[j].w); }
        ss = wave_sum(ss);
        const float rstd = rsqrtf(ss * (1.f / D) + 1e-6f);
#pragma unroll
        for (int j = 0; j < 8; ++j) { const f32x4 g = *(const f32x4*)(p.final_g + 4 * (lane + 64 * j)); xr[lane + 64 * j] = v[j] * rstd * g; }
    }
}


__device__ __forceinline__ void rw_scan4(const Params& p, LAS unsigned char* lds, int tid, int wave, int lane) {
    LAS float* buf = (LAS float*)lds;
    const bf16_t* Prw = (const bf16_t*)(p.ws + WS_PRW); const float* rnp = (const float*)(p.ws + WS_RN);
    bf16_t* Ybase = (bf16_t*)((unsigned char*)p.out + DO_Y);
    for (int u = blockIdx.x; u < 256; u += gridDim.x) {
        const int b = u >> 5, h = (u >> 1) & 15, dir = u & 1;
        const bf16_t* Ed = (const bf16_t*)(p.ws + (dir ? WS_E1 : WS_E0)); const bf16_t* Ad = (const bf16_t*)(p.ws + (dir ? WS_A1 : WS_A0));
        bf16_t* Y = Ybase + (size_t)dir * MLAT * 1024;
        const int ls0 = tid >> 5, cp = tid & 31, ch = h * 64 + 2 * cp;
        float mu_[3][4][2];
#pragma unroll
        for (int a = 0; a < 3; ++a)
#pragma unroll
            for (int m = 0; m < 4; ++m) { const f32x2 t = *(const f32x2*)(p.rw_mu + m * SHC + a * 1024 + ch); mu_[a][m][0] = t.x; mu_[a][m][1] = t.y; }
        const f32x2 kkc = *(const f32x2*)(p.rw_kk + ch), kac = *(const f32x2*)(p.rw_ka + ch);
        auto rowof = [&](int tau) -> int { if (tau < CTXL) { const int t = dir ? (CTXL - 1 - tau) : tau; return MLAT + b * CTXL + t; } const int t0 = tau - CTXL; const int t = dir ? (SEQ - 1 - t0) : t0; return b * SEQ + t; };
        auto issue = [&](int c, int ls, RwRegs& r) { const int R = rowof(c * 16 + ls); const Nbr nb = nbr_of(R);
#pragma unroll
            for (int a = 0; a < 3; ++a) { const bf16_t* base = Prw + a * 1024 + ch;
                r.raw[a][0] = *(const unsigned*)(base + (size_t)R * SHC);
                r.raw[a][1] = nb.L >= 0 ? *(const unsigned*)(base + (size_t)nb.L * SHC) : 0u;
                r.raw[a][2] = nb.R >= 0 ? *(const unsigned*)(base + (size_t)nb.R * SHC) : 0u;
                r.raw[a][3] = nb.U >= 0 ? *(const unsigned*)(base + (size_t)nb.U * SHC) : 0u;
                r.raw[a][4] = nb.Dn >= 0 ? *(const unsigned*)(base + (size_t)nb.Dn * SHC) : 0u; }
            r.e = *(const unsigned*)(Ed + (size_t)R * 1024 + ch); r.a = *(const unsigned*)(Ad + (size_t)R * 1024 + ch); r.rn = rnp[(size_t)R * 16 + h]; };
        auto stage = [&](int c, int ls, const RwRegs& r) { LAS float* bs = buf + ((c & 1) * 16 + ls) * 384 + 2 * cp; const bool vert = c >= 16;
            float sh[3][2];
#pragma unroll
            for (int a = 0; a < 3; ++a)
#pragma unroll
                for (int e = 0; e < 2; ++e) { const float pv = e ? bfhi(r.raw[a][0]) : bflo(r.raw[a][0]), l = e ? bfhi(r.raw[a][1]) : bflo(r.raw[a][1]), rr = e ? bfhi(r.raw[a][2]) : bflo(r.raw[a][2]),
                                                  up = e ? bfhi(r.raw[a][3]) : bflo(r.raw[a][3]), dn = e ? bfhi(r.raw[a][4]) : bflo(r.raw[a][4]);
                    float o = pv + mu_[a][0][e] * (l - pv) + mu_[a][1][e] * (rr - pv);
                    if (vert) o += mu_[a][2][e] * (up - pv) + mu_[a][3][e] * (dn - pv);
                    sh[a][e] = o; }
            f32x2 w, kk, bb, kd, rr2, vv;
#pragma unroll
            for (int e = 0; e < 2; ++e) { const float ev = e ? bfhi(r.e) : bflo(r.e), av = e ? bfhi(r.a) : bflo(r.a); const float ksh = sh[1][e];
                const float kkv = ksh * kkc[e] * r.rn;
                w[e] = __expf(-ev); kk[e] = kkv; bb[e] = kkv * av; kd[e] = ksh * (1.f + (av - 1.f) * kac[e]); rr2[e] = sh[0][e]; vv[e] = sh[2][e]; }
            *(LAS f32x2*)(bs + 0) = w; *(LAS f32x2*)(bs + 64) = kk; *(LAS f32x2*)(bs + 128) = bb; *(LAS f32x2*)(bs + 192) = kd; *(LAS f32x2*)(bs + 256) = rr2; *(LAS f32x2*)(bs + 320) = vv; };
        const int rg = lane >> 4, q = lane & 15, row0 = wave * 16 + rg * 4; const bool b0 = (q & 1) != 0, b1 = (q & 2) != 0;
        const int myrow = row0 + ((q & 1) << 1) + ((q >> 1) & 1);
        float S[4][4];
#pragma unroll
        for (int i = 0; i < 4; ++i)
#pragma unroll
            for (int j = 0; j < 4; ++j) S[i][j] = 0.f;
        RwRegs ra, rb;
        issue(0, ls0, ra); issue(0, ls0 + 8, rb); stage(0, ls0, ra); stage(0, ls0 + 8, rb);
        __syncthreads();
        for (int c = 0; c < 144; ++c) {
            if (c + 1 < 144) { issue(c + 1, ls0, ra); issue(c + 1, ls0 + 8, rb); }
            const bool lat = c >= 16;
#pragma unroll 2
            for (int s = 0; s < 16; ++s) {
                const LAS float* bs = buf + ((c & 1) * 16 + s) * 384;
                const f32x4 w4 = *(const LAS f32x4*)(bs + q * 4), kk4 = *(const LAS f32x4*)(bs + 64 + q * 4), b4 = *(const LAS f32x4*)(bs + 128 + q * 4), kd4 = *(const LAS f32x4*)(bs + 192 + q * 4), r4 = *(const LAS f32x4*)(bs + 256 + q * 4);
                const f32x4 v4 = *(const LAS f32x4*)(bs + 320 + row0);
                float pp[4];
#pragma unroll
                for (int i = 0; i < 4; ++i) pp[i] = (S[i][0] * kk4[0] + S[i][1] * kk4[1]) + (S[i][2] * kk4[2] + S[i][3] * kk4[3]);
                float ta = (b0 ? pp[2] : pp[0]) + dpp<0xB1>(b0 ? pp[0] : pp[2]);
                float tb = (b0 ? pp[3] : pp[1]) + dpp<0xB1>(b0 ? pp[1] : pp[3]);
                float t = (b1 ? tb : ta) + dpp<0x4E>(b1 ? ta : tb);
                t += dpp<0x124>(t); t += dpp<0x128>(t);
                float sa[4]; sa[0] = dpp<0x00>(t); sa[1] = dpp<0xAA>(t); sa[2] = dpp<0x55>(t); sa[3] = dpp<0xFF>(t);
#pragma unroll
                for (int i = 0; i < 4; ++i)
#pragma unroll
                    for (int j = 0; j < 4; ++j) S[i][j] = S[i][j] * w4[j] + (v4[i] * kd4[j] - sa[i] * b4[j]);
                if (lat) {
#pragma unroll
                    for (int i = 0; i < 4; ++i) pp[i] = (S[i][0] * r4[0] + S[i][1] * r4[1]) + (S[i][2] * r4[2] + S[i][3] * r4[3]);
                    float ya = (b0 ? pp[2] : pp[0]) + dpp<0xB1>(b0 ? pp[0] : pp[2]);
                    float yb = (b0 ? pp[3] : pp[1]) + dpp<0xB1>(b0 ? pp[1] : pp[3]);
                    float y = (b1 ? yb : ya) + dpp<0x4E>(b1 ? ya : yb);
                    y += dpp<0x124>(y); y += dpp<0x128>(y);
                    if (q < 4) Y[(size_t)rowof(c * 16 + s) * 1024 + h * 64 + myrow] = f2bf(y);
                }
            }
            if (c + 1 < 144) { stage(c + 1, ls0, ra); stage(c + 1, ls0 + 8, rb); }
            __syncthreads();
        }
    }
}

__device__ __forceinline__ void hg_scan4(const Params& p, LAS unsigned char* lds, int tid, int wave, int lane) {
    LAS bf16_t* qd = (LAS bf16_t*)(lds);
    LAS bf16_t* kd = (LAS bf16_t*)(lds + 17408);
    LAS bf16_t* kdT = (LAS bf16_t*)(lds + 34816);
    LAS bf16_t* vT = (LAS bf16_t*)(lds + 53248);
    LAS bf16_t* ST = (LAS bf16_t*)(lds + 62464);
    LAS bf16_t* at = (LAS bf16_t*)(lds + 79872);
    LAS float* tot = (LAS float*)(lds + 89088);
    const bf16_t* Pq = (const bf16_t*)(p.ws + WS_PQ); const bf16_t* Pi = (const bf16_t*)(p.ws + WS_PI);
    bf16_t* Obase = (bf16_t*)((unsigned char*)p.out + DO_O);
    const int l15 = lane & 15, fq = lane >> 4;
    for (int u = blockIdx.x; u < 256; u += gridDim.x) {
        const int b = u >> 5, h = (u >> 2) & 7, dir = (u >> 1) & 1, vh = u & 1;
        const bf16_t* Pg = (const bf16_t*)(p.ws + (dir ? WS_PGB : WS_PGF));
        bf16_t* O = Obase + (size_t)dir * MLAT * 1024;
        const int k0 = 2 * lane, qtr = wave, vs = tid >> 2, vq = tid & 3;
        const int sgn = dir ? -1 : 1;
        auto rbase = [&](int c) -> int { if (c < 4) return MLAT + b * CTXL + (dir ? (CTXL - 1 - c * 64) : c * 64); const int t0 = (c - 4) * 64; return b * SEQ + (dir ? (SEQ - 1 - t0) : t0); };
        const long rstep = (long)sgn * 1024;
        f32x4 S[2][4];
#pragma unroll
        for (int a = 0; a < 2; ++a)
#pragma unroll
            for (int i = 0; i < 4; ++i) S[a][i] = (f32x4){0.f, 0.f, 0.f, 0.f};
        unsigned gN[16], qN[16]; u32x4 vN[2];
#pragma unroll
        for (int j = 0; j < 16; ++j) { const long o = ((long)rbase(0) + sgn * (qtr * 16)) * 1024 + h * 128 + k0 + j * rstep; gN[j] = *(const unsigned*)(Pg + o); qN[j] = *(const unsigned*)(Pq + o); }
#pragma unroll
        for (int i = 0; i < 2; ++i) vN[i] = *(const u32x4*)(Pi + ((long)rbase(0) + sgn * vs) * 1024 + h * 128 + vh * 64 + vq * 16 + i * 8);
        __syncthreads();
        for (int c = 0; c < 36; ++c) {
            unsigned g[16], q[16]; const u32x4 vC0 = vN[0], vC1 = vN[1];
#pragma unroll
            for (int j = 0; j < 16; ++j) { g[j] = gN[j]; q[j] = qN[j]; }
            if (c + 1 < 36) {
                const long rb1 = rbase(c + 1);
                const bf16_t* gp = Pg + (rb1 + sgn * (qtr * 16)) * 1024 + h * 128 + k0; const bf16_t* qp_ = Pq + (rb1 + sgn * (qtr * 16)) * 1024 + h * 128 + k0;
#pragma unroll
                for (int j = 0; j < 16; ++j) { gN[j] = *(const unsigned*)(gp + j * rstep); qN[j] = *(const unsigned*)(qp_ + j * rstep); }
#pragma unroll
                for (int i = 0; i < 2; ++i) vN[i] = *(const u32x4*)(Pi + (rb1 + sgn * vs) * 1024 + h * 128 + vh * 64 + vq * 16 + i * 8);
            }
            float run0 = 0.f, run1 = 0.f;
#pragma unroll
            for (int j = 0; j < 16; ++j) { run0 += bflo(g[j]); run1 += bfhi(g[j]); }
            *(LAS f32x2*)(tot + qtr * 128 + k0) = (f32x2){run0, run1};
            __syncthreads();
            {
                const f32x2 t0 = *(const LAS f32x2*)(tot + k0), t1 = *(const LAS f32x2*)(tot + 128 + k0), t2 = *(const LAS f32x2*)(tot + 256 + k0);
                const float mid0 = t0.x + t1.x, mid1 = t0.y + t1.y;
                const float off0 = qtr == 0 ? 0.f : (qtr == 1 ? t0.x : (qtr == 2 ? mid0 : mid0 + t2.x));
                const float off1 = qtr == 0 ? 0.f : (qtr == 1 ? t0.y : (qtr == 2 ? mid1 : mid1 + t2.y));
                unsigned kp0[8], kp1[8]; float bc0 = off0, bc1 = off1;
#pragma unroll
                for (int j = 0; j < 16; j += 2) {
                    float kv0[2], kv1[2];
#pragma unroll
                    for (int e = 0; e < 2; ++e) { const int jj = j + e;
                        bc0 += bflo(g[jj]); bc1 += bfhi(g[jj]);
                        const float qv0 = bflo(q[jj]) * __expf(fminf(bc0 - mid0, 80.f)), qv1 = bfhi(q[jj]) * __expf(fminf(bc1 - mid1, 80.f));
                        kv0[e] = (1.f - __expf(bflo(g[jj]))) * __expf(fminf(mid0 - bc0, 80.f)); kv1[e] = (1.f - __expf(bfhi(g[jj]))) * __expf(fminf(mid1 - bc1, 80.f));
                        const int t = qtr * 16 + jj;
                        *(LAS unsigned*)(qd + t * 136 + k0) = cvt_pk_bf16(qv0, qv1); *(LAS unsigned*)(kd + t * 136 + k0) = cvt_pk_bf16(kv0[e], kv1[e]); }
                    kp0[j >> 1] = cvt_pk_bf16(kv0[0], kv0[1]); kp1[j >> 1] = cvt_pk_bf16(kv1[0], kv1[1]);
                }
                *(LAS u32x4*)(kdT + k0 * 72 + qtr * 16) = (u32x4){kp0[0], kp0[1], kp0[2], kp0[3]};
                *(LAS u32x4*)(kdT + k0 * 72 + qtr * 16 + 8) = (u32x4){kp0[4], kp0[5], kp0[6], kp0[7]};
                *(LAS u32x4*)(kdT + (k0 + 1) * 72 + qtr * 16) = (u32x4){kp1[0], kp1[1], kp1[2], kp1[3]};
                *(LAS u32x4*)(kdT + (k0 + 1) * 72 + qtr * 16 + 8) = (u32x4){kp1[4], kp1[5], kp1[6], kp1[7]};
#pragma unroll
                for (int kt = 0; kt < 2; ++kt) { const int kb = 32 * wave + 16 * kt + fq * 4;
                    float em[4];
#pragma unroll
                    for (int j = 0; j < 4; ++j) em[j] = __expf(tot[kb + j] + tot[128 + kb + j]);
#pragma unroll
                    for (int nt = 0; nt < 4; ++nt) { u32x2 w; w.x = cvt_pk_bf16(S[kt][nt][0] * em[0], S[kt][nt][1] * em[1]); w.y = cvt_pk_bf16(S[kt][nt][2] * em[2], S[kt][nt][3] * em[3]);
                        *(LAS u32x2*)(ST + (nt * 16 + l15) * 136 + kb) = w; } }
                const unsigned vw[8] = {vC0.x, vC0.y, vC0.z, vC0.w, vC1.x, vC1.y, vC1.z, vC1.w};
#pragma unroll
                for (int i = 0; i < 8; ++i) { vT[(vq * 16 + 2 * i) * 72 + vs] = (bf16_t)(vw[i] & 0xffffu); vT[(vq * 16 + 2 * i + 1) * 72 + vs] = (bf16_t)(vw[i] >> 16); }
            }
            __syncthreads();
            const bool lat = c >= 4;
            if (lat) {
                const int tt = wave;
#pragma unroll
                for (int st = 0; st < 4; ++st) {
                    f32x4 a = (f32x4){0.f, 0.f, 0.f, 0.f};
                    if (st <= tt) {
#pragma unroll
                        for (int ks = 0; ks < 4; ++ks) { const bf16x8 A = *(const LAS bf16x8*)(qd + (tt * 16 + l15) * 136 + ks * 32 + fq * 8); const bf16x8 B = *(const LAS bf16x8*)(kd + (st * 16 + l15) * 136 + ks * 32 + fq * 8); a = mfma16(A, B, a); } }
#pragma unroll
                    for (int j = 0; j < 4; ++j) { const int t = tt * 16 + fq * 4 + j, s = st * 16 + l15; at[t * 72 + s] = f2bf(s <= t ? a[j] : 0.f); } }
            }
            __syncthreads();
            if (lat) {
                const int tt = wave;
#pragma unroll
                for (int nt = 0; nt < 4; ++nt) {
                    f32x4 o = (f32x4){0.f, 0.f, 0.f, 0.f};
#pragma unroll
                    for (int ks = 0; ks < 2; ++ks) { const bf16x8 A = *(const LAS bf16x8*)(at + (tt * 16 + l15) * 72 + ks * 32 + fq * 8); const bf16x8 B = *(const LAS bf16x8*)(vT + (nt * 16 + l15) * 72 + ks * 32 + fq * 8); o = mfma16(A, B, o); }
#pragma unroll
                    for (int ks = 0; ks < 4; ++ks) { const bf16x8 A = *(const LAS bf16x8*)(qd + (tt * 16 + l15) * 136 + ks * 32 + fq * 8); const bf16x8 B = *(const LAS bf16x8*)(ST + (nt * 16 + l15) * 136 + ks * 32 + fq * 8); o = mfma16(A, B, o); }
#pragma unroll
                    for (int j = 0; j < 4; ++j) { const long row = (long)rbase(c) + sgn * (tt * 16 + fq * 4 + j); O[row * 1024 + h * 128 + vh * 64 + nt * 16 + l15] = f2bf(o[j]); } }
            }
#pragma unroll
            for (int kt = 0; kt < 2; ++kt) { const int kb = 32 * wave + 16 * kt;
                float eb[4], e2[4];
#pragma unroll
                for (int j = 0; j < 4; ++j) { const int kj = kb + fq * 4 + j; const float m = tot[kj] + tot[128 + kj], bl = m + tot[256 + kj] + tot[384 + kj]; eb[j] = __expf(bl); e2[j] = __expf(bl - m); }
#pragma unroll
                for (int nt = 0; nt < 4; ++nt) { f32x4 tmp = (f32x4){0.f, 0.f, 0.f, 0.f};
#pragma unroll
                    for (int ks = 0; ks < 2; ++ks) { const bf16x8 A = *(const LAS bf16x8*)(kdT + (kb + l15) * 72 + ks * 32 + fq * 8); const bf16x8 B = *(const LAS bf16x8*)(vT + (nt * 16 + l15) * 72 + ks * 32 + fq * 8); tmp = mfma16(A, B, tmp); }
#pragma unroll
                    for (int j = 0; j < 4; ++j) S[kt][nt][j] = eb[j] * S[kt][nt][j] + e2[j] * tmp[j]; } }
            __syncthreads();
        }
    }
}

#define XB_TMO      128
#define XB_XCNT(j)  (256  + 64 * (j))
#define XB_XSUB(j)  (1280 + 64 * (j))
#define XB_XGEN(j)  (2304 + 64 * (j))
#define XB_TOP      3328
#define XB_TOPGEN   3392
#define XCD_BAR_WORDS 3456
#define XB_SPIN_CAP (1u << 18)

__device__ __forceinline__ unsigned xb_ld(unsigned* p)              { return __hip_atomic_load(p, __ATOMIC_RELAXED, __HIP_MEMORY_SCOPE_AGENT); }
__device__ __forceinline__ unsigned xb_add(unsigned* p, unsigned v) { return __hip_atomic_fetch_add(p, v, __ATOMIC_RELAXED, __HIP_MEMORY_SCOPE_AGENT); }
__device__ __forceinline__ unsigned xb_xcc_id() { return (unsigned)__builtin_amdgcn_s_getreg((3 << 11) | 20) & 0xFu; }
#define XB_SPIN(cond, bar) do { unsigned _sp = 0; while (cond) { __builtin_amdgcn_s_sleep(1); \
    if ((++_sp & 255u) == 0u) { if (xb_ld(&(bar)[XB_TMO])) break; if (_sp > XB_SPIN_CAP) { atomicAdd(&(bar)[XB_TMO], 1u); break; } } } } while (0)

struct XcdBarrier {
    unsigned* bar; unsigned x;
    volatile LAS unsigned* st;
};

__device__ __forceinline__ XcdBarrier xcd_barrier_post(unsigned* bar, volatile LAS unsigned* st) {
    XcdBarrier b; b.bar = bar; b.x = xb_xcc_id(); b.st = st;
    if (threadIdx.x == 0) (void)xb_add(&bar[XB_XCNT(b.x)], 1u);
    return b;
}
__device__ __forceinline__ void xcd_barrier_complete(unsigned* bar, unsigned x, unsigned& nloc, unsigned& nx) {
    const unsigned G = gridDim.x * gridDim.y * gridDim.z;
    unsigned sum, cnt, mine, sp = 0u;
    for (;;) {
        sum = 0u; cnt = 0u; mine = 0u;
#pragma unroll
        for (unsigned j = 0; j < 16; ++j) { const unsigned c = xb_ld(&bar[XB_XCNT(j)]); sum += c; cnt += (c > 0u) ? 1u : 0u; mine = (j == x) ? c : mine; }
        if (sum == G) break;
        __builtin_amdgcn_s_sleep(1);
        if ((++sp & 255u) == 0u) { if (xb_ld(&bar[XB_TMO])) break; if (sp > XB_SPIN_CAP) { atomicAdd(&bar[XB_TMO], 1u); break; } }
    }
    nloc = mine > 0u ? mine : 1u; nx = cnt > 0u ? cnt : 1u;
}

__device__ __forceinline__ void xcd_barrier(const XcdBarrier& b) {
    asm volatile("s_waitcnt vmcnt(0)" ::: "memory");
    __syncthreads();
    if (threadIdx.x == 0) {
        unsigned* bar = b.bar;
        __builtin_amdgcn_s_waitcnt(0);
        unsigned nloc = b.st[0], nx = b.st[1];
        if (nloc == 0u) { xcd_barrier_complete(bar, b.x, nloc, nx); b.st[0] = nloc; b.st[1] = nx; }
        const unsigned old = xb_add(&bar[XB_XSUB(b.x)], 1u);
        const unsigned gen = old / nloc;
        if (old + 1u == (gen + 1u) * nloc) {
            __builtin_amdgcn_fence(__ATOMIC_RELEASE, "agent");
            asm volatile("s_waitcnt vmcnt(0)" ::: "memory");
            const unsigned og = xb_add(&bar[XB_TOP], 1u);
            const unsigned tg = og / nx;
            if (og + 1u == (tg + 1u) * nx) xb_add(&bar[XB_TOPGEN], 1u);
            else XB_SPIN(xb_ld(&bar[XB_TOPGEN]) == tg, bar);
            __builtin_amdgcn_fence(__ATOMIC_ACQUIRE, "agent");
            xb_add(&bar[XB_XGEN(b.x)], 1u);
            asm volatile("s_waitcnt vmcnt(0)" ::: "memory");
        } else {
            XB_SPIN(xb_ld(&bar[XB_XGEN(b.x)]) == gen, bar);
            __builtin_amdgcn_fence(__ATOMIC_ACQUIRE, "agent");
            asm volatile("s_waitcnt vmcnt(0)" ::: "memory");
        }
    }
    __syncthreads();
}


#ifndef GA
#define GA true
#endif
#ifndef GS
#define GS true
#endif
#ifndef COMBINED
#define COMBINED 0
#endif

__global__ void __launch_bounds__(512, 2) mega(Params p) {
    extern __shared__ __attribute__((aligned(16))) unsigned char shm[];
    LAS unsigned char* lds = (LAS unsigned char*)shm;
    cg::grid_group grid = cg::this_grid();
    const int tid = threadIdx.x, wave = __builtin_amdgcn_readfirstlane(tid >> 6), lane = tid & 63;
    volatile LAS unsigned* xst = (volatile LAS unsigned*)(lds + 131072);
    if (tid == 0) { xst[0] = 0u; xst[1] = 0u; }
    __syncthreads();
    const XcdBarrier xb = xcd_barrier_post((unsigned*)(p.ws + WS_BAR), xst);
    phase0(p, lds, tid, wave, lane);
    if (p.ws == nullptr) grid.sync();
    xcd_barrier(xb);
    phase1(p, (bf16_t*)((unsigned char*)p.out + DO_H), MTOT, wave, lane);
    xcd_barrier(xb);
    { pg8::Gemm g{(const bf16_t*)((unsigned char*)p.out + DO_H), (const bf16_t*)((unsigned char*)p.out + DO_WTIN), MTOT, NC1, D};
      InOrder S{(int)gridDim.x, (int)blockIdx.x}; EpiProj E{p.ws};
      pg8::gemm_phase<EpiProj, InOrder, GA, GS>(lds, g, S, E); }
    xcd_barrier(xb);
    rw_prep(p, lds, wave, lane);
    xcd_barrier(xb);
#if COMBINED
    if (wave < 4) rw_scan4(p, lds, tid, wave, lane);
    else hg_scan4(p, lds + RW_LDS, tid - 256, wave - 4, lane);
#else
    hg_scan(p, lds, tid, wave, lane);
    rw_scan(p, lds, tid, wave, lane);
#endif
    xcd_barrier(xb);
    post_hg(p, wave, lane);
    post_rw(p, lds, wave, lane);
    phase1(p, (bf16_t*)(p.ws + WS_H2), MLAT, wave, lane);
    xcd_barrier(xb);
    { pg8::Gemm g{(const bf16_t*)(p.ws + WS_H2), (const bf16_t*)(p.ws + WS_WTG), MLAT, 4096, D};
      pg8::StaticOrder S; S.init(MLAT, 4096, (int)gridDim.x, (int)blockIdx.x); EpiGate E{p.ws};
      pg8::gemm_phase<EpiGate, pg8::StaticOrder, GA, GS>(lds, g, S, E); }
    xcd_barrier(xb);
    { pg8::Gemm g{(const bf16_t*)(p.ws + WS_YHG), (const bf16_t*)(p.ws + WS_WTO1), 0, 0, 1024};
      OrderOut1 S{(int)gridDim.x, (int)blockIdx.x}; EpiOut1 E{p.ws};
      pg8::gemm_phase<EpiOut1, OrderOut1, GA, GS>(lds, g, S, E); }
    xcd_barrier(xb);
    { pg8::Gemm g{(const bf16_t*)(p.ws + WS_MERGED), (const bf16_t*)(p.ws + WS_WTO2), MLAT, D, D};
      pg8::StaticOrder S; S.init(MLAT, D, (int)gridDim.x, (int)blockIdx.x); EpiOut2 E{p.x, (const float*)(p.ws + WS_MOD), p.out};
      pg8::gemm_phase<EpiOut2, pg8::StaticOrder, GA, GS>(lds, g, S, E); }
    xcd_barrier(xb);
    final_norm(p, wave, lane);
}
}

extern "C" void kernel_launch(void* const* d_in, const int* in_sizes, int n_in, void* d_out, int out_size, void* d_ws, size_t ws_size, hipStream_t stream) {
    static int grid = 0;
    if (grid == 0) {
        if (n_in != 24 || ws_size < mk::WS_END) { fprintf(stderr, "kernel_launch: unexpected inputs (n_in %d, ws %zu)\n", n_in, ws_size); grid = -1; return; }
        int dev = 0, cus = 0, per_cu = 0;
        (void)hipGetDevice(&dev); (void)hipDeviceGetAttribute(&cus, hipDeviceAttributeMultiprocessorCount, dev);
        if (hipFuncSetAttribute((const void*)mk::mega, hipFuncAttributeMaxDynamicSharedMemorySize, mk::LDS_BYTES) != hipSuccess) { fprintf(stderr, "kernel_launch: hipFuncSetAttribute failed\n"); }
        if (hipOccupancyMaxActiveBlocksPerMultiprocessor(&per_cu, (const void*)mk::mega, 512, mk::LDS_BYTES) != hipSuccess || per_cu < 1) per_cu = 1;
        (void)hipGetLastError();
        grid = cus * (per_cu > 1 ? 1 : per_cu);
        if (grid <= 0) grid = 256;
    }
    if (grid < 0) return;
    mk::Params p{};
    const float** f = (const float**)&p;
    for (int i = 0; i < 24; ++i) f[i] = (const float*)d_in[i];
    p.out = (float*)d_out; p.ws = (unsigned char*)d_ws;
    (void)hipMemsetAsync((unsigned char*)d_ws + mk::WS_BAR, 0, XCD_BAR_WORDS * sizeof(unsigned), stream);
    void* args[] = {&p};
    hipError_t e = hipLaunchCooperativeKernel((const void*)mk::mega, dim3(grid), dim3(512), args, mk::LDS_BYTES, stream);
    if (e != hipSuccess) fprintf(stderr, "cooperative launch failed: %s (grid %d)\n", hipGetErrorString(e), grid);
}
```

```cpp
#include <hip/hip_runtime.h>
#include <hip/hip_cooperative_groups.h>
#include <cstdio>
#include <cstdint>
namespace cg = cooperative_groups;
namespace pg8 {
#define PG8_LAS __attribute__((address_space(3)))
typedef unsigned short bf16_t;
typedef short bf16x8 __attribute__((ext_vector_type(8)));
typedef float f32x4 __attribute__((ext_vector_type(4)));
typedef unsigned u32x4 __attribute__((ext_vector_type(4)));
constexpr int BM = 256, BK = 64, HALF = 128, HTB = HALF * BK * 2  , STAGE_BYTES = 8 * HTB, NXCD = 8, WGM = 4;

__host__ __device__ __forceinline__ int lds_byte(int r, int c) { const int st = (r >> 4) * 2 + (c >> 5), rr = r & 15, cc = c & 31, ob = rr * 64 + cc * 2; return st * 1024 + (ob ^ (((ob >> 9) & 1) << 5)); }
__host__ __device__ __forceinline__ void stage_rc(int b, int& R, int& C) { const int st = b / 1024, sb = b % 1024, swz = sb ^ (((sb >> 9) & 1) << 5); R = (st >> 1) * 16 + swz / 64; C = (st & 1) * 32 + (swz % 64) / 2; }
__host__ __device__ __forceinline__ int perm32(int rho) { const int n = rho >> 4, i = rho & 15; return 8 * (i >> 2) + 4 * n + (i & 3); }

struct Unit { int pm, pn; };
struct Gemm { const bf16_t* A; const bf16_t* Bt; int M, N, K; };

struct StaticOrder {
    int nM, nN, nwg, G, c;
    __host__ __device__ void init(int M, int N, int G_, int c_) { nM = M / BM; nN = N / BM; nwg = nM * nN; G = G_; c = c_; }
    __host__ __device__ bool next(int i, Unit& u) const {
        const long L = (long)i * G + c; if (L >= nwg) return false;
        int wgid = (int)L; { const int q = nwg / NXCD, r = nwg % NXCD, xcd = wgid % NXCD, off = wgid / NXCD; wgid = (xcd < r ? xcd * (q + 1) : r * (q + 1) + (xcd - r) * q) + off; }
        const int nig = WGM * nN, gid = wgid / nig, fm = gid * WGM, gsz = (nM - fm) < WGM ? (nM - fm) : WGM;
        u.pm = fm + ((wgid % nig) % gsz); u.pn = (wgid % nig) / gsz; return true;
    }
    __device__ __forceinline__ void a_ready(const Unit&) const {}
    __device__ __forceinline__ void done(const Unit&) const {}
};
typedef float f32x2 __attribute__((ext_vector_type(2)));
typedef __bf16 bf16x2v __attribute__((ext_vector_type(2)));
__device__ __forceinline__ unsigned cvt_pk_bf16(float lo, float hi) { const f32x2 v = {lo, hi}; const bf16x2v b = __builtin_convertvector(v, bf16x2v); return __builtin_bit_cast(unsigned, b); }
template <class Epi, class Sched, bool ALIGN_EPI = false, bool SP2 = false>
__device__ __forceinline__ void gemm_phase(PG8_LAS unsigned char* lds, const Gemm g, const Sched& S, const Epi& E) {
    const int tid = threadIdx.x, wid = __builtin_amdgcn_readfirstlane(tid >> 6), lane = tid & 63, wr = wid >> 2, wc = wid & 3, fr = lane & 15, fq = lane >> 4;
    const int K = g.K, nt = K / BK;
    unsigned voffA[2], voffB[2];
#pragma unroll
    for (int i = 0; i < 2; ++i) { int R, C; stage_rc(tid * 16 + i * 8192, R, C); const int Rb = Epi::PERM ? ((R & ~31) + perm32(R & 31)) : R;
        voffA[i] = (unsigned)(R * K + C) * 2u; voffB[i] = (unsigned)(Rb * K + C) * 2u; }
    const size_t kstep = (size_t)(BK * 2);
    const size_t hstep = (size_t)HALF * K * 2;
    const size_t tstep = 2 * hstep;
    const unsigned ldsw = (unsigned)wid * 1024u;
    const int aoff = lds_byte(wr * 64 + fr, fq * 8), boff = lds_byte(wc * 32 + fr, fq * 8);
#define PG8_SA(b, h) (((b) * 2 + (h)) * HTB)
#define PG8_SB(b, h) ((4 + (b) * 2 + (h)) * HTB)
#define PG8_STAGE(bufoff, gbase, voff) do { _Pragma("unroll") for (int _i = 0; _i < 2; ++_i) \
        __builtin_amdgcn_global_load_lds((const unsigned*)((const char*)(gbase) + (voff)[_i]), (PG8_LAS unsigned*)(lds + (bufoff) + ldsw + _i * 8192), 16, 0, 0); } while (0)
#define PG8_LDA(dst, b, h) do { _Pragma("unroll") for (int m = 0; m < 4; ++m) _Pragma("unroll") for (int k = 0; k < 2; ++k) dst[m][k] = *(const PG8_LAS bf16x8*)(lds + PG8_SA(b, h) + aoff + m * 2048 + k * 1024); } while (0)
#define PG8_LDB(dst, b, h) do { _Pragma("unroll") for (int n = 0; n < 2; ++n) _Pragma("unroll") for (int k = 0; k < 2; ++k) dst[n][k] = *(const PG8_LAS bf16x8*)(lds + PG8_SB(b, h) + boff + n * 2048 + k * 1024); } while (0)
#define PG8_MMA(ai, bj, At, Bt) do { __builtin_amdgcn_s_setprio(1); _Pragma("unroll") for (int m = 0; m < 4; ++m) _Pragma("unroll") for (int n = 0; n < 2; ++n) _Pragma("unroll") for (int k = 0; k < 2; ++k) \
        acc[ai][bj][m][n] = __builtin_amdgcn_mfma_f32_16x16x32_bf16(Bt[n][k], At[m][k], acc[ai][bj][m][n], 0, 0, 0); __builtin_amdgcn_s_setprio(0); } while (0)
#define PG8_WAIT_V(n) asm volatile("s_waitcnt vmcnt(" #n ")" ::: "memory")
#define PG8_WAIT_L(n) asm volatile("s_waitcnt lgkmcnt(" #n ")" ::: "memory")
#define PG8_BAR __builtin_amdgcn_s_barrier()
#define PG8_SCHED __builtin_amdgcn_sched_barrier(0)
    Unit cur, nxt; int ui = 0;
    if (!S.next(0, cur)) return;
    f32x4 acc[2][2][4][2];
#pragma unroll
    for (int a = 0; a < 2; ++a)
#pragma unroll
        for (int b = 0; b < 2; ++b)
#pragma unroll
            for (int m = 0; m < 4; ++m)
#pragma unroll
                for (int n = 0; n < 2; ++n) acc[a][b][m][n] = (f32x4){0.f, 0.f, 0.f, 0.f};
    bf16x8 At[4][2], B0[2][2], B1[2][2];
    const char* cA = (const char*)g.A + (size_t)cur.pm * tstep; const char* cB = (const char*)g.Bt + (size_t)cur.pn * tstep;
    S.a_ready(cur);
    if constexpr (SP2) {
        PG8_STAGE(PG8_SB(0, 0), cB, voffB); PG8_STAGE(PG8_SB(0, 1), cB + hstep, voffB); PG8_STAGE(PG8_SA(0, 0), cA, voffA); PG8_STAGE(PG8_SA(0, 1), cA + hstep, voffA);
        if (wr == 1) PG8_BAR;
        PG8_WAIT_V(2); PG8_BAR;
        PG8_STAGE(PG8_SB(1, 0), cB + kstep, voffB); PG8_STAGE(PG8_SA(1, 0), cA + kstep, voffA); PG8_STAGE(PG8_SB(1, 1), cB + hstep + kstep, voffB);
        PG8_WAIT_V(6); PG8_BAR;
    } else {
        PG8_STAGE(PG8_SB(0, 0), cB, voffB); PG8_STAGE(PG8_SA(0, 0), cA, voffA); PG8_STAGE(PG8_SB(0, 1), cB + hstep, voffB); PG8_STAGE(PG8_SA(0, 1), cA + hstep, voffA);
        if (wr == 1) PG8_BAR;
        PG8_WAIT_V(4); PG8_BAR;
        PG8_STAGE(PG8_SB(1, 0), cB + kstep, voffB); PG8_STAGE(PG8_SA(1, 0), cA + kstep, voffA); PG8_STAGE(PG8_SB(1, 1), cB + hstep + kstep, voffB);
        PG8_WAIT_V(6); PG8_BAR;
    }
    for (;;) {
        const bool has_next = S.next(ui + 1, nxt);
        const char* nA = has_next ? (const char*)g.A + (size_t)nxt.pm * tstep : cA; const char* nB = has_next ? (const char*)g.Bt + (size_t)nxt.pn * tstep : cB;
        for (int t = 0; t < nt; t += 2) {
            const bool last = (t == nt - 2);
            const char* a1 = cA + (size_t)(t + 1) * kstep;
            const char* a2 = last ? nA : cA + (size_t)(t + 2) * kstep; const char* b2 = last ? nB : cB + (size_t)(t + 2) * kstep;
            const char* a3 = a2 + kstep; const char* b3 = b2 + kstep;
            if (last && has_next) S.a_ready(nxt);
            if constexpr (SP2) {
            PG8_LDB(B0, 0, 0); PG8_LDB(B1, 0, 1); PG8_SCHED; PG8_LDA(At, 0, 0); PG8_STAGE(PG8_SA(1, 1), a1 + hstep, voffA);
            PG8_WAIT_V(8); PG8_WAIT_L(0); PG8_BAR; PG8_MMA(0, 0, At, B0); PG8_MMA(0, 1, At, B1); PG8_BAR; PG8_SCHED;
            PG8_LDA(At, 0, 1); PG8_STAGE(PG8_SB(0, 0), b2, voffB); PG8_STAGE(PG8_SB(0, 1), b2 + hstep, voffB); PG8_STAGE(PG8_SA(0, 0), a2, voffA);
            PG8_WAIT_V(8); PG8_WAIT_L(0); PG8_BAR; PG8_MMA(1, 0, At, B0); PG8_MMA(1, 1, At, B1); PG8_BAR; PG8_SCHED;
            PG8_LDB(B0, 1, 0); PG8_LDB(B1, 1, 1); PG8_SCHED; PG8_LDA(At, 1, 0); PG8_STAGE(PG8_SA(0, 1), a2 + hstep, voffA);
            PG8_WAIT_V(8); PG8_WAIT_L(0); PG8_BAR; PG8_MMA(0, 0, At, B0); PG8_MMA(0, 1, At, B1); PG8_BAR; PG8_SCHED;
            PG8_LDA(At, 1, 1); PG8_STAGE(PG8_SB(1, 0), b3, voffB); PG8_STAGE(PG8_SB(1, 1), b3 + hstep, voffB); PG8_STAGE(PG8_SA(1, 0), a3, voffA);
            PG8_WAIT_V(8); PG8_WAIT_L(0); PG8_BAR; PG8_MMA(1, 0, At, B0); PG8_MMA(1, 1, At, B1); PG8_BAR; PG8_SCHED;
            } else {
            PG8_LDB(B0, 0, 0); PG8_SCHED; PG8_LDA(At, 0, 0); PG8_STAGE(PG8_SA(1, 1), a1 + hstep, voffA);
            PG8_WAIT_L(8); PG8_BAR; PG8_WAIT_L(0); PG8_MMA(0, 0, At, B0); PG8_BAR; PG8_SCHED;
            PG8_LDB(B1, 0, 1); PG8_STAGE(PG8_SB(0, 0), b2, voffB);
            PG8_BAR; PG8_WAIT_L(0); PG8_MMA(0, 1, At, B1); PG8_BAR;
            PG8_LDA(At, 0, 1); PG8_STAGE(PG8_SA(0, 0), a2, voffA);
            PG8_BAR; PG8_WAIT_L(0); PG8_MMA(1, 0, At, B0); PG8_BAR; PG8_SCHED;
            PG8_STAGE(PG8_SB(0, 1), b2 + hstep, voffB);
            PG8_WAIT_V(6); PG8_BAR; PG8_MMA(1, 1, At, B1); PG8_BAR;
            PG8_LDB(B0, 1, 0); PG8_SCHED; PG8_LDA(At, 1, 0); PG8_STAGE(PG8_SA(0, 1), a2 + hstep, voffA);
            PG8_WAIT_L(8); PG8_BAR; PG8_WAIT_L(0); PG8_MMA(0, 0, At, B0); PG8_BAR; PG8_SCHED;
            PG8_LDB(B1, 1, 1); PG8_STAGE(PG8_SB(1, 0), b3, voffB);
            PG8_BAR; PG8_WAIT_L(0); PG8_MMA(0, 1, At, B1); PG8_BAR;
            PG8_LDA(At, 1, 1); PG8_STAGE(PG8_SA(1, 0), a3, voffA);
            PG8_BAR; PG8_WAIT_L(0); PG8_MMA(1, 0, At, B0); PG8_BAR; PG8_SCHED;
            PG8_STAGE(PG8_SB(1, 1), b3 + hstep, voffB);
            PG8_WAIT_V(6); PG8_BAR; PG8_MMA(1, 1, At, B1); PG8_BAR;
            }
        }
        if constexpr (ALIGN_EPI) { if (wr == 0) PG8_BAR; }
        bool keep_acc = false;
        if constexpr (Epi::CHAIN) { keep_acc = E.chain(acc, cur, wr, wc, fr, fq); S.done(cur); }
        else if constexpr (!Epi::AFTER_DRAIN) { E(acc, cur, wr, wc, fr, fq); S.done(cur); }
        if (!has_next) break;
        if (!keep_acc)
#pragma unroll
        for (int a = 0; a < 2; ++a)
#pragma unroll
            for (int b = 0; b < 2; ++b)
#pragma unroll
                for (int m = 0; m < 4; ++m)
#pragma unroll
                    for (int n = 0; n < 2; ++n) acc[a][b][m][n] = (f32x4){0.f, 0.f, 0.f, 0.f};
        cur = nxt; cA = nA; cB = nB; ++ui;
        if constexpr (ALIGN_EPI) { if (wr == 1) PG8_BAR; }
    }
    PG8_WAIT_V(0);
    if constexpr (!ALIGN_EPI) { if (wr == 0) PG8_BAR; }
    PG8_BAR;
    if constexpr (Epi::AFTER_DRAIN) { E.fused(acc, cur, wr, wc, fr, fq, lds, wid, lane); S.done(cur); }
#undef PG8_SA
#undef PG8_SB
#undef PG8_STAGE
#undef PG8_LDA
#undef PG8_LDB
#undef PG8_MMA
#undef PG8_WAIT_V
#undef PG8_WAIT_L
#undef PG8_BAR
#undef PG8_SCHED
}
}

namespace mk {
using pg8::bf16_t; using pg8::bf16x8; using pg8::f32x4; using pg8::u32x4; using pg8::Unit; using pg8::cvt_pk_bf16; using pg8::f32x2;
typedef unsigned u32x2 __attribute__((ext_vector_type(2)));
#define LAS __attribute__((address_space(3)))
#define LDS_WAIT() asm volatile("s_waitcnt lgkmcnt(0)" ::: "memory")

constexpr int D = 2048, NB = 8, SEQ = 2048, CTXL = 256;
constexpr int MLAT = NB * SEQ, MCTX = NB * CTXL, MTOT = MLAT + MCTX;
constexpr int NCOLS = 13568, SHC = 3328;
constexpr size_t MiB = (size_t)1 << 20;
constexpr size_t WS_MOD = 0, WS_LB = 256 * 1024, WS_W2T = 512 * 1024, WS_RN = 1 * MiB, WS_BONUS = 2 * MiB + 256 * 1024;
constexpr size_t WS_PQ = 4 * MiB, WS_PI = 40 * MiB, WS_PGF = 76 * MiB, WS_PGB = 112 * MiB, WS_PZ = 148 * MiB, WS_PRW = 184 * MiB, WS_PZRW = 301 * MiB;
constexpr size_t WS_E0 = 337 * MiB, WS_E1 = 373 * MiB, WS_A0 = 409 * MiB, WS_A1 = 445 * MiB;
constexpr size_t WS_WTO1 = 481 * MiB, WS_WTO2 = 489 * MiB;
constexpr size_t WS_YHG = 4 * MiB, WS_YRW = 36 * MiB, WS_H2 = 68 * MiB, WS_WTG = 132 * MiB;
constexpr size_t WS_PGATE = 337 * MiB;
constexpr size_t WS_T1 = 184 * MiB, WS_MERGED = 248 * MiB;
constexpr size_t WS_BAR = 500 * MiB;
constexpr size_t WS_END = 501 * MiB;
constexpr int YRW_PM_OFF = 64;
static_assert((WS_YRW - WS_YHG) == (size_t)YRW_PM_OFF * 256 * 1024 * 2, "y_hg / y_rw spacing");
constexpr int NC1 = 9472;
constexpr size_t DO_H = 0, DO_WTIN = 72 * MiB, DO_O = 0, DO_Y = 64 * MiB;
constexpr int LDS_BYTES = 147456, RW_LDS = 49152;

struct Params {
    const float *x, *c, *ctx, *c_ctx, *ada_w, *ada_b, *norm_g, *w_in, *hg_lb, *hg_norm_g, *rw_mu, *rw_w0, *rw_w2, *rw_a0, *rw_a2, *rw_kk, *rw_ka, *rw_rk, *rw_gn_g, *rw_gn_b,
        *w_hg_out, *w_rw_out, *w_out, *final_g;
    float* out; unsigned char* ws;
};

__device__ __forceinline__ float bflo(unsigned u) { return __uint_as_float(u << 16); }
__device__ __forceinline__ float bfhi(unsigned u) { return __uint_as_float(u & 0xffff0000u); }
__device__ __forceinline__ float bf2f(bf16_t u) { return __uint_as_float(((unsigned)u) << 16); }
__device__ __forceinline__ bf16_t f2bf(float f) { return (bf16_t)(cvt_pk_bf16(f, 0.f) & 0xffffu); }
__device__ __forceinline__ float sigm(float x) { return __builtin_amdgcn_rcpf(1.f + __expf(-x)); }
__device__ __forceinline__ float silu(float x) { return x * sigm(x); }
__device__ __forceinline__ float tanh_(float x) { return 1.f - 2.f * __builtin_amdgcn_rcpf(1.f + __expf(2.f * x)); }
__device__ __forceinline__ float wave_sum(float v) {
#pragma unroll
    for (int o = 1; o < 64; o <<= 1) v += __shfl_xor(v, o);
    return v;
}
template <int CTRL> __device__ __forceinline__ float dpp(float x) { return __int_as_float(__builtin_amdgcn_update_dpp(0, __float_as_int(x), CTRL, 0xf, 0xf, true)); }
__device__ __forceinline__ f32x4 mfma16(bf16x8 a, bf16x8 b, f32x4 c) { return __builtin_amdgcn_mfma_f32_16x16x32_bf16(a, b, c, 0, 0, 0); }

template <int W> __device__ __forceinline__ void ldbf(const bf16_t* p, float (&o)[W]) {
    if constexpr (W == 2) { const unsigned u = *(const unsigned*)p; o[0] = bflo(u); o[1] = bfhi(u); }
    else if constexpr (W == 4) { const u32x2 u = *(const u32x2*)p; o[0] = bflo(u.x); o[1] = bfhi(u.x); o[2] = bflo(u.y); o[3] = bfhi(u.y); }
    else {
#pragma unroll
        for (int i = 0; i < W / 8; ++i) { const u32x4 u = *(const u32x4*)(p + 8 * i);
            o[8 * i + 0] = bflo(u.x); o[8 * i + 1] = bfhi(u.x); o[8 * i + 2] = bflo(u.y); o[8 * i + 3] = bfhi(u.y);
            o[8 * i + 4] = bflo(u.z); o[8 * i + 5] = bfhi(u.z); o[8 * i + 6] = bflo(u.w); o[8 * i + 7] = bfhi(u.w); }
    }
}
template <int W> __device__ __forceinline__ void ldf(const float* p, float (&o)[W]) {
    if constexpr (W == 2) { const f32x2 u = *(const f32x2*)p; o[0] = u.x; o[1] = u.y; }
    else {
#pragma unroll
        for (int i = 0; i < W / 4; ++i) { const f32x4 u = *(const f32x4*)(p + 4 * i); o[4 * i] = u.x; o[4 * i + 1] = u.y; o[4 * i + 2] = u.z; o[4 * i + 3] = u.w; }
    }
}
template <int W> __device__ __forceinline__ void stbf(bf16_t* p, const float (&v)[W]) {
    if constexpr (W == 4) { u32x2 u; u.x = cvt_pk_bf16(v[0], v[1]); u.y = cvt_pk_bf16(v[2], v[3]); *(u32x2*)p = u; }
    else {
#pragma unroll
        for (int i = 0; i < W / 8; ++i) { u32x4 u; u.x = cvt_pk_bf16(v[8 * i], v[8 * i + 1]); u.y = cvt_pk_bf16(v[8 * i + 2], v[8 * i + 3]); u.z = cvt_pk_bf16(v[8 * i + 4], v[8 * i + 5]); u.w = cvt_pk_bf16(v[8 * i + 6], v[8 * i + 7]); *(u32x4*)(p + 8 * i) = u; }
    }
}

struct Nbr { int L, R, U, Dn; bool vert; };
__device__ __forceinline__ Nbr nbr_of(int R) {
    Nbr n;
    if (R < MLAT) { const int t = R & (SEQ - 1), col = t & 63; n.L = col > 0 ? R - 1 : -1; n.R = col < 63 ? R + 1 : -1; n.U = t >= 64 ? R - 64 : -1; n.Dn = t < SEQ - 64 ? R + 64 : -1; n.vert = true; }
    else { const int t = (R - MLAT) & (CTXL - 1); n.L = t > 0 ? R - 1 : -1; n.R = t < CTXL - 1 ? R + 1 : -1; n.U = -1; n.Dn = -1; n.vert = false; }
    return n;
}
template <int W> __device__ __forceinline__ void shifted(const bf16_t* Prw, int R, const Nbr& nb, int col, const float* mu, float (&o)[W]) {
    float p[W], t[W], m[W];
    ldbf<W>(Prw + (size_t)R * SHC + col, p);
#pragma unroll
    for (int i = 0; i < W; ++i) o[i] = p[i];
    ldf<W>(mu + col, m);
    if (nb.L >= 0) ldbf<W>(Prw + (size_t)nb.L * SHC + col, t); else {
#pragma unroll
        for (int i = 0; i < W; ++i) t[i] = 0.f; }
#pragma unroll
    for (int i = 0; i < W; ++i) o[i] += m[i] * (t[i] - p[i]);
    ldf<W>(mu + SHC + col, m);
    if (nb.R >= 0) ldbf<W>(Prw + (size_t)nb.R * SHC + col, t); else {
#pragma unroll
        for (int i = 0; i < W; ++i) t[i] = 0.f; }
#pragma unroll
    for (int i = 0; i < W; ++i) o[i] += m[i] * (t[i] - p[i]);
    if (nb.vert) {
        ldf<W>(mu + 2 * SHC + col, m);
        if (nb.U >= 0) ldbf<W>(Prw + (size_t)nb.U * SHC + col, t); else {
#pragma unroll
            for (int i = 0; i < W; ++i) t[i] = 0.f; }
#pragma unroll
        for (int i = 0; i < W; ++i) o[i] += m[i] * (t[i] - p[i]);
        ldf<W>(mu + 3 * SHC + col, m);
        if (nb.Dn >= 0) ldbf<W>(Prw + (size_t)nb.Dn * SHC + col, t); else {
#pragma unroll
            for (int i = 0; i < W; ++i) t[i] = 0.f; }
#pragma unroll
        for (int i = 0; i < W; ++i) o[i] += m[i] * (t[i] - p[i]);
    }
}

__device__ __forceinline__ void shifted4m(const bf16_t* Prw, int R, const Nbr& nb, int col, const f32x4 (&mu4)[4], float (&o)[4]) {
    float p[4], t[4];
    ldbf<4>(Prw + (size_t)R * SHC + col, p);
#pragma unroll
    for (int i = 0; i < 4; ++i) o[i] = p[i];
#pragma unroll
    for (int d = 0; d < 4; ++d) {
        if (d >= 2 && !nb.vert) break;
        const int nr = d == 0 ? nb.L : (d == 1 ? nb.R : (d == 2 ? nb.U : nb.Dn));
        if (nr >= 0) ldbf<4>(Prw + (size_t)nr * SHC + col, t); else {
#pragma unroll
            for (int i = 0; i < 4; ++i) t[i] = 0.f; }
#pragma unroll
        for (int i = 0; i < 4; ++i) o[i] += mu4[d][i] * (t[i] - p[i]);
    }
}

__device__ __forceinline__ void transpose_item(const float* W, int K, int ldw, int N, bf16_t* WT, LAS float* scr, int item, int lane) {
    const int nblk = N / 32, kb = item / nblk, nb = item % nblk, k0 = 64 * kb, n0 = 32 * nb;
#pragma unroll 8
    for (int i = 0; i < 32; ++i) { const int kk = 2 * i + (lane >> 5); scr[kk * 33 + (lane & 31)] = W[(size_t)(k0 + kk) * ldw + n0 + (lane & 31)]; }
    LDS_WAIT();
    const int c = lane & 7;
#pragma unroll
    for (int j = 0; j < 4; ++j) { const int n = (lane >> 3) + 8 * j; const LAS float* s = scr + (8 * c) * 33 + n;
        u32x4 o; o.x = cvt_pk_bf16(s[0 * 33], s[1 * 33]); o.y = cvt_pk_bf16(s[2 * 33], s[3 * 33]); o.z = cvt_pk_bf16(s[4 * 33], s[5 * 33]); o.w = cvt_pk_bf16(s[6 * 33], s[7 * 33]);
        *(u32x4*)(WT + (size_t)(n0 + n) * K + k0 + 8 * c) = o; }
    LDS_WAIT();
}

__device__ __forceinline__ void phase0(const Params& p, LAS unsigned char* lds, int tid, int wave, int lane) {
    float* mod = (float*)(p.ws + WS_MOD);
    LAS float* sc = (LAS float*)lds;
    for (int i = tid; i < 9 * D; i += 512) { const int r = i >> 11, k = i & (D - 1); const float v = r < 8 ? p.c[r * D + k] : p.c_ctx[k]; sc[i] = silu(v); }
    __syncthreads();
    for (int cb = blockIdx.x; cb < 256; cb += gridDim.x) {
        if (wave < 6) {
            const int n0 = cb * 24 + wave * 4;
            float acc[9][4];
#pragma unroll
            for (int r = 0; r < 9; ++r)
#pragma unroll
                for (int j = 0; j < 4; ++j) acc[r][j] = 0.f;
            for (int i = 0; i < 32; ++i) { const int k = lane + 64 * i; const f32x4 w = *(const f32x4*)(p.ada_w + (size_t)k * (3 * D) + n0);
#pragma unroll
                for (int r = 0; r < 9; ++r) { const float s = sc[r * D + k]; acc[r][0] += s * w.x; acc[r][1] += s * w.y; acc[r][2] += s * w.z; acc[r][3] += s * w.w; } }
#pragma unroll
            for (int r = 0; r < 9; ++r)
#pragma unroll
                for (int j = 0; j < 4; ++j) { const float v = wave_sum(acc[r][j]); if (lane == 0) mod[r * (3 * D) + n0 + j] = v + p.ada_b[n0 + j]; }
        }
    }
    __syncthreads();
    LAS float* scr = (LAS float*)(lds + wave * 8448);
    const int gw = blockIdx.x * 8 + wave, NGW = gridDim.x * 8;
    bf16_t* wt_in = (bf16_t*)((unsigned char*)p.out + DO_WTIN);
    constexpr int I_IN = (D / 64) * (NC1 / 32);
    for (int it = gw; it < I_IN; it += NGW) transpose_item(p.w_in, D, NCOLS, NC1, wt_in, scr, it, lane);
    bf16_t* w2t = (bf16_t*)(p.ws + WS_W2T);
    const int gt = blockIdx.x * 512 + tid, NGT = gridDim.x * 512;
    for (int i = gt; i < 4 * 1024 * 8; i += NGT) { const int mat = i >> 13, n = (i >> 3) & 1023, k8 = i & 7;
        const float* src = (mat < 2 ? p.rw_w2 + (size_t)mat * 64 * 1024 : p.rw_a2 + (size_t)(mat - 2) * 64 * 1024) + n;
        float v[8];
#pragma unroll
        for (int j = 0; j < 8; ++j) v[j] = src[(size_t)(k8 * 8 + j) * 1024];
        stbf<8>(w2t + ((size_t)mat * 1024 + n) * 64 + k8 * 8, v); }
    float* lb = (float*)(p.ws + WS_LB);
    for (int i = gt; i < 2048; i += NGT) { const int d = i >> 10, j = i & 1023; const float a = p.hg_lb[(d * 2 + 0) * 1024 + j], b = p.hg_lb[(d * 2 + 1) * 1024 + j]; lb[i] = 1.f / (1.f + __expf(b - a)); }
}

__device__ __forceinline__ void phase1(const Params& p, bf16_t* H, int nrows, int wave, int lane) {
    const float* mod = (const float*)(p.ws + WS_MOD);
    const int gw = blockIdx.x * 8 + wave, NGW = gridDim.x * 8;
    for (int row = gw; row < nrows; row += NGW) {
        const float* xr = row < MLAT ? p.x + (size_t)row * D : p.ctx + (size_t)(row - MLAT) * D;
        const int mr = row < MLAT ? (row >> 11) : 8;
        const float* shift = mod + mr * (3 * D); const float* scale = shift + D;
        f32x4 v[8]; float ss = 0.f;
#pragma unroll
        for (int j = 0; j < 8; ++j) { v[j] = ((const f32x4*)xr)[lane + 64 * j]; ss += (v[j].x * v[j].x + v[j].y * v[j].y) + (v[j].z * v[j].z + v[j].w * v[j].w); }
        ss = wave_sum(ss);
        const float rstd = rsqrtf(ss * (1.f / D) + 1e-6f);
#pragma unroll
        for (int j = 0; j < 8; ++j) { const int c = 4 * (lane + 64 * j);
            const f32x4 g = *(const f32x4*)(p.norm_g + c), s1 = *(const f32x4*)(scale + c), s0 = *(const f32x4*)(shift + c);
            float o[4]; o[0] = v[j].x * rstd * g.x * (1.f + s1.x) + s0.x; o[1] = v[j].y * rstd * g.y * (1.f + s1.y) + s0.y; o[2] = v[j].z * rstd * g.z * (1.f + s1.z) + s0.z; o[3] = v[j].w * rstd * g.w * (1.f + s1.w) + s0.w;
            stbf<4>(H + (size_t)row * D + c, o); }
    }
}

struct EpiProj {
    static constexpr bool PERM = true, AFTER_DRAIN = false, CHAIN = false;
    unsigned char* ws;
    template <int ACT> __device__ __forceinline__ void run(const f32x4 (&acc)[2][2][4][2], bf16_t* base, int ld, int row0, int col0, const float* lb) const {
        float lbv[2][8];
        if constexpr (ACT == 3) {
#pragma unroll
            for (int bj = 0; bj < 2; ++bj) ldf<8>(lb + col0 + bj * 128, lbv[bj]); }
#pragma unroll
        for (int ai = 0; ai < 2; ++ai)
#pragma unroll
            for (int m = 0; m < 4; ++m) { bf16_t* rowp = base + (size_t)(row0 + ai * 128 + m * 16) * ld + col0;
#pragma unroll
                for (int bj = 0; bj < 2; ++bj) { float v[8];
#pragma unroll
                    for (int i = 0; i < 4; ++i) { v[i] = acc[ai][bj][m][0][i]; v[4 + i] = acc[ai][bj][m][1][i]; }
#pragma unroll
                    for (int i = 0; i < 8; ++i) {
                        if constexpr (ACT == 1) v[i] = silu(v[i]);
                        if constexpr (ACT == 2) v[i] = sigm(v[i]);
                        if constexpr (ACT == 3) v[i] = __logf(lbv[bj][i] + (1.f - lbv[bj][i]) * sigm(v[i])); }
                    stbf<8>(rowp + bj * 128, v); } }
    }
    __device__ __forceinline__ void operator()(const f32x4 (&acc)[2][2][4][2], const Unit& u, int wr, int wc, int fr, int fq) const {
        const int pn = u.pn; const int row0 = u.pm * 256 + wr * 64 + fr, cw = wc * 32 + 8 * fq;
        const float* lb = (const float*)(ws + WS_LB);
        if (pn < 4) run<1>(acc, (bf16_t*)(ws + WS_PQ), 1024, row0, pn * 256 + cw, lb);
        else if (pn < 8) run<0>(acc, (bf16_t*)(ws + WS_PI), 1024, row0, (pn - 4) * 256 + cw, lb);
        else if (pn < 12) run<3>(acc, (bf16_t*)(ws + WS_PGF), 1024, row0, (pn - 8) * 256 + cw, lb);
        else if (pn < 16) run<3>(acc, (bf16_t*)(ws + WS_PGB), 1024, row0, (pn - 12) * 256 + cw, lb + 1024);
        else if (pn < 20) run<1>(acc, (bf16_t*)(ws + WS_PZ), 1024, row0, (pn - 16) * 256 + cw, lb);
        else if (pn < 33) run<0>(acc, (bf16_t*)(ws + WS_PRW), SHC, row0, (pn - 20) * 256 + cw, lb);
        else run<1>(acc, (bf16_t*)(ws + WS_PZRW), 1024, row0, (pn - 33) * 256 + cw, lb);
    }
};

struct InOrder {
    int G, c;
    __device__ bool next(int i, Unit& u) const {
        const int L = i * G + c;
        if (L < 2368) { pg8::StaticOrder so; so.init(MLAT, NC1, G, c); return so.next(i, u); }
        if (L >= 2368 + 168) return false;
        const int idx = L - 2368, j = idx % 21; u.pm = 64 + idx / 21; u.pn = j < 12 ? 4 + j : 12 + j; return true;
    }
    __device__ __forceinline__ void a_ready(const Unit&) const {}
    __device__ __forceinline__ void done(const Unit&) const {}
};
struct EpiGate {
    static constexpr bool PERM = true, AFTER_DRAIN = false, CHAIN = false;
    unsigned char* ws;
    __device__ __forceinline__ void operator()(const f32x4 (&acc)[2][2][4][2], const Unit& u, int wr, int wc, int fr, int fq) const {
        EpiProj e{ws};
        e.run<2>(acc, (bf16_t*)(ws + WS_PGATE), 4096, u.pm * 256 + wr * 64 + fr, u.pn * 256 + wc * 32 + 8 * fq, nullptr);
    }
};

__device__ __forceinline__ void hg_scan(const Params& p, LAS unsigned char* lds, int tid, int wave, int lane) {
    LAS bf16_t* qd = (LAS bf16_t*)(lds);
    LAS bf16_t* kd = (LAS bf16_t*)(lds + 17408);
    LAS bf16_t* kdT = (LAS bf16_t*)(lds + 34816);
    LAS bf16_t* vT = (LAS bf16_t*)(lds + 53248);
    LAS bf16_t* ST = (LAS bf16_t*)(lds + 62464);
    LAS bf16_t* at = (LAS bf16_t*)(lds + 79872);
    LAS float* tot = (LAS float*)(lds + 89088);
    const bf16_t* Pq = (const bf16_t*)(p.ws + WS_PQ); const bf16_t* Pi = (const bf16_t*)(p.ws + WS_PI);
    bf16_t* Obase = (bf16_t*)((unsigned char*)p.out + DO_O);
    const int l15 = lane & 15, fq = lane >> 4;
    for (int u = blockIdx.x; u < 256; u += gridDim.x) {
        const int b = u >> 5, h = (u >> 2) & 7, dir = (u >> 1) & 1, vh = u & 1;
        const bf16_t* Pg = (const bf16_t*)(p.ws + (dir ? WS_PGB : WS_PGF));
        bf16_t* O = Obase + (size_t)dir * MLAT * 1024;
        const int k0 = 2 * lane, e8 = wave, vs = tid >> 3, vn8 = tid & 7;
        const int sgn = dir ? -1 : 1;
        auto rbase = [&](int c) -> long { if (c < 4) return MLAT + b * CTXL + (dir ? (CTXL - 1 - c * 64) : c * 64); const int t0 = (c - 4) * 64; return b * SEQ + (dir ? (SEQ - 1 - t0) : t0); };
        const long rstep = (long)sgn * 1024;
        f32x4 S[4];
#pragma unroll
        for (int i = 0; i < 4; ++i) S[i] = (f32x4){0.f, 0.f, 0.f, 0.f};
        unsigned gN[8], qN[8]; u32x4 vN;
        { const long rb = rbase(0); const bf16_t* gp = Pg + (rb + sgn * (e8 * 8)) * 1024 + h * 128 + k0; const bf16_t* qp_ = Pq + (rb + sgn * (e8 * 8)) * 1024 + h * 128 + k0;
#pragma unroll
          for (int j = 0; j < 8; ++j) { gN[j] = *(const unsigned*)(gp + j * rstep); qN[j] = *(const unsigned*)(qp_ + j * rstep); }
          vN = *(const u32x4*)(Pi + (rb + sgn * vs) * 1024 + h * 128 + vh * 64 + vn8 * 8); }
        for (int c = 0; c < 36; ++c) {
            unsigned g[8], q[8]; const u32x4 vC = vN;
#pragma unroll
            for (int j = 0; j < 8; ++j) { g[j] = gN[j]; q[j] = qN[j]; }
            if (c + 1 < 36) {
                const long rb1 = rbase(c + 1); const bf16_t* gp = Pg + (rb1 + sgn * (e8 * 8)) * 1024 + h * 128 + k0; const bf16_t* qp_ = Pq + (rb1 + sgn * (e8 * 8)) * 1024 + h * 128 + k0;
#pragma unroll
                for (int j = 0; j < 8; ++j) { gN[j] = *(const unsigned*)(gp + j * rstep); qN[j] = *(const unsigned*)(qp_ + j * rstep); }
                vN = *(const u32x4*)(Pi + (rb1 + sgn * vs) * 1024 + h * 128 + vh * 64 + vn8 * 8);
            }
            float run0 = 0.f, run1 = 0.f;
#pragma unroll
            for (int j = 0; j < 8; ++j) { run0 += bflo(g[j]); run1 += bfhi(g[j]); }
            *(LAS f32x2*)(tot + e8 * 128 + k0) = (f32x2){run0, run1};
            __syncthreads();
            {
                float off0 = 0.f, off1 = 0.f, mid0 = 0.f, mid1 = 0.f;
#pragma unroll
                for (int i = 0; i < 8; ++i) { const f32x2 t = *(const LAS f32x2*)(tot + i * 128 + k0); if (i < e8) { off0 += t.x; off1 += t.y; } if (i < 4) { mid0 += t.x; mid1 += t.y; } }
                unsigned kp0[4], kp1[4]; float bc0 = off0, bc1 = off1;
#pragma unroll
                for (int j = 0; j < 8; j += 2) {
                    float kv0[2], kv1[2];
#pragma unroll
                    for (int e = 0; e < 2; ++e) { const int jj = j + e;
                        bc0 += bflo(g[jj]); bc1 += bfhi(g[jj]);
                        const float E0 = __expf(__builtin_amdgcn_fmed3f(bc0 - mid0, -80.f, 80.f)), E1 = __expf(__builtin_amdgcn_fmed3f(bc1 - mid1, -80.f, 80.f));
                        const float qv0 = bflo(q[jj]) * E0, qv1 = bfhi(q[jj]) * E1;
                        kv0[e] = (1.f - __expf(bflo(g[jj]))) * __builtin_amdgcn_rcpf(E0); kv1[e] = (1.f - __expf(bfhi(g[jj]))) * __builtin_amdgcn_rcpf(E1);
                        const int t = e8 * 8 + jj;
                        *(LAS unsigned*)(qd + t * 136 + k0) = cvt_pk_bf16(qv0, qv1); *(LAS unsigned*)(kd + t * 136 + k0) = cvt_pk_bf16(kv0[e], kv1[e]); }
                    kp0[j >> 1] = cvt_pk_bf16(kv0[0], kv0[1]); kp1[j >> 1] = cvt_pk_bf16(kv1[0], kv1[1]);
                }
                *(LAS u32x4*)(kdT + k0 * 72 + e8 * 8) = (u32x4){kp0[0], kp0[1], kp0[2], kp0[3]};
                *(LAS u32x4*)(kdT + (k0 + 1) * 72 + e8 * 8) = (u32x4){kp1[0], kp1[1], kp1[2], kp1[3]};
                float em[4];
#pragma unroll
                for (int j = 0; j < 4; ++j) { const int kj = 16 * wave + fq * 4 + j; em[j] = __expf((tot[kj] + tot[128 + kj]) + (tot[256 + kj] + tot[384 + kj])); }
#pragma unroll
                for (int nt = 0; nt < 4; ++nt) { u32x2 w; w.x = cvt_pk_bf16(S[nt][0] * em[0], S[nt][1] * em[1]); w.y = cvt_pk_bf16(S[nt][2] * em[2], S[nt][3] * em[3]);
                    *(LAS u32x2*)(ST + (nt * 16 + l15) * 136 + 16 * wave + fq * 4) = w; }
                const unsigned vw[4] = {vC.x, vC.y, vC.z, vC.w};
#pragma unroll
                for (int i = 0; i < 4; ++i) { vT[(vn8 * 8 + 2 * i) * 72 + vs] = (bf16_t)(vw[i] & 0xffffu); vT[(vn8 * 8 + 2 * i + 1) * 72 + vs] = (bf16_t)(vw[i] >> 16); }
            }
            __syncthreads();
            const bool lat = c >= 4;
            if (lat) {
#pragma unroll
                for (int q2 = 0; q2 < 2; ++q2) { const int id = 2 * wave + q2, tt = id >> 2, st = id & 3;
                    f32x4 a = (f32x4){0.f, 0.f, 0.f, 0.f};
                    if (st <= tt) {
#pragma unroll
                        for (int ks = 0; ks < 4; ++ks) { const bf16x8 A = *(const LAS bf16x8*)(kd + (st * 16 + l15) * 136 + ks * 32 + fq * 8); const bf16x8 B = *(const LAS bf16x8*)(qd + (tt * 16 + l15) * 136 + ks * 32 + fq * 8); a = mfma16(A, B, a); } }
                    { const int t = tt * 16 + l15, s0 = st * 16 + fq * 4; u32x2 w; w.x = cvt_pk_bf16(s0 <= t ? a[0] : 0.f, s0 + 1 <= t ? a[1] : 0.f); w.y = cvt_pk_bf16(s0 + 2 <= t ? a[2] : 0.f, s0 + 3 <= t ? a[3] : 0.f);
                      *(LAS u32x2*)(at + t * 72 + s0) = w; } }
            }
            __syncthreads();
            if (lat) {
                const long rb = rbase(c);
#pragma unroll
                for (int q2 = 0; q2 < 2; ++q2) { const int id = 2 * wave + q2, tt = id >> 2, nt = id & 3;
                    f32x4 o = (f32x4){0.f, 0.f, 0.f, 0.f};
#pragma unroll
                    for (int ks = 0; ks < 2; ++ks) { const bf16x8 A = *(const LAS bf16x8*)(vT + (nt * 16 + l15) * 72 + ks * 32 + fq * 8); const bf16x8 B = *(const LAS bf16x8*)(at + (tt * 16 + l15) * 72 + ks * 32 + fq * 8); o = mfma16(A, B, o); }
#pragma unroll
                    for (int ks = 0; ks < 4; ++ks) { const bf16x8 A = *(const LAS bf16x8*)(ST + (nt * 16 + l15) * 136 + ks * 32 + fq * 8); const bf16x8 B = *(const LAS bf16x8*)(qd + (tt * 16 + l15) * 136 + ks * 32 + fq * 8); o = mfma16(A, B, o); }
                    { const long row = rb + sgn * (tt * 16 + l15); u32x2 w; w.x = cvt_pk_bf16(o[0], o[1]); w.y = cvt_pk_bf16(o[2], o[3]);
                      *(u32x2*)(O + row * 1024 + h * 128 + vh * 64 + nt * 16 + fq * 4) = w; } }
            }
            {
                float eb[4], e2[4];
#pragma unroll
                for (int j = 0; j < 4; ++j) { const int kj = 16 * wave + fq * 4 + j; const float m = (tot[kj] + tot[128 + kj]) + (tot[256 + kj] + tot[384 + kj]), bl = m + ((tot[512 + kj] + tot[640 + kj]) + (tot[768 + kj] + tot[896 + kj])); eb[j] = __expf(bl); e2[j] = __expf(bl - m); }
#pragma unroll
                for (int nt = 0; nt < 4; ++nt) { f32x4 tmp = (f32x4){0.f, 0.f, 0.f, 0.f};
#pragma unroll
                    for (int ks = 0; ks < 2; ++ks) { const bf16x8 A = *(const LAS bf16x8*)(kdT + (16 * wave + l15) * 72 + ks * 32 + fq * 8); const bf16x8 B = *(const LAS bf16x8*)(vT + (nt * 16 + l15) * 72 + ks * 32 + fq * 8); tmp = mfma16(A, B, tmp); }
#pragma unroll
                    for (int j = 0; j < 4; ++j) S[nt][j] = eb[j] * S[nt][j] + e2[j] * tmp[j]; }
            }
            __syncthreads();
        }
    }
}

__device__ __forceinline__ void post_hg(const Params& p, int wave, int lane) {
    const bf16_t* O0 = (const bf16_t*)((unsigned char*)p.out + DO_O); const bf16_t* O1 = O0 + (size_t)MLAT * 1024;
    const bf16_t* Pz = (const bf16_t*)(p.ws + WS_PZ); bf16_t* Y = (bf16_t*)(p.ws + WS_YHG);
    const int gw = blockIdx.x * 8 + wave, NGW = gridDim.x * 8, c0 = lane * 16;
    float g[16]; ldf<16>(p.hg_norm_g + c0, g);
    for (int tok = gw; tok < MLAT; tok += NGW) {
        float a[16], bq[16], z[16];
        ldbf<16>(O0 + (size_t)tok * 1024 + c0, a); ldbf<16>(O1 + (size_t)tok * 1024 + c0, bq); ldbf<16>(Pz + (size_t)tok * 1024 + c0, z);
        float ss = 0.f;
#pragma unroll
        for (int i = 0; i < 16; ++i) { a[i] += bq[i]; ss += a[i] * a[i]; }
        ss += __shfl_xor(ss, 1); ss += __shfl_xor(ss, 2); ss += __shfl_xor(ss, 4);
        const float rstd = rsqrtf(ss * (1.f / 128.f) + 1e-6f);
#pragma unroll
        for (int i = 0; i < 16; ++i) a[i] = a[i] * rstd * g[i] * z[i];
        stbf<16>(Y + (size_t)tok * 1024 + c0, a);
    }
}

__device__ __forceinline__ void rw_prep(const Params& p, LAS unsigned char* lds, int wave, int lane) {
    const bf16_t* Prw = (const bf16_t*)(p.ws + WS_PRW); const bf16_t* w2t = (const bf16_t*)(p.ws + WS_W2T);
    bf16_t* E0 = (bf16_t*)(p.ws + WS_E0); bf16_t* E1 = (bf16_t*)(p.ws + WS_E1); bf16_t* A0 = (bf16_t*)(p.ws + WS_A0); bf16_t* A1 = (bf16_t*)(p.ws + WS_A1);
    float* rn = (float*)(p.ws + WS_RN); float* bonus = (float*)(p.ws + WS_BONUS);
    const int l15 = lane & 15, fq = lane >> 4;
    LAS f32x4* cst = (LAS f32x4*)(lds + 8192) + wave * 480;
    for (int idx = lane; idx < 480; idx += 64) { const int nt8 = idx / 60, rem = idx % 60, arr = rem >> 2, fqi = rem & 3, chc = (wave * 2 + (nt8 >> 2)) * 64 + (nt8 & 3) * 16 + fqi * 4;
        const float* sp = arr < 4 ? p.rw_mu + arr * SHC + chc : arr < 8 ? p.rw_mu + (arr - 4) * SHC + 1024 + chc : arr == 8 ? p.rw_w0 + chc : arr == 9 ? p.rw_w0 + 1024 + chc : arr == 10 ? p.rw_a0 + chc : arr == 11 ? p.rw_a0 + 1024 + chc
                        : arr == 12 ? p.rw_kk + chc : arr == 13 ? p.rw_ka + chc : p.rw_rk + chc;
        cst[idx] = *(const f32x4*)sp; }
    const bool xmap = gridDim.x == 256; const int nmine = xmap ? 5 : ((MTOT / 16 - 1 - (int)blockIdx.x) / (int)gridDim.x + 1);
    const int rgrow = ((int)(blockIdx.x & 7) * 32 + (int)(blockIdx.x >> 3)) * 4;
    for (int it = 0; it < nmine; ++it) {
        const bool half = xmap && it == 4; const int hh0 = half ? (int)(blockIdx.x >> 7) : 0, hh1 = half ? hh0 + 1 : 2;
        const int tile = xmap ? (it < 4 ? rgrow + it : 1024 + (int)(blockIdx.x & 127)) : ((int)blockIdx.x + it * (int)gridDim.x);
        const int hp = wave, R = tile * 16 + l15;
        const Nbr nb = nbr_of(R);
        { const int mat = wave >> 1, ks = wave & 1; float v[8]; shifted<8>(Prw, R, nb, 3072 + mat * 64 + ks * 32 + fq * 8, p.rw_mu, v);
          if (mat < 2) {
#pragma unroll
              for (int i = 0; i < 8; ++i) v[i] = tanh_(v[i]); }
          u32x4 w; w.x = cvt_pk_bf16(v[0], v[1]); w.y = cvt_pk_bf16(v[2], v[3]); w.z = cvt_pk_bf16(v[4], v[5]); w.w = cvt_pk_bf16(v[6], v[7]);
          *(LAS u32x4*)(lds + (wave * 64 + lane) * 16) = w; }
        __syncthreads();
        bf16x8 Bf[4][2];
#pragma unroll
        for (int mat = 0; mat < 4; ++mat)
#pragma unroll
            for (int ks = 0; ks < 2; ++ks) Bf[mat][ks] = *(const LAS bf16x8*)(lds + ((mat * 2 + ks) * 64 + lane) * 16);
#pragma unroll 1
        for (int hh = hh0; hh < hh1; ++hh) { const int head = hp * 2 + hh; float skk = 0.f, sb = 0.f;
#pragma unroll 1
            for (int nt = 0; nt < 4; ++nt) { const int n0 = head * 64 + nt * 16, ch = n0 + fq * 4;
                f32x4 acc[4];
#pragma unroll
                for (int mat = 0; mat < 4; ++mat) { acc[mat] = (f32x4){0.f, 0.f, 0.f, 0.f};
#pragma unroll
                    for (int ks = 0; ks < 2; ++ks) { const bf16x8 A = *(const bf16x8*)(w2t + ((size_t)mat * 1024 + n0 + l15) * 64 + ks * 32 + fq * 8); acc[mat] = mfma16(A, Bf[mat][ks], acc[mat]); } }
                const LAS f32x4* cs = cst + (hh * 4 + nt) * 60 + fq;
                const f32x4 mur[4] = {cs[0], cs[4], cs[8], cs[12]}, muk[4] = {cs[16], cs[20], cs[24], cs[28]};
                float rs[4], ks_[4]; shifted4m(Prw, R, nb, ch, mur, rs); shifted4m(Prw, R, nb, 1024 + ch, muk, ks_);
                const f32x4 w00 = cs[32], w01 = cs[36], a00 = cs[40], a01 = cs[44], kkc = cs[48], kac = cs[52], rkc = cs[56];
                float e0[4], e1[4], a0[4], a1[4];
#pragma unroll
                for (int j = 0; j < 4; ++j) { e0[j] = 0.60653066f * sigm(w00[j] + acc[0][j]); e1[j] = 0.60653066f * sigm(w01[j] + acc[1][j]); a0[j] = sigm(a00[j] + acc[2][j]); a1[j] = sigm(a01[j] + acc[3][j]);
                    const float kr = ks_[j] * kkc[j]; skk += kr * kr; sb += rs[j] * ks_[j] * (2.f + (a0[j] + a1[j] - 2.f) * kac[j]) * rkc[j]; }
                stbf<4>(E0 + (size_t)R * 1024 + ch, e0); stbf<4>(E1 + (size_t)R * 1024 + ch, e1); stbf<4>(A0 + (size_t)R * 1024 + ch, a0); stbf<4>(A1 + (size_t)R * 1024 + ch, a1);
            }
            skk += __shfl_xor(skk, 16); skk += __shfl_xor(skk, 32); sb += __shfl_xor(sb, 16); sb += __shfl_xor(sb, 32);
            if (fq == 0) { rn[(size_t)R * 16 + head] = rsqrtf(skk + 1e-12f); if (R < MLAT) bonus[(size_t)R * 16 + head] = sb; }
        }
        __syncthreads();
    }
}

struct RwVec { f32x4 wA, wB, kA, kB, bA, bB, dA, dB, rA, rB; float v; };
template <bool LAT> __device__ __forceinline__ void rw_ldv(const LAS float* bs, int voff, RwVec& V) {
    V.wA = *(const LAS f32x4*)(bs); V.wB = *(const LAS f32x4*)(bs + 4); V.kA = *(const LAS f32x4*)(bs + 64); V.kB = *(const LAS f32x4*)(bs + 68);
    V.bA = *(const LAS f32x4*)(bs + 128); V.bB = *(const LAS f32x4*)(bs + 132); V.dA = *(const LAS f32x4*)(bs + 192); V.dB = *(const LAS f32x4*)(bs + 196);
    if (LAT) { V.rA = *(const LAS f32x4*)(bs + 256); V.rB = *(const LAS f32x4*)(bs + 260); }
    V.v = bs[voff];
}
template <bool LAT> __device__ __forceinline__ void rw_chunk(const LAS float* cb, int voff, int q, f32x2 (&S)[4], float& ylo, float& yhi) {
    RwVec cur, nxt; rw_ldv<LAT>(cb, voff, cur);
#pragma unroll 2
    for (int s = 0; s < 16; ++s) {
        rw_ldv<LAT>(cb + (s < 15 ? s + 1 : 15) * 384, voff, nxt);
        f32x2 d = S[0] * cur.kA.lo; d = S[1] * cur.kA.hi + d; d = S[2] * cur.kB.lo + d; d = S[3] * cur.kB.hi + d;
        float t = d.x + d.y;
        t += dpp<0xB1>(t); t += dpp<0x4E>(t); t += dpp<0x141>(t);
        const f32x2 vv = {cur.v, cur.v}, ns = {-t, -t};
        S[0] = S[0] * cur.wA.lo + (cur.dA.lo * vv + cur.bA.lo * ns); S[1] = S[1] * cur.wA.hi + (cur.dA.hi * vv + cur.bA.hi * ns);
        S[2] = S[2] * cur.wB.lo + (cur.dB.lo * vv + cur.bB.lo * ns); S[3] = S[3] * cur.wB.hi + (cur.dB.hi * vv + cur.bB.hi * ns);
        if (LAT) {
            d = S[0] * cur.rA.lo; d = S[1] * cur.rA.hi + d; d = S[2] * cur.rB.lo + d; d = S[3] * cur.rB.hi + d;
            float y = d.x + d.y;
            y += dpp<0xB1>(y); y += dpp<0x4E>(y); y += dpp<0x141>(y);
            if (s < 8) ylo = (q == (s & 7)) ? y : ylo; else yhi = (q == (s & 7)) ? y : yhi;
        }
        cur = nxt;
    }
}
struct RwRegs { unsigned raw[3][5]; unsigned e, a; float rn; unsigned vmask; };
__device__ __forceinline__ void rw_scan(const Params& p, LAS unsigned char* lds, int tid, int wave, int lane) {
    LAS float* buf = (LAS float*)lds;
    const bf16_t* Prw = (const bf16_t*)(p.ws + WS_PRW); const float* rnp = (const float*)(p.ws + WS_RN);
    bf16_t* Ybase = (bf16_t*)((unsigned char*)p.out + DO_Y);
    for (int u = blockIdx.x; u < 256; u += gridDim.x) {
        const int b = u >> 5, h = (u >> 1) & 15, dir = u & 1;
        const bf16_t* Ed = (const bf16_t*)(p.ws + (dir ? WS_E1 : WS_E0)); const bf16_t* Ad = (const bf16_t*)(p.ws + (dir ? WS_A1 : WS_A0));
        bf16_t* Y = Ybase + (size_t)dir * MLAT * 1024;
        const int ls = tid >> 5, cp = tid & 31, ch = h * 64 + 2 * cp;
        float mu_[3][4][2];
#pragma unroll
        for (int a = 0; a < 3; ++a)
#pragma unroll
            for (int m = 0; m < 4; ++m) { const f32x2 t = *(const f32x2*)(p.rw_mu + m * SHC + a * 1024 + ch); mu_[a][m][0] = t.x; mu_[a][m][1] = t.y; }
        float c0v[3][2], c0h[3][2];
#pragma unroll
        for (int a = 0; a < 3; ++a)
#pragma unroll
            for (int e = 0; e < 2; ++e) { c0h[a][e] = 1.f - (mu_[a][0][e] + mu_[a][1][e]); c0v[a][e] = c0h[a][e] - (mu_[a][2][e] + mu_[a][3][e]); }
        const f32x2 kkc = *(const f32x2*)(p.rw_kk + ch), kac = *(const f32x2*)(p.rw_ka + ch);
        auto rowof = [&](int tau) -> int { if (tau < CTXL) { const int t = dir ? (CTXL - 1 - tau) : tau; return MLAT + b * CTXL + t; } const int t0 = tau - CTXL; const int t = dir ? (SEQ - 1 - t0) : t0; return b * SEQ + t; };
        const char* PrwA[3] = {(const char*)Prw, (const char*)Prw + 2048, (const char*)Prw + 4096};
        const int lsgn = dir ? -ls : ls;
        auto issue = [&](int c, RwRegs& r) { const int R = rowof(c * 16) + lsgn; const bool lat = c >= 16;
            const int t = lat ? (R & (SEQ - 1)) : ((R - MLAT) & (CTXL - 1));
            const bool vL = lat ? (t & 63) > 0 : t > 0, vR = lat ? (t & 63) < 63 : t < CTXL - 1, vU = lat && t >= 64, vD = lat && t < SEQ - 64;
            const unsigned oS = (unsigned)R * (unsigned)(SHC * 2) + (unsigned)(ch * 2);
            const unsigned oL = vL ? oS - SHC * 2 : oS, oR = vR ? oS + SHC * 2 : oS, oU = vU ? oS - 64 * SHC * 2 : oS, oD = vD ? oS + 64 * SHC * 2 : oS;
#pragma unroll
            for (int a = 0; a < 3; ++a) { r.raw[a][0] = *(const unsigned*)(PrwA[a] + oS); r.raw[a][1] = *(const unsigned*)(PrwA[a] + oL); r.raw[a][2] = *(const unsigned*)(PrwA[a] + oR);
                r.raw[a][3] = *(const unsigned*)(PrwA[a] + oU); r.raw[a][4] = *(const unsigned*)(PrwA[a] + oD); }
            r.e = *(const unsigned*)((const char*)Ed + (unsigned)R * 2048u + (unsigned)(ch * 2)); r.a = *(const unsigned*)((const char*)Ad + (unsigned)R * 2048u + (unsigned)(ch * 2)); r.rn = rnp[(unsigned)R * 16u + (unsigned)h];
            r.vmask = (vL ? 1u : 0u) | (vR ? 2u : 0u) | (vU ? 4u : 0u) | (vD ? 8u : 0u); };
        auto stage = [&](int c, const RwRegs& r) { LAS float* bs = buf + ((c & 1) * 16 + ls) * 384 + 2 * cp; const bool vert = c >= 16;
            float sh[3][2];
#pragma unroll
            for (int a = 0; a < 3; ++a) {
                const unsigned rl = (r.vmask & 1u) ? r.raw[a][1] : 0u, rr_ = (r.vmask & 2u) ? r.raw[a][2] : 0u, ru = (r.vmask & 4u) ? r.raw[a][3] : 0u, rd = (r.vmask & 8u) ? r.raw[a][4] : 0u;
#pragma unroll
                for (int e = 0; e < 2; ++e) { const float pv = e ? bfhi(r.raw[a][0]) : bflo(r.raw[a][0]), l = e ? bfhi(rl) : bflo(rl), rr = e ? bfhi(rr_) : bflo(rr_), up = e ? bfhi(ru) : bflo(ru), dn = e ? bfhi(rd) : bflo(rd);
                    const float c0 = vert ? c0v[a][e] : c0h[a][e];
                    sh[a][e] = c0 * pv + mu_[a][0][e] * l + mu_[a][1][e] * rr + mu_[a][2][e] * up + mu_[a][3][e] * dn; } }
            f32x2 w, kk, bb, kd, rr2, vv;
#pragma unroll
            for (int e = 0; e < 2; ++e) { const float ev = e ? bfhi(r.e) : bflo(r.e), av = e ? bfhi(r.a) : bflo(r.a); const float ksh = sh[1][e];
                const float kkv = ksh * kkc[e] * r.rn;
                w[e] = __expf(-ev); kk[e] = kkv; bb[e] = kkv * av; kd[e] = ksh * (1.f + (av - 1.f) * kac[e]); rr2[e] = sh[0][e]; vv[e] = sh[2][e]; }
            *(LAS f32x2*)(bs + 0) = w; *(LAS f32x2*)(bs + 64) = kk; *(LAS f32x2*)(bs + 128) = bb; *(LAS f32x2*)(bs + 192) = kd; *(LAS f32x2*)(bs + 256) = rr2; *(LAS f32x2*)(bs + 320) = vv; };
        const int q = lane & 7, row = wave * 8 + (lane >> 3);
        f32x2 S[4];
#pragma unroll
        for (int i = 0; i < 4; ++i) S[i] = (f32x2){0.f, 0.f};
        RwRegs regs;
        issue(0, regs); stage(0, regs);
        __syncthreads();
        const int voff = 320 - q * 8 + row; const long ysgn = dir ? -1 : 1;
        for (int c = 0; c < 144; ++c) {
            if (c + 1 < 144) issue(c + 1, regs);
            const LAS float* cb = buf + (c & 1) * (16 * 384) + q * 8;
            if (c < 16) { float y0 = 0.f, y1 = 0.f; rw_chunk<false>(cb, voff, q, S, y0, y1); }
            else { float y0 = 0.f, y1 = 0.f; rw_chunk<true>(cb, voff, q, S, y0, y1);
                const long rb = rowof(c * 16);
                bf16_t* yp = Y + (rb + ysgn * q) * 1024 + h * 64 + row;
                yp[0] = f2bf(y0); yp[ysgn * 8 * 1024] = f2bf(y1); }
            if (c + 1 < 144) stage(c + 1, regs);
            __syncthreads();
        }
    }
}

__device__ __forceinline__ void post_rw(const Params& p, LAS unsigned char* lds, int wave, int lane) {
    const bf16_t* Y0 = (const bf16_t*)((unsigned char*)p.out + DO_Y); const bf16_t* Y1 = Y0 + (size_t)MLAT * 1024;
    const bf16_t* Prw = (const bf16_t*)(p.ws + WS_PRW); const bf16_t* Pzrw = (const bf16_t*)(p.ws + WS_PZRW); const float* bonus = (const float*)(p.ws + WS_BONUS);
    bf16_t* Yo = (bf16_t*)(p.ws + WS_YRW);
    const int gw = blockIdx.x * 8 + wave, NGW = gridDim.x * 8, c0 = lane * 16, head = lane >> 2;
    float gg[16], gb[16]; ldf<16>(p.rw_gn_g + c0, gg); ldf<16>(p.rw_gn_b + c0, gb);
    for (int tok = gw; tok < MLAT; tok += NGW) {
        float a[16], bq[16], z[16], vs[16];
        ldbf<16>(Y0 + (size_t)tok * 1024 + c0, a); ldbf<16>(Y1 + (size_t)tok * 1024 + c0, bq); ldbf<16>(Pzrw + (size_t)tok * 1024 + c0, z);
        const Nbr nb = nbr_of(tok);
        shifted<16>(Prw, tok, nb, 2048 + c0, p.rw_mu, vs);
        float s = 0.f;
#pragma unroll
        for (int i = 0; i < 16; ++i) { a[i] += bq[i]; s += a[i]; }
        s += __shfl_xor(s, 1); s += __shfl_xor(s, 2);
        const float mean = s * (1.f / 64.f); float vr = 0.f;
#pragma unroll
        for (int i = 0; i < 16; ++i) { a[i] -= mean; vr += a[i] * a[i]; }
        vr += __shfl_xor(vr, 1); vr += __shfl_xor(vr, 2);
        const float rstd = rsqrtf(vr * (1.f / 64.f) + 64e-5f), bon = bonus[(size_t)tok * 16 + head];
#pragma unroll
        for (int i = 0; i < 16; ++i) a[i] = (a[i] * rstd * gg[i] + gb[i] + bon * vs[i]) * z[i];
        stbf<16>(Yo + (size_t)tok * 1024 + c0, a);
    }
    LAS float* scr = (LAS float*)(lds + wave * 8448);
    bf16_t* wto1 = (bf16_t*)(p.ws + WS_WTO1); bf16_t* wto2 = (bf16_t*)(p.ws + WS_WTO2); bf16_t* wtg = (bf16_t*)(p.ws + WS_WTG);
    constexpr int I_1 = (1024 / 64) * (D / 32), I_2 = (D / 64) * (D / 32), I_G = (D / 64) * (4096 / 32);
    for (int it = gw; it < 2 * I_1 + I_2 + I_G; it += NGW) {
        if (it < I_1) transpose_item(p.w_hg_out, 1024, D, D, wto1, scr, it, lane);
        else if (it < 2 * I_1) transpose_item(p.w_rw_out, 1024, D, D, wto1 + (size_t)D * 1024, scr, it - I_1, lane);
        else if (it < 2 * I_1 + I_2) transpose_item(p.w_out, D, D, D, wto2, scr, it - 2 * I_1, lane);
        else transpose_item(p.w_in + NC1, D, NCOLS, 4096, wtg, scr, it - 2 * I_1 - I_2, lane);
    }
}

struct OrderOut1 {
    int G, c;
    __device__ bool next(int i, Unit& u) const { const int tile = (i >> 1) * G + c, br = i & 1; if (tile >= 512) return false; const int pm = tile >> 3, pn = tile & 7;
        if (br == 0) { u.pm = pm; u.pn = pn; } else { u.pm = pm + YRW_PM_OFF; u.pn = pn + 8; } return true; }
    __device__ __forceinline__ void a_ready(const Unit&) const {}
    __device__ __forceinline__ void done(const Unit&) const {}
};
struct EpiOut1 {
    static constexpr bool PERM = true, AFTER_DRAIN = false, CHAIN = true;
    unsigned char* ws;
    __device__ __forceinline__ bool chain(f32x4 (&acc)[2][2][4][2], const Unit& u, int wr, int wc, int fr, int fq) const {
        const int br = u.pn >> 3, ct = u.pn & 7, rt = u.pm & 63;
        const bf16_t* G = (const bf16_t*)(ws + WS_PGATE); bf16_t* Mg = (bf16_t*)(ws + WS_MERGED);
        const int row0 = rt * 256 + wr * 64 + fr, col0 = ct * 256 + wc * 32 + 8 * fq;
#pragma unroll
        for (int ai = 0; ai < 2; ++ai)
#pragma unroll
            for (int m = 0; m < 4; ++m) { const size_t row = (size_t)(row0 + ai * 128 + m * 16);
#pragma unroll
                for (int bj = 0; bj < 2; ++bj) { const int col = col0 + bj * 128; float g2[8]; ldbf<8>(G + row * 4096 + 2048 + col, g2);
#pragma unroll
                    for (int i = 0; i < 8; ++i) g2[i] = fmaxf(g2[i], 1e-30f);
                    if (br == 0) { float g1[8]; ldbf<8>(G + row * 4096 + col, g1);
#pragma unroll
                        for (int i = 0; i < 4; ++i) { acc[ai][bj][m][0][i] *= g1[i] * __builtin_amdgcn_rcpf(g2[i]); acc[ai][bj][m][1][i] *= g1[4 + i] * __builtin_amdgcn_rcpf(g2[4 + i]); } }
                    else { float v[8];
#pragma unroll
                        for (int i = 0; i < 4; ++i) { v[i] = acc[ai][bj][m][0][i] * g2[i]; v[4 + i] = acc[ai][bj][m][1][i] * g2[4 + i]; }
                        stbf<8>(Mg + row * 2048 + col, v); } } }
        return br == 0;
    }
};
struct EpiOut2 {
    static constexpr bool PERM = false, AFTER_DRAIN = false, CHAIN = false;
    const float* x; const float* mod; float* out;
    __device__ __forceinline__ void operator()(const f32x4 (&acc)[2][2][4][2], const Unit& u, int wr, int wc, int fr, int fq) const {
        const int row0 = u.pm * 256 + wr * 64 + fr, col0 = u.pn * 256 + wc * 32 + 4 * fq;
#pragma unroll
        for (int ai = 0; ai < 2; ++ai)
#pragma unroll
            for (int m = 0; m < 4; ++m) { const int row = row0 + ai * 128 + m * 16; const float* gate = mod + (row >> 11) * (3 * D) + 2 * D;
#pragma unroll
                for (int bj = 0; bj < 2; ++bj)
#pragma unroll
                    for (int n = 0; n < 2; ++n) { const int col = col0 + bj * 128 + n * 16; const f32x4 xv = *(const f32x4*)(x + (size_t)row * D + col), gv = *(const f32x4*)(gate + col);
                        *(f32x4*)(out + (size_t)row * D + col) = xv + gv * acc[ai][bj][m][n]; } }
    }
};
__device__ __forceinline__ void final_norm(const Params& p, int wave, int lane) {
    const int gw = blockIdx.x * 8 + wave, NGW = gridDim.x * 8;
    for (int row = gw; row < MLAT; row += NGW) {
        f32x4* xr = (f32x4*)(p.out + (size_t)row * D);
        f32x4 v[8]; float ss = 0.f;
#pragma unroll
        for (int j = 0; j < 8; ++j) { v[j] = xr[lane + 64 * j]; ss += (v[j].x * v[j].x + v[j].y * v[j].y) + (v[j].z * v[j].z + v[j].w * v[j].w); }
        ss = wave_sum(ss);
        const float rstd = rsqrtf(ss * (1.f / D) + 1e-6f);
#pragma unroll
        for (int j = 0; j < 8; ++j) { const f32x4 g = *(const f32x4*)(p.final_g + 4 * (lane + 64 * j)); xr[lane + 64 * j] = v[j] * rstd * g; }
    }
}


__device__ __forceinline__ void rw_scan4(const Params& p, LAS unsigned char* lds, int tid, int wave, int lane) {
    LAS float* buf = (LAS float*)lds;
    const bf16_t* Prw = (const bf16_t*)(p.ws + WS_PRW); const float* rnp = (const float*)(p.ws + WS_RN);
    bf16_t* Ybase = (bf16_t*)((unsigned char*)p.out + DO_Y);
    for (int u = blockIdx.x; u < 256; u += gridDim.x) {
        const int b = u >> 5, h = (u >> 1) & 15, dir = u & 1;
        const bf16_t* Ed = (const bf16_t*)(p.ws + (dir ? WS_E1 : WS_E0)); const bf16_t* Ad = (const bf16_t*)(p.ws + (dir ? WS_A1 : WS_A0));
        bf16_t* Y = Ybase + (size_t)dir * MLAT * 1024;
        const int ls0 = tid >> 5, cp = tid & 31, ch = h * 64 + 2 * cp;
        float mu_[3][4][2];
#pragma unroll
        for (int a = 0; a < 3; ++a)
#pragma unroll
            for (int m = 0; m < 4; ++m) { const f32x2 t = *(const f32x2*)(p.rw_mu + m * SHC + a * 1024 + ch); mu_[a][m][0] = t.x; mu_[a][m][1] = t.y; }
        const f32x2 kkc = *(const f32x2*)(p.rw_kk + ch), kac = *(const f32x2*)(p.rw_ka + ch);
        auto rowof = [&](int tau) -> int { if (tau < CTXL) { const int t = dir ? (CTXL - 1 - tau) : tau; return MLAT + b * CTXL + t; } const int t0 = tau - CTXL; const int t = dir ? (SEQ - 1 - t0) : t0; return b * SEQ + t; };
        auto issue = [&](int c, int ls, RwRegs& r) { const int R = rowof(c * 16 + ls); const Nbr nb = nbr_of(R);
#pragma unroll
            for (int a = 0; a < 3; ++a) { const bf16_t* base = Prw + a * 1024 + ch;
                r.raw[a][0] = *(const unsigned*)(base + (size_t)R * SHC);
                r.raw[a][1] = nb.L >= 0 ? *(const unsigned*)(base + (size_t)nb.L * SHC) : 0u;
                r.raw[a][2] = nb.R >= 0 ? *(const unsigned*)(base + (size_t)nb.R * SHC) : 0u;
                r.raw[a][3] = nb.U >= 0 ? *(const unsigned*)(base + (size_t)nb.U * SHC) : 0u;
                r.raw[a][4] = nb.Dn >= 0 ? *(const unsigned*)(base + (size_t)nb.Dn * SHC) : 0u; }
            r.e = *(const unsigned*)(Ed + (size_t)R * 1024 + ch); r.a = *(const unsigned*)(Ad + (size_t)R * 1024 + ch); r.rn = rnp[(size_t)R * 16 + h]; };
        auto stage = [&](int c, int ls, const RwRegs& r) { LAS float* bs = buf + ((c & 1) * 16 + ls) * 384 + 2 * cp; const bool vert = c >= 16;
            float sh[3][2];
#pragma unroll
            for (int a = 0; a < 3; ++a)
#pragma unroll
                for (int e = 0; e < 2; ++e) { const float pv = e ? bfhi(r.raw[a][0]) : bflo(r.raw[a][0]), l = e ? bfhi(r.raw[a][1]) : bflo(r.raw[a][1]), rr = e ? bfhi(r.raw[a][2]) : bflo(r.raw[a][2]),
                                                  up = e ? bfhi(r.raw[a][3]) : bflo(r.raw[a][3]), dn = e ? bfhi(r.raw[a][4]) : bflo(r.raw[a][4]);
                    float o = pv + mu_[a][0][e] * (l - pv) + mu_[a][1][e] * (rr - pv);
                    if (vert) o += mu_[a][2][e] * (up - pv) + mu_[a][3][e] * (dn - pv);
                    sh[a][e] = o; }
            f32x2 w, kk, bb, kd, rr2, vv;
#pragma unroll
            for (int e = 0; e < 2; ++e) { const float ev = e ? bfhi(r.e) : bflo(r.e), av = e ? bfhi(r.a) : bflo(r.a); const float ksh = sh[1][e];
                const float kkv = ksh * kkc[e] * r.rn;
                w[e] = __expf(-ev); kk[e] = kkv; bb[e] = kkv * av; kd[e] = ksh * (1.f + (av - 1.f) * kac[e]); rr2[e] = sh[0][e]; vv[e] = sh[2][e]; }
            *(LAS f32x2*)(bs + 0) = w; *(LAS f32x2*)(bs + 64) = kk; *(LAS f32x2*)(bs + 128) = bb; *(LAS f32x2*)(bs + 192) = kd; *(LAS f32x2*)(bs + 256) = rr2; *(LAS f32x2*)(bs + 320) = vv; };
        const int rg = lane >> 4, q = lane & 15, row0 = wave * 16 + rg * 4; const bool b0 = (q & 1) != 0, b1 = (q & 2) != 0;
        const int myrow = row0 + ((q & 1) << 1) + ((q >> 1) & 1);
        float S[4][4];
#pragma unroll
        for (int i = 0; i < 4; ++i)
#pragma unroll
            for (int j = 0; j < 4; ++j) S[i][j] = 0.f;
        RwRegs ra, rb;
        issue(0, ls0, ra); issue(0, ls0 + 8, rb); stage(0, ls0, ra); stage(0, ls0 + 8, rb);
        __syncthreads();
        for (int c = 0; c < 144; ++c) {
            if (c + 1 < 144) { issue(c + 1, ls0, ra); issue(c + 1, ls0 + 8, rb); }
            const bool lat = c >= 16;
#pragma unroll 2
            for (int s = 0; s < 16; ++s) {
                const LAS float* bs = buf + ((c & 1) * 16 + s) * 384;
                const f32x4 w4 = *(const LAS f32x4*)(bs + q * 4), kk4 = *(const LAS f32x4*)(bs + 64 + q * 4), b4 = *(const LAS f32x4*)(bs + 128 + q * 4), kd4 = *(const LAS f32x4*)(bs + 192 + q * 4), r4 = *(const LAS f32x4*)(bs + 256 + q * 4);
                const f32x4 v4 = *(const LAS f32x4*)(bs + 320 + row0);
                float pp[4];
#pragma unroll
                for (int i = 0; i < 4; ++i) pp[i] = (S[i][0] * kk4[0] + S[i][1] * kk4[1]) + (S[i][2] * kk4[2] + S[i][3] * kk4[3]);
                float ta = (b0 ? pp[2] : pp[0]) + dpp<0xB1>(b0 ? pp[0] : pp[2]);
                float tb = (b0 ? pp[3] : pp[1]) + dpp<0xB1>(b0 ? pp[1] : pp[3]);
                float t = (b1 ? tb : ta) + dpp<0x4E>(b1 ? ta : tb);
                t += dpp<0x124>(t); t += dpp<0x128>(t);
                float sa[4]; sa[0] = dpp<0x00>(t); sa[1] = dpp<0xAA>(t); sa[2] = dpp<0x55>(t); sa[3] = dpp<0xFF>(t);
#pragma unroll
                for (int i = 0; i < 4; ++i)
#pragma unroll
                    for (int j = 0; j < 4; ++j) S[i][j] = S[i][j] * w4[j] + (v4[i] * kd4[j] - sa[i] * b4[j]);
                if (lat) {
#pragma unroll
                    for (int i = 0; i < 4; ++i) pp[i] = (S[i][0] * r4[0] + S[i][1] * r4[1]) + (S[i][2] * r4[2] + S[i][3] * r4[3]);
                    float ya = (b0 ? pp[2] : pp[0]) + dpp<0xB1>(b0 ? pp[0] : pp[2]);
                    float yb = (b0 ? pp[3] : pp[1]) + dpp<0xB1>(b0 ? pp[1] : pp[3]);
                    float y = (b1 ? yb : ya) + dpp<0x4E>(b1 ? ya : yb);
                    y += dpp<0x124>(y); y += dpp<0x128>(y);
                    if (q < 4) Y[(size_t)rowof(c * 16 + s) * 1024 + h * 64 + myrow] = f2bf(y);
                }
            }
            if (c + 1 < 144) { stage(c + 1, ls0, ra); stage(c + 1, ls0 + 8, rb); }
            __syncthreads();
        }
    }
}

__device__ __forceinline__ void hg_scan4(const Params& p, LAS unsigned char* lds, int tid, int wave, int lane) {
    LAS bf16_t* qd = (LAS bf16_t*)(lds);
    LAS bf16_t* kd = (LAS bf16_t*)(lds + 17408);
    LAS bf16_t* kdT = (LAS bf16_t*)(lds + 34816);
    LAS bf16_t* vT = (LAS bf16_t*)(lds + 53248);
    LAS bf16_t* ST = (LAS bf16_t*)(lds + 62464);
    LAS bf16_t* at = (LAS bf16_t*)(lds + 79872);
    LAS float* tot = (LAS float*)(lds + 89088);
    const bf16_t* Pq = (const bf16_t*)(p.ws + WS_PQ); const bf16_t* Pi = (const bf16_t*)(p.ws + WS_PI);
    bf16_t* Obase = (bf16_t*)((unsigned char*)p.out + DO_O);
    const int l15 = lane & 15, fq = lane >> 4;
    for (int u = blockIdx.x; u < 256; u += gridDim.x) {
        const int b = u >> 5, h = (u >> 2) & 7, dir = (u >> 1) & 1, vh = u & 1;
        const bf16_t* Pg = (const bf16_t*)(p.ws + (dir ? WS_PGB : WS_PGF));
        bf16_t* O = Obase + (size_t)dir * MLAT * 1024;
        const int k0 = 2 * lane, qtr = wave, vs = tid >> 2, vq = tid & 3;
        const int sgn = dir ? -1 : 1;
        auto rbase = [&](int c) -> int { if (c < 4) return MLAT + b * CTXL + (dir ? (CTXL - 1 - c * 64) : c * 64); const int t0 = (c - 4) * 64; return b * SEQ + (dir ? (SEQ - 1 - t0) : t0); };
        const long rstep = (long)sgn * 1024;
        f32x4 S[2][4];
#pragma unroll
        for (int a = 0; a < 2; ++a)
#pragma unroll
            for (int i = 0; i < 4; ++i) S[a][i] = (f32x4){0.f, 0.f, 0.f, 0.f};
        unsigned gN[16], qN[16]; u32x4 vN[2];
#pragma unroll
        for (int j = 0; j < 16; ++j) { const long o = ((long)rbase(0) + sgn * (qtr * 16)) * 1024 + h * 128 + k0 + j * rstep; gN[j] = *(const unsigned*)(Pg + o); qN[j] = *(const unsigned*)(Pq + o); }
#pragma unroll
        for (int i = 0; i < 2; ++i) vN[i] = *(const u32x4*)(Pi + ((long)rbase(0) + sgn * vs) * 1024 + h * 128 + vh * 64 + vq * 16 + i * 8);
        __syncthreads();
        for (int c = 0; c < 36; ++c) {
            unsigned g[16], q[16]; const u32x4 vC0 = vN[0], vC1 = vN[1];
#pragma unroll
            for (int j = 0; j < 16; ++j) { g[j] = gN[j]; q[j] = qN[j]; }
            if (c + 1 < 36) {
                const long rb1 = rbase(c + 1);
                const bf16_t* gp = Pg + (rb1 + sgn * (qtr * 16)) * 1024 + h * 128 + k0; const bf16_t* qp_ = Pq + (rb1 + sgn * (qtr * 16)) * 1024 + h * 128 + k0;
#pragma unroll
                for (int j = 0; j < 16; ++j) { gN[j] = *(const unsigned*)(gp + j * rstep); qN[j] = *(const unsigned*)(qp_ + j * rstep); }
#pragma unroll
                for (int i = 0; i < 2; ++i) vN[i] = *(const u32x4*)(Pi + (rb1 + sgn * vs) * 1024 + h * 128 + vh * 64 + vq * 16 + i * 8);
            }
            float run0 = 0.f, run1 = 0.f;
#pragma unroll
            for (int j = 0; j < 16; ++j) { run0 += bflo(g[j]); run1 += bfhi(g[j]); }
            *(LAS f32x2*)(tot + qtr * 128 + k0) = (f32x2){run0, run1};
            __syncthreads();
            {
                const f32x2 t0 = *(const LAS f32x2*)(tot + k0), t1 = *(const LAS f32x2*)(tot + 128 + k0), t2 = *(const LAS f32x2*)(tot + 256 + k0);
                const float mid0 = t0.x + t1.x, mid1 = t0.y + t1.y;
                const float off0 = qtr == 0 ? 0.f : (qtr == 1 ? t0.x : (qtr == 2 ? mid0 : mid0 + t2.x));
                const float off1 = qtr == 0 ? 0.f : (qtr == 1 ? t0.y : (qtr == 2 ? mid1 : mid1 + t2.y));
                unsigned kp0[8], kp1[8]; float bc0 = off0, bc1 = off1;
#pragma unroll
                for (int j = 0; j < 16; j += 2) {
                    float kv0[2], kv1[2];
#pragma unroll
                    for (int e = 0; e < 2; ++e) { const int jj = j + e;
                        bc0 += bflo(g[jj]); bc1 += bfhi(g[jj]);
                        const float qv0 = bflo(q[jj]) * __expf(fminf(bc0 - mid0, 80.f)), qv1 = bfhi(q[jj]) * __expf(fminf(bc1 - mid1, 80.f));
                        kv0[e] = (1.f - __expf(bflo(g[jj]))) * __expf(fminf(mid0 - bc0, 80.f)); kv1[e] = (1.f - __expf(bfhi(g[jj]))) * __expf(fminf(mid1 - bc1, 80.f));
                        const int t = qtr * 16 + jj;
                        *(LAS unsigned*)(qd + t * 136 + k0) = cvt_pk_bf16(qv0, qv1); *(LAS unsigned*)(kd + t * 136 + k0) = cvt_pk_bf16(kv0[e], kv1[e]); }
                    kp0[j >> 1] = cvt_pk_bf16(kv0[0], kv0[1]); kp1[j >> 1] = cvt_pk_bf16(kv1[0], kv1[1]);
                }
                *(LAS u32x4*)(kdT + k0 * 72 + qtr * 16) = (u32x4){kp0[0], kp0[1], kp0[2], kp0[3]};
                *(LAS u32x4*)(kdT + k0 * 72 + qtr * 16 + 8) = (u32x4){kp0[4], kp0[5], kp0[6], kp0[7]};
                *(LAS u32x4*)(kdT + (k0 + 1) * 72 + qtr * 16) = (u32x4){kp1[0], kp1[1], kp1[2], kp1[3]};
                *(LAS u32x4*)(kdT + (k0 + 1) * 72 + qtr * 16 + 8) = (u32x4){kp1[4], kp1[5], kp1[6], kp1[7]};
#pragma unroll
                for (int kt = 0; kt < 2; ++kt) { const int kb = 32 * wave + 16 * kt + fq * 4;
                    float em[4];
#pragma unroll
                    for (int j = 0; j < 4; ++j) em[j] = __expf(tot[kb + j] + tot[128 + kb + j]);
#pragma unroll
                    for (int nt = 0; nt < 4; ++nt) { u32x2 w; w.x = cvt_pk_bf16(S[kt][nt][0] * em[0], S[kt][nt][1] * em[1]); w.y = cvt_pk_bf16(S[kt][nt][2] * em[2], S[kt][nt][3] * em[3]);
                        *(LAS u32x2*)(ST + (nt * 16 + l15) * 136 + kb) = w; } }
                const unsigned vw[8] = {vC0.x, vC0.y, vC0.z, vC0.w, vC1.x, vC1.y, vC1.z, vC1.w};
#pragma unroll
                for (int i = 0; i < 8; ++i) { vT[(vq * 16 + 2 * i) * 72 + vs] = (bf16_t)(vw[i] & 0xffffu); vT[(vq * 16 + 2 * i + 1) * 72 + vs] = (bf16_t)(vw[i] >> 16); }
            }
            __syncthreads();
            const bool lat = c >= 4;
            if (lat) {
                const int tt = wave;
#pragma unroll
                for (int st = 0; st < 4; ++st) {
                    f32x4 a = (f32x4){0.f, 0.f, 0.f, 0.f};
                    if (st <= tt) {
#pragma unroll
                        for (int ks = 0; ks < 4; ++ks) { const bf16x8 A = *(const LAS bf16x8*)(qd + (tt * 16 + l15) * 136 + ks * 32 + fq * 8); const bf16x8 B = *(const LAS bf16x8*)(kd + (st * 16 + l15) * 136 + ks * 32 + fq * 8); a = mfma16(A, B, a); } }
#pragma unroll
                    for (int j = 0; j < 4; ++j) { const int t = tt * 16 + fq * 4 + j, s = st * 16 + l15; at[t * 72 + s] = f2bf(s <= t ? a[j] : 0.f); } }
            }
            __syncthreads();
            if (lat) {
                const int tt = wave;
#pragma unroll
                for (int nt = 0; nt < 4; ++nt) {
                    f32x4 o = (f32x4){0.f, 0.f, 0.f, 0.f};
#pragma unroll
                    for (int ks = 0; ks < 2; ++ks) { const bf16x8 A = *(const LAS bf16x8*)(at + (tt * 16 + l15) * 72 + ks * 32 + fq * 8); const bf16x8 B = *(const LAS bf16x8*)(vT + (nt * 16 + l15) * 72 + ks * 32 + fq * 8); o = mfma16(A, B, o); }
#pragma unroll
                    for (int ks = 0; ks < 4; ++ks) { const bf16x8 A = *(const LAS bf16x8*)(qd + (tt * 16 + l15) * 136 + ks * 32 + fq * 8); const bf16x8 B = *(const LAS bf16x8*)(ST + (nt * 16 + l15) * 136 + ks * 32 + fq * 8); o = mfma16(A, B, o); }
#pragma unroll
                    for (int j = 0; j < 4; ++j) { const long row = (long)rbase(c) + sgn * (tt * 16 + fq * 4 + j); O[row * 1024 + h * 128 + vh * 64 + nt * 16 + l15] = f2bf(o[j]); } }
            }
#pragma unroll
            for (int kt = 0; kt < 2; ++kt) { const int kb = 32 * wave + 16 * kt;
                float eb[4], e2[4];
#pragma unroll
                for (int j = 0; j < 4; ++j) { const int kj = kb + fq * 4 + j; const float m = tot[kj] + tot[128 + kj], bl = m + tot[256 + kj] + tot[384 + kj]; eb[j] = __expf(bl); e2[j] = __expf(bl - m); }
#pragma unroll
                for (int nt = 0; nt < 4; ++nt) { f32x4 tmp = (f32x4){0.f, 0.f, 0.f, 0.f};
#pragma unroll
                    for (int ks = 0; ks < 2; ++ks) { const bf16x8 A = *(const LAS bf16x8*)(kdT + (kb + l15) * 72 + ks * 32 + fq * 8); const bf16x8 B = *(const LAS bf16x8*)(vT + (nt * 16 + l15) * 72 + ks * 32 + fq * 8); tmp = mfma16(A, B, tmp); }
#pragma unroll
                    for (int j = 0; j < 4; ++j) S[kt][nt][j] = eb[j] * S[kt][nt][j] + e2[j] * tmp[j]; } }
            __syncthreads();
        }
    }
}

#define XB_TMO      128
#define XB_XCNT(j)  (256  + 64 * (j))
#define XB_XSUB(j)  (1280 + 64 * (j))
#define XB_XGEN(j)  (2304 + 64 * (j))
#define XB_TOP      3328
#define XB_TOPGEN   3392
#define XCD_BAR_WORDS 3456
#define XB_SPIN_CAP (1u << 18)

__device__ __forceinline__ unsigned xb_ld(unsigned* p)              { return __hip_atomic_load(p, __ATOMIC_RELAXED, __HIP_MEMORY_SCOPE_AGENT); }
__device__ __forceinline__ unsigned xb_add(unsigned* p, unsigned v) { return __hip_atomic_fetch_add(p, v, __ATOMIC_RELAXED, __HIP_MEMORY_SCOPE_AGENT); }
__device__ __forceinline__ unsigned xb_xcc_id() { return (unsigned)__builtin_amdgcn_s_getreg((3 << 11) | 20) & 0xFu; }
#define XB_SPIN(cond, bar) do { unsigned _sp = 0; while (cond) { __builtin_amdgcn_s_sleep(1); \
    if ((++_sp & 255u) == 0u) { if (xb_ld(&(bar)[XB_TMO])) break; if (_sp > XB_SPIN_CAP) { atomicAdd(&(bar)[XB_TMO], 1u); break; } } } } while (0)

struct XcdBarrier {
    unsigned* bar; unsigned x;
    volatile LAS unsigned* st;
};

__device__ __forceinline__ XcdBarrier xcd_barrier_post(unsigned* bar, volatile LAS unsigned* st) {
    XcdBarrier b; b.bar = bar; b.x = xb_xcc_id(); b.st = st;
    if (threadIdx.x == 0) (void)xb_add(&bar[XB_XCNT(b.x)], 1u);
    return b;
}
__device__ __forceinline__ void xcd_barrier_complete(unsigned* bar, unsigned x, unsigned& nloc, unsigned& nx) {
    const unsigned G = gridDim.x * gridDim.y * gridDim.z;
    unsigned sum, cnt, mine, sp = 0u;
    for (;;) {
        sum = 0u; cnt = 0u; mine = 0u;
#pragma unroll
        for (unsigned j = 0; j < 16; ++j) { const unsigned c = xb_ld(&bar[XB_XCNT(j)]); sum += c; cnt += (c > 0u) ? 1u : 0u; mine = (j == x) ? c : mine; }
        if (sum == G) break;
        __builtin_amdgcn_s_sleep(1);
        if ((++sp & 255u) == 0u) { if (xb_ld(&bar[XB_TMO])) break; if (sp > XB_SPIN_CAP) { atomicAdd(&bar[XB_TMO], 1u); break; } }
    }
    nloc = mine > 0u ? mine : 1u; nx = cnt > 0u ? cnt : 1u;
}

__device__ __forceinline__ void xcd_barrier(const XcdBarrier& b) {
    asm volatile("s_waitcnt vmcnt(0)" ::: "memory");
    __syncthreads();
    if (threadIdx.x == 0) {
        unsigned* bar = b.bar;
        __builtin_amdgcn_s_waitcnt(0);
        unsigned nloc = b.st[0], nx = b.st[1];
        if (nloc == 0u) { xcd_barrier_complete(bar, b.x, nloc, nx); b.st[0] = nloc; b.st[1] = nx; }
        const unsigned old = xb_add(&bar[XB_XSUB(b.x)], 1u);
        const unsigned gen = old / nloc;
        if (old + 1u == (gen + 1u) * nloc) {
            __builtin_amdgcn_fence(__ATOMIC_RELEASE, "agent");
            asm volatile("s_waitcnt vmcnt(0)" ::: "memory");
            const unsigned og = xb_add(&bar[XB_TOP], 1u);
            const unsigned tg = og / nx;
            if (og + 1u == (tg + 1u) * nx) xb_add(&bar[XB_TOPGEN], 1u);
            else XB_SPIN(xb_ld(&bar[XB_TOPGEN]) == tg, bar);
            __builtin_amdgcn_fence(__ATOMIC_ACQUIRE, "agent");
            xb_add(&bar[XB_XGEN(b.x)], 1u);
            asm volatile("s_waitcnt vmcnt(0)" ::: "memory");
        } else {
            XB_SPIN(xb_ld(&bar[XB_XGEN(b.x)]) == gen, bar);
            __builtin_amdgcn_fence(__ATOMIC_ACQUIRE, "agent");
            asm volatile("s_waitcnt vmcnt(0)" ::: "memory");
        }
    }
    __syncthreads();
}


#ifndef GA
#define GA true
#endif
#ifndef GS
#define GS true
#endif
#ifndef COMBINED
#define COMBINED 0
#endif

__global__ void __launch_bounds__(512, 2) mega(Params p) {
    extern __shared__ __attribute__((aligned(16))) unsigned char shm[];
    LAS unsigned char* lds = (LAS unsigned char*)shm;
    cg::grid_group grid = cg::this_grid();
    const int tid = threadIdx.x, wave = __builtin_amdgcn_readfirstlane(tid >> 6), lane = tid & 63;
    volatile LAS unsigned* xst = (volatile LAS unsigned*)(lds + 131072);
    if (tid == 0) { xst[0] = 0u; xst[1] = 0u; }
    __syncthreads();
    const XcdBarrier xb = xcd_barrier_post((unsigned*)(p.ws + WS_BAR), xst);
    phase0(p, lds, tid, wave, lane);
    if (p.ws == nullptr) grid.sync();
    xcd_barrier(xb);
    phase1(p, (bf16_t*)((unsigned char*)p.out + DO_H), MTOT, wave, lane);
    xcd_barrier(xb);
    { pg8::Gemm g{(const bf16_t*)((unsigned char*)p.out + DO_H), (const bf16_t*)((unsigned char*)p.out + DO_WTIN), MTOT, NC1, D};
      InOrder S{(int)gridDim.x, (int)blockIdx.x}; EpiProj E{p.ws};
      pg8::gemm_phase<EpiProj, InOrder, GA, GS>(lds, g, S, E); }
    xcd_barrier(xb);
    rw_prep(p, lds, wave, lane);
    xcd_barrier(xb);
#if COMBINED
    if (wave < 4) rw_scan4(p, lds, tid, wave, lane);
    else hg_scan4(p, lds + RW_LDS, tid - 256, wave - 4, lane);
#else
    hg_scan(p, lds, tid, wave, lane);
    rw_scan(p, lds, tid, wave, lane);
#endif
    xcd_barrier(xb);
    post_hg(p, wave, lane);
    post_rw(p, lds, wave, lane);
    phase1(p, (bf16_t*)(p.ws + WS_H2), MLAT, wave, lane);
    xcd_barrier(xb);
    { pg8::Gemm g{(const bf16_t*)(p.ws + WS_H2), (const bf16_t*)(p.ws + WS_WTG), MLAT, 4096, D};
      pg8::StaticOrder S; S.init(MLAT, 4096, (int)gridDim.x, (int)blockIdx.x); EpiGate E{p.ws};
      pg8::gemm_phase<EpiGate, pg8::StaticOrder, GA, GS>(lds, g, S, E); }
    xcd_barrier(xb);
    { pg8::Gemm g{(const bf16_t*)(p.ws + WS_YHG), (const bf16_t*)(p.ws + WS_WTO1), 0, 0, 1024};
      OrderOut1 S{(int)gridDim.x, (int)blockIdx.x}; EpiOut1 E{p.ws};
      pg8::gemm_phase<EpiOut1, OrderOut1, GA, GS>(lds, g, S, E); }
    xcd_barrier(xb);
    { pg8::Gemm g{(const bf16_t*)(p.ws + WS_MERGED), (const bf16_t*)(p.ws + WS_WTO2), MLAT, D, D};
      pg8::StaticOrder S; S.init(MLAT, D, (int)gridDim.x, (int)blockIdx.x); EpiOut2 E{p.x, (const float*)(p.ws + WS_MOD), p.out};
      pg8::gemm_phase<EpiOut2, pg8::StaticOrder, GA, GS>(lds, g, S, E); }
    xcd_barrier(xb);
    final_norm(p, wave, lane);
}
}

extern "C" void kernel_launch(void* const* d_in, const int* in_sizes, int n_in, void* d_out, int out_size, void* d_ws, size_t ws_size, hipStream_t stream) {
    static int grid = 0;
    if (grid == 0) {
        if (n_in != 24 || ws_size < mk::WS_END) { fprintf(stderr, "kernel_launch: unexpected inputs (n_in %d, ws %zu)\n", n_in, ws_size); grid = -1; return; }
        int dev = 0, cus = 0, per_cu = 0;
        (void)hipGetDevice(&dev); (void)hipDeviceGetAttribute(&cus, hipDeviceAttributeMultiprocessorCount, dev);
        if (hipFuncSetAttribute((const void*)mk::mega, hipFuncAttributeMaxDynamicSharedMemorySize, mk::LDS_BYTES) != hipSuccess) { fprintf(stderr, "kernel_launch: hipFuncSetAttribute failed\n"); }
        if (hipOccupancyMaxActiveBlocksPerMultiprocessor(&per_cu, (const void*)mk::mega, 512, mk::LDS_BYTES) != hipSuccess || per_cu < 1) per_cu = 1;
        (void)hipGetLastError();
        grid = cus * (per_cu > 1 ? 1 : per_cu);
        if (grid <= 0) grid = 256;
    }
    if (grid < 0) return;
    mk::Params p{};
    const float** f = (const float**)&p;
    for (int i = 0; i < 24; ++i) f[i] = (const float*)d_in[i];
    p.out = (float*)d_out; p.ws = (unsigned char*)d_ws;
    (void)hipMemsetAsync((unsigned char*)d_ws + mk::WS_BAR, 0, XCD_BAR_WORDS * sizeof(unsigned), stream);
    void* args[] = {&p};
    hipError_t e = hipLaunchCooperativeKernel((const void*)mk::mega, dim3(grid), dim3(512), args, mk::LDS_BYTES, stream);
    if (e != hipSuccess) fprintf(stderr, "cooperative launch failed: %s (grid %d)\n", hipGetErrorString(e), grid);
}
```

```cpp
#include <hip/hip_runtime.h>
#include <hip/hip_cooperative_groups.h>
#include <cstdio>
#include <cstdint>
namespace cg = cooperative_groups;
namespace pg8 {
#define PG8_LAS __attribute__((address_space(3)))
typedef unsigned short bf16_t;
typedef short bf16x8 __attribute__((ext_vector_type(8)));
typedef float f32x4 __attribute__((ext_vector_type(4)));
typedef unsigned u32x4 __attribute__((ext_vector_type(4)));
constexpr int BM = 256, BK = 64, HALF = 128, HTB = HALF * BK * 2  , STAGE_BYTES = 8 * HTB, NXCD = 8, WGM = 4;

__host__ __device__ __forceinline__ int lds_byte(int r, int c) { const int st = (r >> 4) * 2 + (c >> 5), rr = r & 15, cc = c & 31, ob = rr * 64 + cc * 2; return st * 1024 + (ob ^ (((ob >> 9) & 1) << 5)); }
__host__ __device__ __forceinline__ void stage_rc(int b, int& R, int& C) { const int st = b / 1024, sb = b % 1024, swz = sb ^ (((sb >> 9) & 1) << 5); R = (st >> 1) * 16 + swz / 64; C = (st & 1) * 32 + (swz % 64) / 2; }
__host__ __device__ __forceinline__ int perm32(int rho) { const int n = rho >> 4, i = rho & 15; return 8 * (i >> 2) + 4 * n + (i & 3); }

struct Unit { int pm, pn; };
struct Gemm { const bf16_t* A; const bf16_t* Bt; int M, N, K; };

struct StaticOrder {
    int nM, nN, nwg, G, c;
    __host__ __device__ void init(int M, int N, int G_, int c_) { nM = M / BM; nN = N / BM; nwg = nM * nN; G = G_; c = c_; }
    __host__ __device__ bool next(int i, Unit& u) const {
        const long L = (long)i * G + c; if (L >= nwg) return false;
        int wgid = (int)L; { const int q = nwg / NXCD, r = nwg % NXCD, xcd = wgid % NXCD, off = wgid / NXCD; wgid = (xcd < r ? xcd * (q + 1) : r * (q + 1) + (xcd - r) * q) + off; }
        const int nig = WGM * nN, gid = wgid / nig, fm = gid * WGM, gsz = (nM - fm) < WGM ? (nM - fm) : WGM;
        u.pm = fm + ((wgid % nig) % gsz); u.pn = (wgid % nig) / gsz; return true;
    }
    __device__ __forceinline__ void a_ready(const Unit&) const {}
    __device__ __forceinline__ void done(const Unit&) const {}
};
typedef float f32x2 __attribute__((ext_vector_type(2)));
typedef __bf16 bf16x2v __attribute__((ext_vector_type(2)));
__device__ __forceinline__ unsigned cvt_pk_bf16(float lo, float hi) { const f32x2 v = {lo, hi}; const bf16x2v b = __builtin_convertvector(v, bf16x2v); return __builtin_bit_cast(unsigned, b); }
template <class Epi, class Sched, bool ALIGN_EPI = false, bool SP2 = false>
__device__ __forceinline__ void gemm_phase(PG8_LAS unsigned char* lds, const Gemm g, const Sched& S, const Epi& E) {
    const int tid = threadIdx.x, wid = __builtin_amdgcn_readfirstlane(tid >> 6), lane = tid & 63, wr = wid >> 2, wc = wid & 3, fr = lane & 15, fq = lane >> 4;
    const int K = g.K, nt = K / BK;
    unsigned voffA[2], voffB[2];
#pragma unroll
    for (int i = 0; i < 2; ++i) { int R, C; stage_rc(tid * 16 + i * 8192, R, C); const int Rb = Epi::PERM ? ((R & ~31) + perm32(R & 31)) : R;
        voffA[i] = (unsigned)(R * K + C) * 2u; voffB[i] = (unsigned)(Rb * K + C) * 2u; }
    const size_t kstep = (size_t)(BK * 2);
    const size_t hstep = (size_t)HALF * K * 2;
    const size_t tstep = 2 * hstep;
    const unsigned ldsw = (unsigned)wid * 1024u;
    const int aoff = lds_byte(wr * 64 + fr, fq * 8), boff = lds_byte(wc * 32 + fr, fq * 8);
#define PG8_SA(b, h) (((b) * 2 + (h)) * HTB)
#define PG8_SB(b, h) ((4 + (b) * 2 + (h)) * HTB)
#define PG8_STAGE(bufoff, gbase, voff) do { _Pragma("unroll") for (int _i = 0; _i < 2; ++_i) \
        __builtin_amdgcn_global_load_lds((const unsigned*)((const char*)(gbase) + (voff)[_i]), (PG8_LAS unsigned*)(lds + (bufoff) + ldsw + _i * 8192), 16, 0, 0); } while (0)
#define PG8_LDA(dst, b, h) do { _Pragma("unroll") for (int m = 0; m < 4; ++m) _Pragma("unroll") for (int k = 0; k < 2; ++k) dst[m][k] = *(const PG8_LAS bf16x8*)(lds + PG8_SA(b, h) + aoff + m * 2048 + k * 1024); } while (0)
#define PG8_LDB(dst, b, h) do { _Pragma("unroll") for (int n = 0; n < 2; ++n) _Pragma("unroll") for (int k = 0; k < 2; ++k) dst[n][k] = *(const PG8_LAS bf16x8*)(lds + PG8_SB(b, h) + boff + n * 2048 + k * 1024); } while (0)
#define PG8_MMA(ai, bj, At, Bt) do { __builtin_amdgcn_s_setprio(1); _Pragma("unroll") for (int m = 0; m < 4; ++m) _Pragma("unroll") for (int n = 0; n < 2; ++n) _Pragma("unroll") for (int k = 0; k < 2; ++k) \
        acc[ai][bj][m][n] = __builtin_amdgcn_mfma_f32_16x16x32_bf16(Bt[n][k], At[m][k], acc[ai][bj][m][n], 0, 0, 0); __builtin_amdgcn_s_setprio(0); } while (0)
#define PG8_WAIT_V(n) asm volatile("s_waitcnt vmcnt(" #n ")" ::: "memory")
#define PG8_WAIT_L(n) asm volatile("s_waitcnt lgkmcnt(" #n ")" ::: "memory")
#define PG8_BAR __builtin_amdgcn_s_barrier()
#define PG8_SCHED __builtin_amdgcn_sched_barrier(0)
    Unit cur, nxt; int ui = 0;
    if (!S.next(0, cur)) return;
    f32x4 acc[2][2][4][2];
#pragma unroll
    for (int a = 0; a < 2; ++a)
#pragma unroll
        for (int b = 0; b < 2; ++b)
#pragma unroll
            for (int m = 0; m < 4; ++m)
#pragma unroll
                for (int n = 0; n < 2; ++n) acc[a][b][m][n] = (f32x4){0.f, 0.f, 0.f, 0.f};
    bf16x8 At[4][2], B0[2][2], B1[2][2];
    const char* cA = (const char*)g.A + (size_t)cur.pm * tstep; const char* cB = (const char*)g.Bt + (size_t)cur.pn * tstep;
    S.a_ready(cur);
    if constexpr (SP2) {
        PG8_STAGE(PG8_SB(0, 0), cB, voffB); PG8_STAGE(PG8_SB(0, 1), cB + hstep, voffB); PG8_STAGE(PG8_SA(0, 0), cA, voffA); PG8_STAGE(PG8_SA(0, 1), cA + hstep, voffA);
        if (wr == 1) PG8_BAR;
        PG8_WAIT_V(2); PG8_BAR;
        PG8_STAGE(PG8_SB(1, 0), cB + kstep, voffB); PG8_STAGE(PG8_SA(1, 0), cA + kstep, voffA); PG8_STAGE(PG8_SB(1, 1), cB + hstep + kstep, voffB);
        PG8_WAIT_V(6); PG8_BAR;
    } else {
        PG8_STAGE(PG8_SB(0, 0), cB, voffB); PG8_STAGE(PG8_SA(0, 0), cA, voffA); PG8_STAGE(PG8_SB(0, 1), cB + hstep, voffB); PG8_STAGE(PG8_SA(0, 1), cA + hstep, voffA);
        if (wr == 1) PG8_BAR;
        PG8_WAIT_V(4); PG8_BAR;
        PG8_STAGE(PG8_SB(1, 0), cB + kstep, voffB); PG8_STAGE(PG8_SA(1, 0), cA + kstep, voffA); PG8_STAGE(PG8_SB(1, 1), cB + hstep + kstep, voffB);
        PG8_WAIT_V(6); PG8_BAR;
    }
    for (;;) {
        const bool has_next = S.next(ui + 1, nxt);
        const char* nA = has_next ? (const char*)g.A + (size_t)nxt.pm * tstep : cA; const char* nB = has_next ? (const char*)g.Bt + (size_t)nxt.pn * tstep : cB;
        for (int t = 0; t < nt; t += 2) {
            const bool last = (t == nt - 2);
            const char* a1 = cA + (size_t)(t + 1) * kstep;
            const char* a2 = last ? nA : cA + (size_t)(t + 2) * kstep; const char* b2 = last ? nB : cB + (size_t)(t + 2) * kstep;
            const char* a3 = a2 + kstep; const char* b3 = b2 + kstep;
            if (last && has_next) S.a_ready(nxt);
            if constexpr (SP2) {
            PG8_LDB(B0, 0, 0); PG8_LDB(B1, 0, 1); PG8_SCHED; PG8_LDA(At, 0, 0); PG8_STAGE(PG8_SA(1, 1), a1 + hstep, voffA);
            PG8_WAIT_V(8); PG8_WAIT_L(0); PG8_BAR; PG8_MMA(0, 0, At, B0); PG8_MMA(0, 1, At, B1); PG8_BAR; PG8_SCHED;
            PG8_LDA(At, 0, 1); PG8_STAGE(PG8_SB(0, 0), b2, voffB); PG8_STAGE(PG8_SB(0, 1), b2 + hstep, voffB); PG8_STAGE(PG8_SA(0, 0), a2, voffA);
            PG8_WAIT_V(8); PG8_WAIT_L(0); PG8_BAR; PG8_MMA(1, 0, At, B0); PG8_MMA(1, 1, At, B1); PG8_BAR; PG8_SCHED;
            PG8_LDB(B0, 1, 0); PG8_LDB(B1, 1, 1); PG8_SCHED; PG8_LDA(At, 1, 0); PG8_STAGE(PG8_SA(0, 1), a2 + hstep, voffA);
            PG8_WAIT_V(8); PG8_WAIT_L(0); PG8_BAR; PG8_MMA(0, 0, At, B0); PG8_MMA(0, 1, At, B1); PG8_BAR; PG8_SCHED;
            PG8_LDA(At, 1, 1); PG8_STAGE(PG8_SB(1, 0), b3, voffB); PG8_STAGE(PG8_SB(1, 1), b3 + hstep, voffB); PG8_STAGE(PG8_SA(1, 0), a3, voffA);
            PG8_WAIT_V(8); PG8_WAIT_L(0); PG8_BAR; PG8_MMA(1, 0, At, B0); PG8_MMA(1, 1, At, B1); PG8_BAR; PG8_SCHED;
            } else {
            PG8_LDB(B0, 0, 0); PG8_SCHED; PG8_LDA(At, 0, 0); PG8_STAGE(PG8_SA(1, 1), a1 + hstep, voffA);
            PG8_WAIT_L(8); PG8_BAR; PG8_WAIT_L(0); PG8_MMA(0, 0, At, B0); PG8_BAR; PG8_SCHED;
            PG8_LDB(B1, 0, 1); PG8_STAGE(PG8_SB(0, 0), b2, voffB);
            PG8_BAR; PG8_WAIT_L(0); PG8_MMA(0, 1, At, B1); PG8_BAR;
            PG8_LDA(At, 0, 1); PG8_STAGE(PG8_SA(0, 0), a2, voffA);
            PG8_BAR; PG8_WAIT_L(0); PG8_MMA(1, 0, At, B0); PG8_BAR; PG8_SCHED;
            PG8_STAGE(PG8_SB(0, 1), b2 + hstep, voffB);
            PG8_WAIT_V(6); PG8_BAR; PG8_MMA(1, 1, At, B1); PG8_BAR;
            PG8_LDB(B0, 1, 0); PG8_SCHED; PG8_LDA(At, 1, 0); PG8_STAGE(PG8_SA(0, 1), a2 + hstep, voffA);
            PG8_WAIT_L(8); PG8_BAR; PG8_WAIT_L(0); PG8_MMA(0, 0, At, B0); PG8_BAR; PG8_SCHED;
            PG8_LDB(B1, 1, 1); PG8_STAGE(PG8_SB(1, 0), b3, voffB);
            PG8_BAR; PG8_WAIT_L(0); PG8_MMA(0, 1, At, B1); PG8_BAR;
            PG8_LDA(At, 1, 1); PG8_STAGE(PG8_SA(1, 0), a3, voffA);
            PG8_BAR; PG8_WAIT_L(0); PG8_MMA(1, 0, At, B0); PG8_BAR; PG8_SCHED;
            PG8_STAGE(PG8_SB(1, 1), b3 + hstep, voffB);
            PG8_WAIT_V(6); PG8_BAR; PG8_MMA(1, 1, At, B1); PG8_BAR;
            }
        }
        if constexpr (ALIGN_EPI) { if (wr == 0) PG8_BAR; }
        bool keep_acc = false;
        if constexpr (Epi::CHAIN) { keep_acc = E.chain(acc, cur, wr, wc, fr, fq); S.done(cur); }
        else if constexpr (!Epi::AFTER_DRAIN) { E(acc, cur, wr, wc, fr, fq); S.done(cur); }
        if (!has_next) break;
        if (!keep_acc)
#pragma unroll
        for (int a = 0; a < 2; ++a)
#pragma unroll
            for (int b = 0; b < 2; ++b)
#pragma unroll
                for (int m = 0; m < 4; ++m)
#pragma unroll
                    for (int n = 0; n < 2; ++n) acc[a][b][m][n] = (f32x4){0.f, 0.f, 0.f, 0.f};
        cur = nxt; cA = nA; cB = nB; ++ui;
        if constexpr (ALIGN_EPI) { if (wr == 1) PG8_BAR; }
    }
    PG8_WAIT_V(0);
    if constexpr (!ALIGN_EPI) { if (wr == 0) PG8_BAR; }
    PG8_BAR;
    if constexpr (Epi::AFTER_DRAIN) { E.fused(acc, cur, wr, wc, fr, fq, lds, wid, lane); S.done(cur); }
#undef PG8_SA
#undef PG8_SB
#undef PG8_STAGE
#undef PG8_LDA
#undef PG8_LDB
#undef PG8_MMA
#undef PG8_WAIT_V
#undef PG8_WAIT_L
#undef PG8_BAR
#undef PG8_SCHED
}
}

namespace mk {
using pg8::bf16_t; using pg8::bf16x8; using pg8::f32x4; using pg8::u32x4; using pg8::Unit; using pg8::cvt_pk_bf16; using pg8::f32x2;
typedef unsigned u32x2 __attribute__((ext_vector_type(2)));
#define LAS __attribute__((address_space(3)))
#define LDS_WAIT() asm volatile("s_waitcnt lgkmcnt(0)" ::: "memory")

constexpr int D = 2048, NB = 8, SEQ = 2048, CTXL = 256;
constexpr int MLAT = NB * SEQ, MCTX = NB * CTXL, MTOT = MLAT + MCTX;
constexpr int NCOLS = 13568, SHC = 3328;
constexpr size_t MiB = (size_t)1 << 20;
constexpr size_t WS_MOD = 0, WS_LB = 256 * 1024, WS_W2T = 512 * 1024, WS_RN = 1 * MiB, WS_BONUS = 2 * MiB + 256 * 1024;
constexpr size_t WS_PQ = 4 * MiB, WS_PI = 40 * MiB, WS_PGF = 76 * MiB, WS_PGB = 112 * MiB, WS_PZ = 148 * MiB, WS_PRW = 184 * MiB, WS_PZRW = 301 * MiB;
constexpr size_t WS_E0 = 337 * MiB, WS_E1 = 373 * MiB, WS_A0 = 409 * MiB, WS_A1 = 445 * MiB;
constexpr size_t WS_WTO1 = 481 * MiB, WS_WTO2 = 489 * MiB;
constexpr size_t WS_YHG = 4 * MiB, WS_YRW = 36 * MiB, WS_H2 = 68 * MiB, WS_WTG = 132 * MiB;
constexpr size_t WS_PGATE = 337 * MiB;
constexpr size_t WS_T1 = 184 * MiB, WS_MERGED = 248 * MiB;
constexpr size_t WS_BAR = 500 * MiB;
constexpr size_t WS_END = 501 * MiB;
constexpr int YRW_PM_OFF = 64;
static_assert((WS_YRW - WS_YHG) == (size_t)YRW_PM_OFF * 256 * 1024 * 2, "y_hg / y_rw spacing");
constexpr int NC1 = 9472;
constexpr size_t DO_H = 0, DO_WTIN = 72 * MiB, DO_O = 0, DO_Y = 64 * MiB;
constexpr int LDS_BYTES = 147456, RW_LDS = 49152;

struct Params {
    const float *x, *c, *ctx, *c_ctx, *ada_w, *ada_b, *norm_g, *w_in, *hg_lb, *hg_norm_g, *rw_mu, *rw_w0, *rw_w2, *rw_a0, *rw_a2, *rw_kk, *rw_ka, *rw_rk, *rw_gn_g, *rw_gn_b,
        *w_hg_out, *w_rw_out, *w_out, *final_g;
    float* out; unsigned char* ws;
};

__device__ __forceinline__ float bflo(unsigned u) { return __uint_as_float(u << 16); }
__device__ __forceinline__ float bfhi(unsigned u) { return __uint_as_float(u & 0xffff0000u); }
__device__ __forceinline__ float bf2f(bf16_t u) { return __uint_as_float(((unsigned)u) << 16); }
__device__ __forceinline__ bf16_t f2bf(float f) { return (bf16_t)(cvt_pk_bf16(f, 0.f) & 0xffffu); }
__device__ __forceinline__ float sigm(float x) { return __builtin_amdgcn_rcpf(1.f + __expf(-x)); }
__device__ __forceinline__ float silu(float x) { return x * sigm(x); }
__device__ __forceinline__ float tanh_(float x) { return 1.f - 2.f * __builtin_amdgcn_rcpf(1.f + __expf(2.f * x)); }
__device__ __forceinline__ float wave_sum(float v) {
#pragma unroll
    for (int o = 1; o < 64; o <<= 1) v += __shfl_xor(v, o);
    return v;
}
template <int CTRL> __device__ __forceinline__ float dpp(float x) { return __int_as_float(__builtin_amdgcn_update_dpp(0, __float_as_int(x), CTRL, 0xf, 0xf, true)); }
__device__ __forceinline__ f32x4 mfma16(bf16x8 a, bf16x8 b, f32x4 c) { return __builtin_amdgcn_mfma_f32_16x16x32_bf16(a, b, c, 0, 0, 0); }

template <int W> __device__ __forceinline__ void ldbf(const bf16_t* p, float (&o)[W]) {
    if constexpr (W == 2) { const unsigned u = *(const unsigned*)p; o[0] = bflo(u); o[1] = bfhi(u); }
    else if constexpr (W == 4) { const u32x2 u = *(const u32x2*)p; o[0] = bflo(u.x); o[1] = bfhi(u.x); o[2] = bflo(u.y); o[3] = bfhi(u.y); }
    else {
#pragma unroll
        for (int i = 0; i < W / 8; ++i) { const u32x4 u = *(const u32x4*)(p + 8 * i);
            o[8 * i + 0] = bflo(u.x); o[8 * i + 1] = bfhi(u.x); o[8 * i + 2] = bflo(u.y); o[8 * i + 3] = bfhi(u.y);
            o[8 * i + 4] = bflo(u.z); o[8 * i + 5] = bfhi(u.z); o[8 * i + 6] = bflo(u.w); o[8 * i + 7] = bfhi(u.w); }
    }
}
template <int W> __device__ __forceinline__ void ldf(const float* p, float (&o)[W]) {
    if constexpr (W == 2) { const f32x2 u = *(const f32x2*)p; o[0] = u.x; o[1] = u.y; }
    else {
#pragma unroll
        for (int i = 0; i < W / 4; ++i) { const f32x4 u = *(const f32x4*)(p + 4 * i); o[4 * i] = u.x; o[4 * i + 1] = u.y; o[4 * i + 2] = u.z; o[4 * i + 3] = u.w; }
    }
}
template <int W> __device__ __forceinline__ void stbf(bf16_t* p, const float (&v)[W]) {
    if constexpr (W == 4) { u32x2 u; u.x = cvt_pk_bf16(v[0], v[1]); u.y = cvt_pk_bf16(v[2], v[3]); *(u32x2*)p = u; }
    else {
#pragma unroll
        for (int i = 0; i < W / 8; ++i) { u32x4 u; u.x = cvt_pk_bf16(v[8 * i], v[8 * i + 1]); u.y = cvt_pk_bf16(v[8 * i + 2], v[8 * i + 3]); u.z = cvt_pk_bf16(v[8 * i + 4], v[8 * i + 5]); u.w = cvt_pk_bf16(v[8 * i + 6], v[8 * i + 7]); *(u32x4*)(p + 8 * i) = u; }
    }
}

struct Nbr { int L, R, U, Dn; bool vert; };
__device__ __forceinline__ Nbr nbr_of(int R) {
    Nbr n;
    if (R < MLAT) { const int t = R & (SEQ - 1), col = t & 63; n.L = col > 0 ? R - 1 : -1; n.R = col < 63 ? R + 1 : -1; n.U = t >= 64 ? R - 64 : -1; n.Dn = t < SEQ - 64 ? R + 64 : -1; n.vert = true; }
    else { const int t = (R - MLAT) & (CTXL - 1); n.L = t > 0 ? R - 1 : -1; n.R = t < CTXL - 1 ? R + 1 : -1; n.U = -1; n.Dn = -1; n.vert = false; }
    return n;
}
template <int W> __device__ __forceinline__ void shifted(const bf16_t* Prw, int R, const Nbr& nb, int col, const float* mu, float (&o)[W]) {
    float p[W], t[W], m[W];
    ldbf<W>(Prw + (size_t)R * SHC + col, p);
#pragma unroll
    for (int i = 0; i < W; ++i) o[i] = p[i];
    ldf<W>(mu + col, m);
    if (nb.L >= 0) ldbf<W>(Prw + (size_t)nb.L * SHC + col, t); else {
#pragma unroll
        for (int i = 0; i < W; ++i) t[i] = 0.f; }
#pragma unroll
    for (int i = 0; i < W; ++i) o[i] += m[i] * (t[i] - p[i]);
    ldf<W>(mu + SHC + col, m);
    if (nb.R >= 0) ldbf<W>(Prw + (size_t)nb.R * SHC + col, t); else {
#pragma unroll
        for (int i = 0; i < W; ++i) t[i] = 0.f; }
#pragma unroll
    for (int i = 0; i < W; ++i) o[i] += m[i] * (t[i] - p[i]);
    if (nb.vert) {
        ldf<W>(mu + 2 * SHC + col, m);
        if (nb.U >= 0) ldbf<W>(Prw + (size_t)nb.U * SHC + col, t); else {
#pragma unroll
            for (int i = 0; i < W; ++i) t[i] = 0.f; }
#pragma unroll
        for (int i = 0; i < W; ++i) o[i] += m[i] * (t[i] - p[i]);
        ldf<W>(mu + 3 * SHC + col, m);
        if (nb.Dn >= 0) ldbf<W>(Prw + (size_t)nb.Dn * SHC + col, t); else {
#pragma unroll
            for (int i = 0; i < W; ++i) t[i] = 0.f; }
#pragma unroll
        for (int i = 0; i < W; ++i) o[i] += m[i] * (t[i] - p[i]);
    }
}

__device__ __forceinline__ void shifted4m(const bf16_t* Prw, int R, const Nbr& nb, int col, const f32x4 (&mu4)[4], float (&o)[4]) {
    float p[4], t[4];
    ldbf<4>(Prw + (size_t)R * SHC + col, p);
#pragma unroll
    for (int i = 0; i < 4; ++i) o[i] = p[i];
#pragma unroll
    for (int d = 0; d < 4; ++d) {
        if (d >= 2 && !nb.vert) break;
        const int nr = d == 0 ? nb.L : (d == 1 ? nb.R : (d == 2 ? nb.U : nb.Dn));
        if (nr >= 0) ldbf<4>(Prw + (size_t)nr * SHC + col, t); else {
#pragma unroll
            for (int i = 0; i < 4; ++i) t[i] = 0.f; }
#pragma unroll
        for (int i = 0; i < 4; ++i) o[i] += mu4[d][i] * (t[i] - p[i]);
    }
}

__device__ __forceinline__ void transpose_item(const float* W, int K, int ldw, int N, bf16_t* WT, LAS float* scr, int item, int lane) {
    const int nblk = N / 32, kb = item / nblk, nb = item % nblk, k0 = 64 * kb, n0 = 32 * nb;
#pragma unroll 8
    for (int i = 0; i < 32; ++i) { const int kk = 2 * i + (lane >> 5); scr[kk * 33 + (lane & 31)] = W[(size_t)(k0 + kk) * ldw + n0 + (lane & 31)]; }
    LDS_WAIT();
    const int c = lane & 7;
#pragma unroll
    for (int j = 0; j < 4; ++j) { const int n = (lane >> 3) + 8 * j; const LAS float* s = scr + (8 * c) * 33 + n;
        u32x4 o; o.x = cvt_pk_bf16(s[0 * 33], s[1 * 33]); o.y = cvt_pk_bf16(s[2 * 33], s[3 * 33]); o.z = cvt_pk_bf16(s[4 * 33], s[5 * 33]); o.w = cvt_pk_bf16(s[6 * 33], s[7 * 33]);
        *(u32x4*)(WT + (size_t)(n0 + n) * K + k0 + 8 * c) = o; }
    LDS_WAIT();
}

__device__ __forceinline__ void phase0(const Params& p, LAS unsigned char* lds, int tid, int wave, int lane) {
    float* mod = (float*)(p.ws + WS_MOD);
    LAS float* sc = (LAS float*)lds;
    for (int i = tid; i < 9 * D; i += 512) { const int r = i >> 11, k = i & (D - 1); const float v = r < 8 ? p.c[r * D + k] : p.c_ctx[k]; sc[i] = silu(v); }
    __syncthreads();
    for (int cb = blockIdx.x; cb < 256; cb += gridDim.x) {
        if (wave < 6) {
            const int n0 = cb * 24 + wave * 4;
            float acc[9][4];
#pragma unroll
            for (int r = 0; r < 9; ++r)
#pragma unroll
                for (int j = 0; j < 4; ++j) acc[r][j] = 0.f;
            for (int i = 0; i < 32; ++i) { const int k = lane + 64 * i; const f32x4 w = *(const f32x4*)(p.ada_w + (size_t)k * (3 * D) + n0);
#pragma unroll
                for (int r = 0; r < 9; ++r) { const float s = sc[r * D + k]; acc[r][0] += s * w.x; acc[r][1] += s * w.y; acc[r][2] += s * w.z; acc[r][3] += s * w.w; } }
#pragma unroll
            for (int r = 0; r < 9; ++r)
#pragma unroll
                for (int j = 0; j < 4; ++j) { const float v = wave_sum(acc[r][j]); if (lane == 0) mod[r * (3 * D) + n0 + j] = v + p.ada_b[n0 + j]; }
        }
    }
    __syncthreads();
    LAS float* scr = (LAS float*)(lds + wave * 8448);
    const int gw = blockIdx.x * 8 + wave, NGW = gridDim.x * 8;
    bf16_t* wt_in = (bf16_t*)((unsigned char*)p.out + DO_WTIN);
    constexpr int I_IN = (D / 64) * (NC1 / 32);
    for (int it = gw; it < I_IN; it += NGW) transpose_item(p.w_in, D, NCOLS, NC1, wt_in, scr, it, lane);
    bf16_t* w2t = (bf16_t*)(p.ws + WS_W2T);
    const int gt = blockIdx.x * 512 + tid, NGT = gridDim.x * 512;
    for (int i = gt; i < 4 * 1024 * 8; i += NGT) { const int mat = i >> 13, n = (i >> 3) & 1023, k8 = i & 7;
        const float* src = (mat < 2 ? p.rw_w2 + (size_t)mat * 64 * 1024 : p.rw_a2 + (size_t)(mat - 2) * 64 * 1024) + n;
        float v[8];
#pragma unroll
        for (int j = 0; j < 8; ++j) v[j] = src[(size_t)(k8 * 8 + j) * 1024];
        stbf<8>(w2t + ((size_t)mat * 1024 + n) * 64 + k8 * 8, v); }
    float* lb = (float*)(p.ws + WS_LB);
    for (int i = gt; i < 2048; i += NGT) { const int d = i >> 10, j = i & 1023; const float a = p.hg_lb[(d * 2 + 0) * 1024 + j], b = p.hg_lb[(d * 2 + 1) * 1024 + j]; lb[i] = 1.f / (1.f + __expf(b - a)); }
}

__device__ __forceinline__ void phase1(const Params& p, bf16_t* H, int nrows, int wave, int lane) {
    const float* mod = (const float*)(p.ws + WS_MOD);
    const int gw = blockIdx.x * 8 + wave, NGW = gridDim.x * 8;
    for (int row = gw; row < nrows; row += NGW) {
        const float* xr = row < MLAT ? p.x + (size_t)row * D : p.ctx + (size_t)(row - MLAT) * D;
        const int mr = row < MLAT ? (row >> 11) : 8;
        const float* shift = mod + mr * (3 * D); const float* scale = shift + D;
        f32x4 v[8]; float ss = 0.f;
#pragma unroll
        for (int j = 0; j < 8; ++j) { v[j] = ((const f32x4*)xr)[lane + 64 * j]; ss += (v[j].x * v[j].x + v[j].y * v[j].y) + (v[j].z * v[j].z + v[j].w * v[j].w); }
        ss = wave_sum(ss);
        const float rstd = rsqrtf(ss * (1.f / D) + 1e-6f);
#pragma unroll
        for (int j = 0; j < 8; ++j) { const int c = 4 * (lane + 64 * j);
            const f32x4 g = *(const f32x4*)(p.norm_g + c), s1 = *(const f32x4*)(scale + c), s0 = *(const f32x4*)(shift + c);
            float o[4]; o[0] = v[j].x * rstd * g.x * (1.f + s1.x) + s0.x; o[1] = v[j].y * rstd * g.y * (1.f + s1.y) + s0.y; o[2] = v[j].z * rstd * g.z * (1.f + s1.z) + s0.z; o[3] = v[j].w * rstd * g.w * (1.f + s1.w) + s0.w;
            stbf<4>(H + (size_t)row * D + c, o); }
    }
}

struct EpiProj {
    static constexpr bool PERM = true, AFTER_DRAIN = false, CHAIN = false;
    unsigned char* ws;
    template <int ACT> __device__ __forceinline__ void run(const f32x4 (&acc)[2][2][4][2], bf16_t* base, int ld, int row0, int col0, const float* lb) const {
        float lbv[2][8];
        if constexpr (ACT == 3) {
#pragma unroll
            for (int bj = 0; bj < 2; ++bj) ldf<8>(lb + col0 + bj * 128, lbv[bj]); }
#pragma unroll
        for (int ai = 0; ai < 2; ++ai)
#pragma unroll
            for (int m = 0; m < 4; ++m) { bf16_t* rowp = base + (size_t)(row0 + ai * 128 + m * 16) * ld + col0;
#pragma unroll
                for (int bj = 0; bj < 2; ++bj) { float v[8];
#pragma unroll
                    for (int i = 0; i < 4; ++i) { v[i] = acc[ai][bj][m][0][i]; v[4 + i] = acc[ai][bj][m][1][i]; }
#pragma unroll
                    for (int i = 0; i < 8; ++i) {
                        if constexpr (ACT == 1) v[i] = silu(v[i]);
                        if constexpr (ACT == 2) v[i] = sigm(v[i]);
                        if constexpr (ACT == 3) v[i] = __logf(lbv[bj][i] + (1.f - lbv[bj][i]) * sigm(v[i])); }
                    stbf<8>(rowp + bj * 128, v); } }
    }
    __device__ __forceinline__ void operator()(const f32x4 (&acc)[2][2][4][2], const Unit& u, int wr, int wc, int fr, int fq) const {
        const int pn = u.pn; const int row0 = u.pm * 256 + wr * 64 + fr, cw = wc * 32 + 8 * fq;
        const float* lb = (const float*)(ws + WS_LB);
        if (pn < 4) run<1>(acc, (bf16_t*)(ws + WS_PQ), 1024, row0, pn * 256 + cw, lb);
        else if (pn < 8) run<0>(acc, (bf16_t*)(ws + WS_PI), 1024, row0, (pn - 4) * 256 + cw, lb);
        else if (pn < 12) run<3>(acc, (bf16_t*)(ws + WS_PGF), 1024, row0, (pn - 8) * 256 + cw, lb);
        else if (pn < 16) run<3>(acc, (bf16_t*)(ws + WS_PGB), 1024, row0, (pn - 12) * 256 + cw, lb + 1024);
        else if (pn < 20) run<1>(acc, (bf16_t*)(ws + WS_PZ), 1024, row0, (pn - 16) * 256 + cw, lb);
        else if (pn < 33) run<0>(acc, (bf16_t*)(ws + WS_PRW), SHC, row0, (pn - 20) * 256 + cw, lb);
        else run<1>(acc, (bf16_t*)(ws + WS_PZRW), 1024, row0, (pn - 33) * 256 + cw, lb);
    }
};

struct InOrder {
    int G, c;
    __device__ bool next(int i, Unit& u) const {
        const int L = i * G + c;
        if (L < 2368) { pg8::StaticOrder so; so.init(MLAT, NC1, G, c); return so.next(i, u); }
        if (L >= 2368 + 168) return false;
        const int idx = L - 2368, j = idx % 21; u.pm = 64 + idx / 21; u.pn = j < 12 ? 4 + j : 12 + j; return true;
    }
    __device__ __forceinline__ void a_ready(const Unit&) const {}
    __device__ __forceinline__ void done(const Unit&) const {}
};
struct OrderPN {
    int G, c, nN, ntiles;
    __device__ bool next(int i, Unit& u) const { const int tile = i * G + c; if (tile >= ntiles) return false; u.pm = tile / nN; u.pn = tile % nN; return true; }
    __device__ __forceinline__ void a_ready(const Unit&) const {}
    __device__ __forceinline__ void done(const Unit&) const {}
};
struct EpiGate {
    static constexpr bool PERM = true, AFTER_DRAIN = false, CHAIN = false;
    unsigned char* ws;
    __device__ __forceinline__ void operator()(const f32x4 (&acc)[2][2][4][2], const Unit& u, int wr, int wc, int fr, int fq) const {
        EpiProj e{ws};
        e.run<2>(acc, (bf16_t*)(ws + WS_PGATE), 4096, u.pm * 256 + wr * 64 + fr, u.pn * 256 + wc * 32 + 8 * fq, nullptr);
    }
};

__device__ __forceinline__ void hg_scan(const Params& p, LAS unsigned char* lds, int tid, int wave, int lane) {
    LAS bf16_t* qd = (LAS bf16_t*)(lds);
    LAS bf16_t* kd = (LAS bf16_t*)(lds + 17408);
    LAS bf16_t* kdT = (LAS bf16_t*)(lds + 34816);
    LAS bf16_t* vT = (LAS bf16_t*)(lds + 53248);
    LAS bf16_t* ST = (LAS bf16_t*)(lds + 62464);
    LAS bf16_t* at = (LAS bf16_t*)(lds + 79872);
    LAS float* tot = (LAS float*)(lds + 89088);
    const bf16_t* Pq = (const bf16_t*)(p.ws + WS_PQ); const bf16_t* Pi = (const bf16_t*)(p.ws + WS_PI);
    bf16_t* Obase = (bf16_t*)((unsigned char*)p.out + DO_O);
    const int l15 = lane & 15, fq = lane >> 4;
    for (int u = blockIdx.x; u < 256; u += gridDim.x) {
        const int b = u >> 5, h = (u >> 2) & 7, dir = (u >> 1) & 1, vh = u & 1;
        const bf16_t* Pg = (const bf16_t*)(p.ws + (dir ? WS_PGB : WS_PGF));
        bf16_t* O = Obase + (size_t)dir * MLAT * 1024;
        const int k0 = 2 * lane, e8 = wave, vs = tid >> 3, vn8 = tid & 7;
        const int sgn = dir ? -1 : 1;
        auto rbase = [&](int c) -> long { if (c < 4) return MLAT + b * CTXL + (dir ? (CTXL - 1 - c * 64) : c * 64); const int t0 = (c - 4) * 64; return b * SEQ + (dir ? (SEQ - 1 - t0) : t0); };
        const long rstep = (long)sgn * 1024;
        f32x4 S[4];
#pragma unroll
        for (int i = 0; i < 4; ++i) S[i] = (f32x4){0.f, 0.f, 0.f, 0.f};
        unsigned gN[8], qN[8]; u32x4 vN;
        { const long rb = rbase(0); const bf16_t* gp = Pg + (rb + sgn * (e8 * 8)) * 1024 + h * 128 + k0; const bf16_t* qp_ = Pq + (rb + sgn * (e8 * 8)) * 1024 + h * 128 + k0;
#pragma unroll
          for (int j = 0; j < 8; ++j) { gN[j] = *(const unsigned*)(gp + j * rstep); qN[j] = *(const unsigned*)(qp_ + j * rstep); }
          vN = *(const u32x4*)(Pi + (rb + sgn * vs) * 1024 + h * 128 + vh * 64 + vn8 * 8); }
        for (int c = 0; c < 36; ++c) {
            unsigned g[8], q[8]; const u32x4 vC = vN;
#pragma unroll
            for (int j = 0; j < 8; ++j) { g[j] = gN[j]; q[j] = qN[j]; }
            if (c + 1 < 36) {
                const long rb1 = rbase(c + 1); const bf16_t* gp = Pg + (rb1 + sgn * (e8 * 8)) * 1024 + h * 128 + k0; const bf16_t* qp_ = Pq + (rb1 + sgn * (e8 * 8)) * 1024 + h * 128 + k0;
#pragma unroll
                for (int j = 0; j < 8; ++j) { gN[j] = *(const unsigned*)(gp + j * rstep); qN[j] = *(const unsigned*)(qp_ + j * rstep); }
                vN = *(const u32x4*)(Pi + (rb1 + sgn * vs) * 1024 + h * 128 + vh * 64 + vn8 * 8);
            }
            float run0 = 0.f, run1 = 0.f;
#pragma unroll
            for (int j = 0; j < 8; ++j) { run0 += bflo(g[j]); run1 += bfhi(g[j]); }
            *(LAS f32x2*)(tot + e8 * 128 + k0) = (f32x2){run0, run1};
            __syncthreads();
            {
                float off0 = 0.f, off1 = 0.f, mid0 = 0.f, mid1 = 0.f;
#pragma unroll
                for (int i = 0; i < 8; ++i) { const f32x2 t = *(const LAS f32x2*)(tot + i * 128 + k0); if (i < e8) { off0 += t.x; off1 += t.y; } if (i < 4) { mid0 += t.x; mid1 += t.y; } }
                unsigned kp0[4], kp1[4]; float bc0 = off0, bc1 = off1;
#pragma unroll
                for (int j = 0; j < 8; j += 2) {
                    float kv0[2], kv1[2];
#pragma unroll
                    for (int e = 0; e < 2; ++e) { const int jj = j + e;
                        bc0 += bflo(g[jj]); bc1 += bfhi(g[jj]);
                        const float E0 = __expf(__builtin_amdgcn_fmed3f(bc0 - mid0, -80.f, 80.f)), E1 = __expf(__builtin_amdgcn_fmed3f(bc1 - mid1, -80.f, 80.f));
                        const float qv0 = bflo(q[jj]) * E0, qv1 = bfhi(q[jj]) * E1;
                        kv0[e] = (1.f - __expf(bflo(g[jj]))) * __builtin_amdgcn_rcpf(E0); kv1[e] = (1.f - __expf(bfhi(g[jj]))) * __builtin_amdgcn_rcpf(E1);
                        const int t = e8 * 8 + jj;
                        *(LAS unsigned*)(qd + t * 136 + k0) = cvt_pk_bf16(qv0, qv1); *(LAS unsigned*)(kd + t * 136 + k0) = cvt_pk_bf16(kv0[e], kv1[e]); }
                    kp0[j >> 1] = cvt_pk_bf16(kv0[0], kv0[1]); kp1[j >> 1] = cvt_pk_bf16(kv1[0], kv1[1]);
                }
                *(LAS u32x4*)(kdT + k0 * 72 + e8 * 8) = (u32x4){kp0[0], kp0[1], kp0[2], kp0[3]};
                *(LAS u32x4*)(kdT + (k0 + 1) * 72 + e8 * 8) = (u32x4){kp1[0], kp1[1], kp1[2], kp1[3]};
                float em[4];
#pragma unroll
                for (int j = 0; j < 4; ++j) { const int kj = 16 * wave + fq * 4 + j; em[j] = __expf((tot[kj] + tot[128 + kj]) + (tot[256 + kj] + tot[384 + kj])); }
#pragma unroll
                for (int nt = 0; nt < 4; ++nt) { u32x2 w; w.x = cvt_pk_bf16(S[nt][0] * em[0], S[nt][1] * em[1]); w.y = cvt_pk_bf16(S[nt][2] * em[2], S[nt][3] * em[3]);
                    *(LAS u32x2*)(ST + (nt * 16 + l15) * 136 + 16 * wave + fq * 4) = w; }
                const unsigned vw[4] = {vC.x, vC.y, vC.z, vC.w};
#pragma unroll
                for (int i = 0; i < 4; ++i) { vT[(vn8 * 8 + 2 * i) * 72 + vs] = (bf16_t)(vw[i] & 0xffffu); vT[(vn8 * 8 + 2 * i + 1) * 72 + vs] = (bf16_t)(vw[i] >> 16); }
            }
            __syncthreads();
            const bool lat = c >= 4;
            if (lat) {
#pragma unroll
                for (int q2 = 0; q2 < 2; ++q2) { const int id = 2 * wave + q2, tt = id >> 2, st = id & 3;
                    f32x4 a = (f32x4){0.f, 0.f, 0.f, 0.f};
                    if (st <= tt) {
#pragma unroll
                        for (int ks = 0; ks < 4; ++ks) { const bf16x8 A = *(const LAS bf16x8*)(kd + (st * 16 + l15) * 136 + ks * 32 + fq * 8); const bf16x8 B = *(const LAS bf16x8*)(qd + (tt * 16 + l15) * 136 + ks * 32 + fq * 8); a = mfma16(A, B, a); } }
                    { const int t = tt * 16 + l15, s0 = st * 16 + fq * 4; u32x2 w; w.x = cvt_pk_bf16(s0 <= t ? a[0] : 0.f, s0 + 1 <= t ? a[1] : 0.f); w.y = cvt_pk_bf16(s0 + 2 <= t ? a[2] : 0.f, s0 + 3 <= t ? a[3] : 0.f);
                      *(LAS u32x2*)(at + t * 72 + s0) = w; } }
            }
            __syncthreads();
            if (lat) {
                const long rb = rbase(c);
#pragma unroll
                for (int q2 = 0; q2 < 2; ++q2) { const int id = 2 * wave + q2, tt = id >> 2, nt = id & 3;
                    f32x4 o = (f32x4){0.f, 0.f, 0.f, 0.f};
#pragma unroll
                    for (int ks = 0; ks < 2; ++ks) { const bf16x8 A = *(const LAS bf16x8*)(vT + (nt * 16 + l15) * 72 + ks * 32 + fq * 8); const bf16x8 B = *(const LAS bf16x8*)(at + (tt * 16 + l15) * 72 + ks * 32 + fq * 8); o = mfma16(A, B, o); }
#pragma unroll
                    for (int ks = 0; ks < 4; ++ks) { const bf16x8 A = *(const LAS bf16x8*)(ST + (nt * 16 + l15) * 136 + ks * 32 + fq * 8); const bf16x8 B = *(const LAS bf16x8*)(qd + (tt * 16 + l15) * 136 + ks * 32 + fq * 8); o = mfma16(A, B, o); }
                    { const long row = rb + sgn * (tt * 16 + l15); u32x2 w; w.x = cvt_pk_bf16(o[0], o[1]); w.y = cvt_pk_bf16(o[2], o[3]);
                      *(u32x2*)(O + row * 1024 + h * 128 + vh * 64 + nt * 16 + fq * 4) = w; } }
            }
            {
                float eb[4], e2[4];
#pragma unroll
                for (int j = 0; j < 4; ++j) { const int kj = 16 * wave + fq * 4 + j; const float m = (tot[kj] + tot[128 + kj]) + (tot[256 + kj] + tot[384 + kj]), bl = m + ((tot[512 + kj] + tot[640 + kj]) + (tot[768 + kj] + tot[896 + kj])); eb[j] = __expf(bl); e2[j] = __expf(bl - m); }
#pragma unroll
                for (int nt = 0; nt < 4; ++nt) { f32x4 tmp = (f32x4){0.f, 0.f, 0.f, 0.f};
#pragma unroll
                    for (int ks = 0; ks < 2; ++ks) { const bf16x8 A = *(const LAS bf16x8*)(kdT + (16 * wave + l15) * 72 + ks * 32 + fq * 8); const bf16x8 B = *(const LAS bf16x8*)(vT + (nt * 16 + l15) * 72 + ks * 32 + fq * 8); tmp = mfma16(A, B, tmp); }
#pragma unroll
                    for (int j = 0; j < 4; ++j) S[nt][j] = eb[j] * S[nt][j] + e2[j] * tmp[j]; }
            }
            __syncthreads();
        }
    }
}

__device__ __forceinline__ void post_hg(const Params& p, int wave, int lane) {
    const bf16_t* O0 = (const bf16_t*)((unsigned char*)p.out + DO_O); const bf16_t* O1 = O0 + (size_t)MLAT * 1024;
    const bf16_t* Pz = (const bf16_t*)(p.ws + WS_PZ); bf16_t* Y = (bf16_t*)(p.ws + WS_YHG);
    const int gw = blockIdx.x * 8 + wave, NGW = gridDim.x * 8, c0 = lane * 16;
    float g[16]; ldf<16>(p.hg_norm_g + c0, g);
    for (int tok = gw; tok < MLAT; tok += NGW) {
        float a[16], bq[16], z[16];
        ldbf<16>(O0 + (size_t)tok * 1024 + c0, a); ldbf<16>(O1 + (size_t)tok * 1024 + c0, bq); ldbf<16>(Pz + (size_t)tok * 1024 + c0, z);
        float ss = 0.f;
#pragma unroll
        for (int i = 0; i < 16; ++i) { a[i] += bq[i]; ss += a[i] * a[i]; }
        ss += __shfl_xor(ss, 1); ss += __shfl_xor(ss, 2); ss += __shfl_xor(ss, 4);
        const float rstd = rsqrtf(ss * (1.f / 128.f) + 1e-6f);
#pragma unroll
        for (int i = 0; i < 16; ++i) a[i] = a[i] * rstd * g[i] * z[i];
        stbf<16>(Y + (size_t)tok * 1024 + c0, a);
    }
}

__device__ __forceinline__ void rw_prep(const Params& p, LAS unsigned char* lds, int wave, int lane) {
    const bf16_t* Prw = (const bf16_t*)(p.ws + WS_PRW); const bf16_t* w2t = (const bf16_t*)(p.ws + WS_W2T);
    bf16_t* E0 = (bf16_t*)(p.ws + WS_E0); bf16_t* E1 = (bf16_t*)(p.ws + WS_E1); bf16_t* A0 = (bf16_t*)(p.ws + WS_A0); bf16_t* A1 = (bf16_t*)(p.ws + WS_A1);
    float* rn = (float*)(p.ws + WS_RN); float* bonus = (float*)(p.ws + WS_BONUS);
    const int l15 = lane & 15, fq = lane >> 4;
    LAS f32x4* cst = (LAS f32x4*)(lds + 8192) + wave * 480;
    for (int idx = lane; idx < 480; idx += 64) { const int nt8 = idx / 60, rem = idx % 60, arr = rem >> 2, fqi = rem & 3, chc = (wave * 2 + (nt8 >> 2)) * 64 + (nt8 & 3) * 16 + fqi * 4;
        const float* sp = arr < 4 ? p.rw_mu + arr * SHC + chc : arr < 8 ? p.rw_mu + (arr - 4) * SHC + 1024 + chc : arr == 8 ? p.rw_w0 + chc : arr == 9 ? p.rw_w0 + 1024 + chc : arr == 10 ? p.rw_a0 + chc : arr == 11 ? p.rw_a0 + 1024 + chc
                        : arr == 12 ? p.rw_kk + chc : arr == 13 ? p.rw_ka + chc : p.rw_rk + chc;
        cst[idx] = *(const f32x4*)sp; }
    const bool xmap = gridDim.x == 256; const int nmine = xmap ? (blockIdx.x < 128 ? 5 : 4) : ((MTOT / 16 - 1 - (int)blockIdx.x) / (int)gridDim.x + 1);
    const int rgrow = ((int)(blockIdx.x & 7) * 32 + (int)(blockIdx.x >> 3)) * 4;
    for (int it = 0; it < nmine; ++it) {
        const int tile = xmap ? (it < 4 ? rgrow + it : 1024 + (int)blockIdx.x) : ((int)blockIdx.x + it * (int)gridDim.x);
        const int hp = wave, R = tile * 16 + l15;
        const Nbr nb = nbr_of(R);
        { const int mat = wave >> 1, ks = wave & 1; float v[8]; shifted<8>(Prw, R, nb, 3072 + mat * 64 + ks * 32 + fq * 8, p.rw_mu, v);
          if (mat < 2) {
#pragma unroll
              for (int i = 0; i < 8; ++i) v[i] = tanh_(v[i]); }
          u32x4 w; w.x = cvt_pk_bf16(v[0], v[1]); w.y = cvt_pk_bf16(v[2], v[3]); w.z = cvt_pk_bf16(v[4], v[5]); w.w = cvt_pk_bf16(v[6], v[7]);
          *(LAS u32x4*)(lds + (wave * 64 + lane) * 16) = w; }
        __syncthreads();
        bf16x8 Bf[4][2];
#pragma unroll
        for (int mat = 0; mat < 4; ++mat)
#pragma unroll
            for (int ks = 0; ks < 2; ++ks) Bf[mat][ks] = *(const LAS bf16x8*)(lds + ((mat * 2 + ks) * 64 + lane) * 16);
#pragma unroll 1
        for (int hh = 0; hh < 2; ++hh) { const int head = hp * 2 + hh; float skk = 0.f, sb = 0.f;
#pragma unroll 1
            for (int nt = 0; nt < 4; ++nt) { const int n0 = head * 64 + nt * 16, ch = n0 + fq * 4;
                f32x4 acc[4];
#pragma unroll
                for (int mat = 0; mat < 4; ++mat) { acc[mat] = (f32x4){0.f, 0.f, 0.f, 0.f};
#pragma unroll
                    for (int ks = 0; ks < 2; ++ks) { const bf16x8 A = *(const bf16x8*)(w2t + ((size_t)mat * 1024 + n0 + l15) * 64 + ks * 32 + fq * 8); acc[mat] = mfma16(A, Bf[mat][ks], acc[mat]); } }
                const LAS f32x4* cs = cst + (hh * 4 + nt) * 60 + fq;
                const f32x4 mur[4] = {cs[0], cs[4], cs[8], cs[12]}, muk[4] = {cs[16], cs[20], cs[24], cs[28]};
                float rs[4], ks_[4]; shifted4m(Prw, R, nb, ch, mur, rs); shifted4m(Prw, R, nb, 1024 + ch, muk, ks_);
                const f32x4 w00 = cs[32], w01 = cs[36], a00 = cs[40], a01 = cs[44], kkc = cs[48], kac = cs[52], rkc = cs[56];
                float e0[4], e1[4], a0[4], a1[4];
#pragma unroll
                for (int j = 0; j < 4; ++j) { e0[j] = 0.60653066f * sigm(w00[j] + acc[0][j]); e1[j] = 0.60653066f * sigm(w01[j] + acc[1][j]); a0[j] = sigm(a00[j] + acc[2][j]); a1[j] = sigm(a01[j] + acc[3][j]);
                    const float kr = ks_[j] * kkc[j]; skk += kr * kr; sb += rs[j] * ks_[j] * (2.f + (a0[j] + a1[j] - 2.f) * kac[j]) * rkc[j]; }
                stbf<4>(E0 + (size_t)R * 1024 + ch, e0); stbf<4>(E1 + (size_t)R * 1024 + ch, e1); stbf<4>(A0 + (size_t)R * 1024 + ch, a0); stbf<4>(A1 + (size_t)R * 1024 + ch, a1);
            }
            skk += __shfl_xor(skk, 16); skk += __shfl_xor(skk, 32); sb += __shfl_xor(sb, 16); sb += __shfl_xor(sb, 32);
            if (fq == 0) { rn[(size_t)R * 16 + head] = rsqrtf(skk + 1e-12f); if (R < MLAT) bonus[(size_t)R * 16 + head] = sb; }
        }
        __syncthreads();
    }
}

struct RwVec { f32x4 wA, wB, kA, kB, bA, bB, dA, dB, rA, rB; float v; };
template <bool LAT> __device__ __forceinline__ void rw_ldv(const LAS float* bs, int voff, RwVec& V) {
    V.wA = *(const LAS f32x4*)(bs); V.wB = *(const LAS f32x4*)(bs + 4); V.kA = *(const LAS f32x4*)(bs + 64); V.kB = *(const LAS f32x4*)(bs + 68);
    V.bA = *(const LAS f32x4*)(bs + 128); V.bB = *(const LAS f32x4*)(bs + 132); V.dA = *(const LAS f32x4*)(bs + 192); V.dB = *(const LAS f32x4*)(bs + 196);
    if (LAT) { V.rA = *(const LAS f32x4*)(bs + 256); V.rB = *(const LAS f32x4*)(bs + 260); }
    V.v = bs[voff];
}
template <bool LAT> __device__ __forceinline__ void rw_chunk(const LAS float* cb, int voff, int q, f32x2 (&S)[4], float& ylo, float& yhi) {
    RwVec cur, nxt; rw_ldv<LAT>(cb, voff, cur);
#pragma unroll 2
    for (int s = 0; s < 16; ++s) {
        rw_ldv<LAT>(cb + (s < 15 ? s + 1 : 15) * 384, voff, nxt);
        f32x2 d = S[0] * cur.kA.lo; d = S[1] * cur.kA.hi + d; d = S[2] * cur.kB.lo + d; d = S[3] * cur.kB.hi + d;
        float t = d.x + d.y;
        t += dpp<0xB1>(t); t += dpp<0x4E>(t); t += dpp<0x141>(t);
        const f32x2 vv = {cur.v, cur.v}, ns = {-t, -t};
        S[0] = S[0] * cur.wA.lo + (cur.dA.lo * vv + cur.bA.lo * ns); S[1] = S[1] * cur.wA.hi + (cur.dA.hi * vv + cur.bA.hi * ns);
        S[2] = S[2] * cur.wB.lo + (cur.dB.lo * vv + cur.bB.lo * ns); S[3] = S[3] * cur.wB.hi + (cur.dB.hi * vv + cur.bB.hi * ns);
        if (LAT) {
            d = S[0] * cur.rA.lo; d = S[1] * cur.rA.hi + d; d = S[2] * cur.rB.lo + d; d = S[3] * cur.rB.hi + d;
            float y = d.x + d.y;
            y += dpp<0xB1>(y); y += dpp<0x4E>(y); y += dpp<0x141>(y);
            if (s < 8) ylo = (q == (s & 7)) ? y : ylo; else yhi = (q == (s & 7)) ? y : yhi;
        }
        cur = nxt;
    }
}
struct RwRegs { unsigned raw[3][5]; unsigned e, a; float rn; unsigned vmask; };
__device__ __forceinline__ void rw_scan(const Params& p, LAS unsigned char* lds, int tid, int wave, int lane) {
    LAS float* buf = (LAS float*)lds;
    const bf16_t* Prw = (const bf16_t*)(p.ws + WS_PRW); const float* rnp = (const float*)(p.ws + WS_RN);
    bf16_t* Ybase = (bf16_t*)((unsigned char*)p.out + DO_Y);
    for (int u = blockIdx.x; u < 256; u += gridDim.x) {
        const int b = u >> 5, h = (u >> 1) & 15, dir = u & 1;
        const bf16_t* Ed = (const bf16_t*)(p.ws + (dir ? WS_E1 : WS_E0)); const bf16_t* Ad = (const bf16_t*)(p.ws + (dir ? WS_A1 : WS_A0));
        bf16_t* Y = Ybase + (size_t)dir * MLAT * 1024;
        const int ls = tid >> 5, cp = tid & 31, ch = h * 64 + 2 * cp;
        float mu_[3][4][2];
#pragma unroll
        for (int a = 0; a < 3; ++a)
#pragma unroll
            for (int m = 0; m < 4; ++m) { const f32x2 t = *(const f32x2*)(p.rw_mu + m * SHC + a * 1024 + ch); mu_[a][m][0] = t.x; mu_[a][m][1] = t.y; }
        float c0v[3][2], c0h[3][2];
#pragma unroll
        for (int a = 0; a < 3; ++a)
#pragma unroll
            for (int e = 0; e < 2; ++e) { c0h[a][e] = 1.f - (mu_[a][0][e] + mu_[a][1][e]); c0v[a][e] = c0h[a][e] - (mu_[a][2][e] + mu_[a][3][e]); }
        const f32x2 kkc = *(const f32x2*)(p.rw_kk + ch), kac = *(const f32x2*)(p.rw_ka + ch);
        auto rowof = [&](int tau) -> int { if (tau < CTXL) { const int t = dir ? (CTXL - 1 - tau) : tau; return MLAT + b * CTXL + t; } const int t0 = tau - CTXL; const int t = dir ? (SEQ - 1 - t0) : t0; return b * SEQ + t; };
        const char* PrwA[3] = {(const char*)Prw, (const char*)Prw + 2048, (const char*)Prw + 4096};
        const int lsgn = dir ? -ls : ls;
        auto issue = [&](int c, RwRegs& r) { const int R = rowof(c * 16) + lsgn; const bool lat = c >= 16;
            const int t = lat ? (R & (SEQ - 1)) : ((R - MLAT) & (CTXL - 1));
            const bool vL = lat ? (t & 63) > 0 : t > 0, vR = lat ? (t & 63) < 63 : t < CTXL - 1, vU = lat && t >= 64, vD = lat && t < SEQ - 64;
            const unsigned oS = (unsigned)R * (unsigned)(SHC * 2) + (unsigned)(ch * 2);
            const unsigned oL = vL ? oS - SHC * 2 : oS, oR = vR ? oS + SHC * 2 : oS, oU = vU ? oS - 64 * SHC * 2 : oS, oD = vD ? oS + 64 * SHC * 2 : oS;
#pragma unroll
            for (int a = 0; a < 3; ++a) { r.raw[a][0] = *(const unsigned*)(PrwA[a] + oS); r.raw[a][1] = *(const unsigned*)(PrwA[a] + oL); r.raw[a][2] = *(const unsigned*)(PrwA[a] + oR);
                r.raw[a][3] = *(const unsigned*)(PrwA[a] + oU); r.raw[a][4] = *(const unsigned*)(PrwA[a] + oD); }
            r.e = *(const unsigned*)((const char*)Ed + (unsigned)R * 2048u + (unsigned)(ch * 2)); r.a = *(const unsigned*)((const char*)Ad + (unsigned)R * 2048u + (unsigned)(ch * 2)); r.rn = rnp[(unsigned)R * 16u + (unsigned)h];
            r.vmask = (vL ? 1u : 0u) | (vR ? 2u : 0u) | (vU ? 4u : 0u) | (vD ? 8u : 0u); };
        auto stage = [&](int c, const RwRegs& r) { LAS float* bs = buf + ((c & 1) * 16 + ls) * 384 + 2 * cp; const bool vert = c >= 16;
            float sh[3][2];
#pragma unroll
            for (int a = 0; a < 3; ++a) {
                const unsigned rl = (r.vmask & 1u) ? r.raw[a][1] : 0u, rr_ = (r.vmask & 2u) ? r.raw[a][2] : 0u, ru = (r.vmask & 4u) ? r.raw[a][3] : 0u, rd = (r.vmask & 8u) ? r.raw[a][4] : 0u;
#pragma unroll
                for (int e = 0; e < 2; ++e) { const float pv = e ? bfhi(r.raw[a][0]) : bflo(r.raw[a][0]), l = e ? bfhi(rl) : bflo(rl), rr = e ? bfhi(rr_) : bflo(rr_), up = e ? bfhi(ru) : bflo(ru), dn = e ? bfhi(rd) : bflo(rd);
                    const float c0 = vert ? c0v[a][e] : c0h[a][e];
                    sh[a][e] = c0 * pv + mu_[a][0][e] * l + mu_[a][1][e] * rr + mu_[a][2][e] * up + mu_[a][3][e] * dn; } }
            f32x2 w, kk, bb, kd, rr2, vv;
#pragma unroll
            for (int e = 0; e < 2; ++e) { const float ev = e ? bfhi(r.e) : bflo(r.e), av = e ? bfhi(r.a) : bflo(r.a); const float ksh = sh[1][e];
                const float kkv = ksh * kkc[e] * r.rn;
                w[e] = __expf(-ev); kk[e] = kkv; bb[e] = kkv * av; kd[e] = ksh * (1.f + (av - 1.f) * kac[e]); rr2[e] = sh[0][e]; vv[e] = sh[2][e]; }
            *(LAS f32x2*)(bs + 0) = w; *(LAS f32x2*)(bs + 64) = kk; *(LAS f32x2*)(bs + 128) = bb; *(LAS f32x2*)(bs + 192) = kd; *(LAS f32x2*)(bs + 256) = rr2; *(LAS f32x2*)(bs + 320) = vv; };
        const int q = lane & 7, row = wave * 8 + (lane >> 3);
        f32x2 S[4];
#pragma unroll
        for (int i = 0; i < 4; ++i) S[i] = (f32x2){0.f, 0.f};
        RwRegs regs;
        issue(0, regs); stage(0, regs);
        __syncthreads();
        const int voff = 320 - q * 8 + row; const long ysgn = dir ? -1 : 1;
        for (int c = 0; c < 144; ++c) {
            if (c + 1 < 144) issue(c + 1, regs);
            const LAS float* cb = buf + (c & 1) * (16 * 384) + q * 8;
            if (c < 16) { float y0 = 0.f, y1 = 0.f; rw_chunk<false>(cb, voff, q, S, y0, y1); }
            else { float y0 = 0.f, y1 = 0.f; rw_chunk<true>(cb, voff, q, S, y0, y1);
                const long rb = rowof(c * 16);
                bf16_t* yp = Y + (rb + ysgn * q) * 1024 + h * 64 + row;
                yp[0] = f2bf(y0); yp[ysgn * 8 * 1024] = f2bf(y1); }
            if (c + 1 < 144) stage(c + 1, regs);
            __syncthreads();
        }
    }
}

__device__ __forceinline__ void post_rw(const Params& p, LAS unsigned char* lds, int wave, int lane) {
    const bf16_t* Y0 = (const bf16_t*)((unsigned char*)p.out + DO_Y); const bf16_t* Y1 = Y0 + (size_t)MLAT * 1024;
    const bf16_t* Prw = (const bf16_t*)(p.ws + WS_PRW); const bf16_t* Pzrw = (const bf16_t*)(p.ws + WS_PZRW); const float* bonus = (const float*)(p.ws + WS_BONUS);
    bf16_t* Yo = (bf16_t*)(p.ws + WS_YRW);
    const int gw = blockIdx.x * 8 + wave, NGW = gridDim.x * 8, c0 = lane * 16, head = lane >> 2;
    float gg[16], gb[16]; ldf<16>(p.rw_gn_g + c0, gg); ldf<16>(p.rw_gn_b + c0, gb);
    for (int tok = gw; tok < MLAT; tok += NGW) {
        float a[16], bq[16], z[16], vs[16];
        ldbf<16>(Y0 + (size_t)tok * 1024 + c0, a); ldbf<16>(Y1 + (size_t)tok * 1024 + c0, bq); ldbf<16>(Pzrw + (size_t)tok * 1024 + c0, z);
        const Nbr nb = nbr_of(tok);
        shifted<16>(Prw, tok, nb, 2048 + c0, p.rw_mu, vs);
        float s = 0.f;
#pragma unroll
        for (int i = 0; i < 16; ++i) { a[i] += bq[i]; s += a[i]; }
        s += __shfl_xor(s, 1); s += __shfl_xor(s, 2);
        const float mean = s * (1.f / 64.f); float vr = 0.f;
#pragma unroll
        for (int i = 0; i < 16; ++i) { a[i] -= mean; vr += a[i] * a[i]; }
        vr += __shfl_xor(vr, 1); vr += __shfl_xor(vr, 2);
        const float rstd = rsqrtf(vr * (1.f / 64.f) + 64e-5f), bon = bonus[(size_t)tok * 16 + head];
#pragma unroll
        for (int i = 0; i < 16; ++i) a[i] = (a[i] * rstd * gg[i] + gb[i] + bon * vs[i]) * z[i];
        stbf<16>(Yo + (size_t)tok * 1024 + c0, a);
    }
    LAS float* scr = (LAS float*)(lds + wave * 8448);
    bf16_t* wto1 = (bf16_t*)(p.ws + WS_WTO1); bf16_t* wto2 = (bf16_t*)(p.ws + WS_WTO2); bf16_t* wtg = (bf16_t*)(p.ws + WS_WTG);
    constexpr int I_1 = (1024 / 64) * (D / 32), I_2 = (D / 64) * (D / 32), I_G = (D / 64) * (4096 / 32);
    for (int it = gw; it < 2 * I_1 + I_2 + I_G; it += NGW) {
        if (it < I_1) transpose_item(p.w_hg_out, 1024, D, D, wto1, scr, it, lane);
        else if (it < 2 * I_1) transpose_item(p.w_rw_out, 1024, D, D, wto1 + (size_t)D * 1024, scr, it - I_1, lane);
        else if (it < 2 * I_1 + I_2) transpose_item(p.w_out, D, D, D, wto2, scr, it - 2 * I_1, lane);
        else transpose_item(p.w_in + NC1, D, NCOLS, 4096, wtg, scr, it - 2 * I_1 - I_2, lane);
    }
}

struct OrderOut1 {
    int G, c;
    __device__ bool next(int i, Unit& u) const { const int tile = (i >> 1) * G + c, br = i & 1; if (tile >= 512) return false; const int pm = tile >> 3, pn = tile & 7;
        if (br == 0) { u.pm = pm; u.pn = pn; } else { u.pm = pm + YRW_PM_OFF; u.pn = pn + 8; } return true; }
    __device__ __forceinline__ void a_ready(const Unit&) const {}
    __device__ __forceinline__ void done(const Unit&) const {}
};
struct EpiOut1 {
    static constexpr bool PERM = true, AFTER_DRAIN = false, CHAIN = true;
    unsigned char* ws;
    __device__ __forceinline__ bool chain(f32x4 (&acc)[2][2][4][2], const Unit& u, int wr, int wc, int fr, int fq) const {
        const int br = u.pn >> 3, ct = u.pn & 7, rt = u.pm & 63;
        const bf16_t* G = (const bf16_t*)(ws + WS_PGATE); bf16_t* Mg = (bf16_t*)(ws + WS_MERGED);
        const int row0 = rt * 256 + wr * 64 + fr, col0 = ct * 256 + wc * 32 + 8 * fq;
#pragma unroll
        for (int ai = 0; ai < 2; ++ai)
#pragma unroll
            for (int m = 0; m < 4; ++m) { const size_t row = (size_t)(row0 + ai * 128 + m * 16);
#pragma unroll
                for (int bj = 0; bj < 2; ++bj) { const int col = col0 + bj * 128; float g2[8]; ldbf<8>(G + row * 4096 + 2048 + col, g2);
#pragma unroll
                    for (int i = 0; i < 8; ++i) g2[i] = fmaxf(g2[i], 1e-30f);
                    if (br == 0) { float g1[8]; ldbf<8>(G + row * 4096 + col, g1);
#pragma unroll
                        for (int i = 0; i < 4; ++i) { acc[ai][bj][m][0][i] *= g1[i] * __builtin_amdgcn_rcpf(g2[i]); acc[ai][bj][m][1][i] *= g1[4 + i] * __builtin_amdgcn_rcpf(g2[4 + i]); } }
                    else { float v[8];
#pragma unroll
                        for (int i = 0; i < 4; ++i) { v[i] = acc[ai][bj][m][0][i] * g2[i]; v[4 + i] = acc[ai][bj][m][1][i] * g2[4 + i]; }
                        stbf<8>(Mg + row * 2048 + col, v); } } }
        return br == 0;
    }
};
struct EpiOut2 {
    static constexpr bool PERM = false, AFTER_DRAIN = false, CHAIN = false;
    const float* x; const float* mod; float* out;
    __device__ __forceinline__ void operator()(const f32x4 (&acc)[2][2][4][2], const Unit& u, int wr, int wc, int fr, int fq) const {
        const int row0 = u.pm * 256 + wr * 64 + fr, col0 = u.pn * 256 + wc * 32 + 4 * fq;
#pragma unroll
        for (int ai = 0; ai < 2; ++ai)
#pragma unroll
            for (int m = 0; m < 4; ++m) { const int row = row0 + ai * 128 + m * 16; const float* gate = mod + (row >> 11) * (3 * D) + 2 * D;
#pragma unroll
                for (int bj = 0; bj < 2; ++bj)
#pragma unroll
                    for (int n = 0; n < 2; ++n) { const int col = col0 + bj * 128 + n * 16; const f32x4 xv = *(const f32x4*)(x + (size_t)row * D + col), gv = *(const f32x4*)(gate + col);
                        *(f32x4*)(out + (size_t)row * D + col) = xv + gv * acc[ai][bj][m][n]; } }
    }
};
__device__ __forceinline__ void final_norm(const Params& p, int wave, int lane) {
    const int gw = blockIdx.x * 8 + wave, NGW = gridDim.x * 8;
    for (int row = gw; row < MLAT; row += NGW) {
        f32x4* xr = (f32x4*)(p.out + (size_t)row * D);
        f32x4 v[8]; float ss = 0.f;
#pragma unroll
        for (int j = 0; j < 8; ++j) { v[j] = xr[lane + 64 * j]; ss += (v[j].x * v[j].x + v[j].y * v[j].y) + (v[j].z * v[j].z + v[j].w * v[j].w); }
        ss = wave_sum(ss);
        const float rstd = rsqrtf(ss * (1.f / D) + 1e-6f);
#pragma unroll
        for (int j = 0; j < 8; ++j) { const f32x4 g = *(const f32x4*)(p.final_g + 4 * (lane + 64 * j)); xr[lane + 64 * j] = v[j] * rstd * g; }
    }
}


__device__ __forceinline__ void rw_scan4(const Params& p, LAS unsigned char* lds, int tid, int wave, int lane) {
    LAS float* buf = (LAS float*)lds;
    const bf16_t* Prw = (const bf16_t*)(p.ws + WS_PRW); const float* rnp = (const float*)(p.ws + WS_RN);
    bf16_t* Ybase = (bf16_t*)((unsigned char*)p.out + DO_Y);
    for (int u = blockIdx.x; u < 256; u += gridDim.x) {
        const int b = u >> 5, h = (u >> 1) & 15, dir = u & 1;
        const bf16_t* Ed = (const bf16_t*)(p.ws + (dir ? WS_E1 : WS_E0)); const bf16_t* Ad = (const bf16_t*)(p.ws + (dir ? WS_A1 : WS_A0));
        bf16_t* Y = Ybase + (size_t)dir * MLAT * 1024;
        const int ls0 = tid >> 5, cp = tid & 31, ch = h * 64 + 2 * cp;
        float mu_[3][4][2];
#pragma unroll
        for (int a = 0; a < 3; ++a)
#pragma unroll
            for (int m = 0; m < 4; ++m) { const f32x2 t = *(const f32x2*)(p.rw_mu + m * SHC + a * 1024 + ch); mu_[a][m][0] = t.x; mu_[a][m][1] = t.y; }
        const f32x2 kkc = *(const f32x2*)(p.rw_kk + ch), kac = *(const f32x2*)(p.rw_ka + ch);
        auto rowof = [&](int tau) -> int { if (tau < CTXL) { const int t = dir ? (CTXL - 1 - tau) : tau; return MLAT + b * CTXL + t; } const int t0 = tau - CTXL; const int t = dir ? (SEQ - 1 - t0) : t0; return b * SEQ + t; };
        auto issue = [&](int c, int ls, RwRegs& r) { const int R = rowof(c * 16 + ls); const Nbr nb = nbr_of(R);
#pragma unroll
            for (int a = 0; a < 3; ++a) { const bf16_t* base = Prw + a * 1024 + ch;
                r.raw[a][0] = *(const unsigned*)(base + (size_t)R * SHC);
                r.raw[a][1] = nb.L >= 0 ? *(const unsigned*)(base + (size_t)nb.L * SHC) : 0u;
                r.raw[a][2] = nb.R >= 0 ? *(const unsigned*)(base + (size_t)nb.R * SHC) : 0u;
                r.raw[a][3] = nb.U >= 0 ? *(const unsigned*)(base + (size_t)nb.U * SHC) : 0u;
                r.raw[a][4] = nb.Dn >= 0 ? *(const unsigned*)(base + (size_t)nb.Dn * SHC) : 0u; }
            r.e = *(const unsigned*)(Ed + (size_t)R * 1024 + ch); r.a = *(const unsigned*)(Ad + (size_t)R * 1024 + ch); r.rn = rnp[(size_t)R * 16 + h]; };
        auto stage = [&](int c, int ls, const RwRegs& r) { LAS float* bs = buf + ((c & 1) * 16 + ls) * 384 + 2 * cp; const bool vert = c >= 16;
            float sh[3][2];
#pragma unroll
            for (int a = 0; a < 3; ++a)
#pragma unroll
                for (int e = 0; e < 2; ++e) { const float pv = e ? bfhi(r.raw[a][0]) : bflo(r.raw[a][0]), l = e ? bfhi(r.raw[a][1]) : bflo(r.raw[a][1]), rr = e ? bfhi(r.raw[a][2]) : bflo(r.raw[a][2]),
                                                  up = e ? bfhi(r.raw[a][3]) : bflo(r.raw[a][3]), dn = e ? bfhi(r.raw[a][4]) : bflo(r.raw[a][4]);
                    float o = pv + mu_[a][0][e] * (l - pv) + mu_[a][1][e] * (rr - pv);
                    if (vert) o += mu_[a][2][e] * (up - pv) + mu_[a][3][e] * (dn - pv);
                    sh[a][e] = o; }
            f32x2 w, kk, bb, kd, rr2, vv;
#pragma unroll
            for (int e = 0; e < 2; ++e) { const float ev = e ? bfhi(r.e) : bflo(r.e), av = e ? bfhi(r.a) : bflo(r.a); const float ksh = sh[1][e];
                const float kkv = ksh * kkc[e] * r.rn;
                w[e] = __expf(-ev); kk[e] = kkv; bb[e] = kkv * av; kd[e] = ksh * (1.f + (av - 1.f) * kac[e]); rr2[e] = sh[0][e]; vv[e] = sh[2][e]; }
            *(LAS f32x2*)(bs + 0) = w; *(LAS f32x2*)(bs + 64) = kk; *(LAS f32x2*)(bs + 128) = bb; *(LAS f32x2*)(bs + 192) = kd; *(LAS f32x2*)(bs + 256) = rr2; *(LAS f32x2*)(bs + 320) = vv; };
        const int rg = lane >> 4, q = lane & 15, row0 = wave * 16 + rg * 4; const bool b0 = (q & 1) != 0, b1 = (q & 2) != 0;
        const int myrow = row0 + ((q & 1) << 1) + ((q >> 1) & 1);
        float S[4][4];
#pragma unroll
        for (int i = 0; i < 4; ++i)
#pragma unroll
            for (int j = 0; j < 4; ++j) S[i][j] = 0.f;
        RwRegs ra, rb;
        issue(0, ls0, ra); issue(0, ls0 + 8, rb); stage(0, ls0, ra); stage(0, ls0 + 8, rb);
        __syncthreads();
        for (int c = 0; c < 144; ++c) {
            if (c + 1 < 144) { issue(c + 1, ls0, ra); issue(c + 1, ls0 + 8, rb); }
            const bool lat = c >= 16;
#pragma unroll 2
            for (int s = 0; s < 16; ++s) {
                const LAS float* bs = buf + ((c & 1) * 16 + s) * 384;
                const f32x4 w4 = *(const LAS f32x4*)(bs + q * 4), kk4 = *(const LAS f32x4*)(bs + 64 + q * 4), b4 = *(const LAS f32x4*)(bs + 128 + q * 4), kd4 = *(const LAS f32x4*)(bs + 192 + q * 4), r4 = *(const LAS f32x4*)(bs + 256 + q * 4);
                const f32x4 v4 = *(const LAS f32x4*)(bs + 320 + row0);
                float pp[4];
#pragma unroll
                for (int i = 0; i < 4; ++i) pp[i] = (S[i][0] * kk4[0] + S[i][1] * kk4[1]) + (S[i][2] * kk4[2] + S[i][3] * kk4[3]);
                float ta = (b0 ? pp[2] : pp[0]) + dpp<0xB1>(b0 ? pp[0] : pp[2]);
                float tb = (b0 ? pp[3] : pp[1]) + dpp<0xB1>(b0 ? pp[1] : pp[3]);
                float t = (b1 ? tb : ta) + dpp<0x4E>(b1 ? ta : tb);
                t += dpp<0x124>(t); t += dpp<0x128>(t);
                float sa[4]; sa[0] = dpp<0x00>(t); sa[1] = dpp<0xAA>(t); sa[2] = dpp<0x55>(t); sa[3] = dpp<0xFF>(t);
#pragma unroll
                for (int i = 0; i < 4; ++i)
#pragma unroll
                    for (int j = 0; j < 4; ++j) S[i][j] = S[i][j] * w4[j] + (v4[i] * kd4[j] - sa[i] * b4[j]);
                if (lat) {
#pragma unroll
                    for (int i = 0; i < 4; ++i) pp[i] = (S[i][0] * r4[0] + S[i][1] * r4[1]) + (S[i][2] * r4[2] + S[i][3] * r4[3]);
                    float ya = (b0 ? pp[2] : pp[0]) + dpp<0xB1>(b0 ? pp[0] : pp[2]);
                    float yb = (b0 ? pp[3] : pp[1]) + dpp<0xB1>(b0 ? pp[1] : pp[3]);
                    float y = (b1 ? yb : ya) + dpp<0x4E>(b1 ? ya : yb);
                    y += dpp<0x124>(y); y += dpp<0x128>(y);
                    if (q < 4) Y[(size_t)rowof(c * 16 + s) * 1024 + h * 64 + myrow] = f2bf(y);
                }
            }
            if (c + 1 < 144) { stage(c + 1, ls0, ra); stage(c + 1, ls0 + 8, rb); }
            __syncthreads();
        }
    }
}

__device__ __forceinline__ void hg_scan4(const Params& p, LAS unsigned char* lds, int tid, int wave, int lane) {
    LAS bf16_t* qd = (LAS bf16_t*)(lds);
    LAS bf16_t* kd = (LAS bf16_t*)(lds + 17408);
    LAS bf16_t* kdT = (LAS bf16_t*)(lds + 34816);
    LAS bf16_t* vT = (LAS bf16_t*)(lds + 53248);
    LAS bf16_t* ST = (LAS bf16_t*)(lds + 62464);
    LAS bf16_t* at = (LAS bf16_t*)(lds + 79872);
    LAS float* tot = (LAS float*)(lds + 89088);
    const bf16_t* Pq = (const bf16_t*)(p.ws + WS_PQ); const bf16_t* Pi = (const bf16_t*)(p.ws + WS_PI);
    bf16_t* Obase = (bf16_t*)((unsigned char*)p.out + DO_O);
    const int l15 = lane & 15, fq = lane >> 4;
    for (int u = blockIdx.x; u < 256; u += gridDim.x) {
        const int b = u >> 5, h = (u >> 2) & 7, dir = (u >> 1) & 1, vh = u & 1;
        const bf16_t* Pg = (const bf16_t*)(p.ws + (dir ? WS_PGB : WS_PGF));
        bf16_t* O = Obase + (size_t)dir * MLAT * 1024;
        const int k0 = 2 * lane, qtr = wave, vs = tid >> 2, vq = tid & 3;
        const int sgn = dir ? -1 : 1;
        auto rbase = [&](int c) -> int { if (c < 4) return MLAT + b * CTXL + (dir ? (CTXL - 1 - c * 64) : c * 64); const int t0 = (c - 4) * 64; return b * SEQ + (dir ? (SEQ - 1 - t0) : t0); };
        const long rstep = (long)sgn * 1024;
        f32x4 S[2][4];
#pragma unroll
        for (int a = 0; a < 2; ++a)
#pragma unroll
            for (int i = 0; i < 4; ++i) S[a][i] = (f32x4){0.f, 0.f, 0.f, 0.f};
        unsigned gN[16], qN[16]; u32x4 vN[2];
#pragma unroll
        for (int j = 0; j < 16; ++j) { const long o = ((long)rbase(0) + sgn * (qtr * 16)) * 1024 + h * 128 + k0 + j * rstep; gN[j] = *(const unsigned*)(Pg + o); qN[j] = *(const unsigned*)(Pq + o); }
#pragma unroll
        for (int i = 0; i < 2; ++i) vN[i] = *(const u32x4*)(Pi + ((long)rbase(0) + sgn * vs) * 1024 + h * 128 + vh * 64 + vq * 16 + i * 8);
        __syncthreads();
        for (int c = 0; c < 36; ++c) {
            unsigned g[16], q[16]; const u32x4 vC0 = vN[0], vC1 = vN[1];
#pragma unroll
            for (int j = 0; j < 16; ++j) { g[j] = gN[j]; q[j] = qN[j]; }
            if (c + 1 < 36) {
                const long rb1 = rbase(c + 1);
                const bf16_t* gp = Pg + (rb1 + sgn * (qtr * 16)) * 1024 + h * 128 + k0; const bf16_t* qp_ = Pq + (rb1 + sgn * (qtr * 16)) * 1024 + h * 128 + k0;
#pragma unroll
                for (int j = 0; j < 16; ++j) { gN[j] = *(const unsigned*)(gp + j * rstep); qN[j] = *(const unsigned*)(qp_ + j * rstep); }
#pragma unroll
                for (int i = 0; i < 2; ++i) vN[i] = *(const u32x4*)(Pi + (rb1 + sgn * vs) * 1024 + h * 128 + vh * 64 + vq * 16 + i * 8);
            }
            float run0 = 0.f, run1 = 0.f;
#pragma unroll
            for (int j = 0; j < 16; ++j) { run0 += bflo(g[j]); run1 += bfhi(g[j]); }
            *(LAS f32x2*)(tot + qtr * 128 + k0) = (f32x2){run0, run1};
            __syncthreads();
            {
                const f32x2 t0 = *(const LAS f32x2*)(tot + k0), t1 = *(const LAS f32x2*)(tot + 128 + k0), t2 = *(const LAS f32x2*)(tot + 256 + k0);
                const float mid0 = t0.x + t1.x, mid1 = t0.y + t1.y;
                const float off0 = qtr == 0 ? 0.f : (qtr == 1 ? t0.x : (qtr == 2 ? mid0 : mid0 + t2.x));
                const float off1 = qtr == 0 ? 0.f : (qtr == 1 ? t0.y : (qtr == 2 ? mid1 : mid1 + t2.y));
                unsigned kp0[8], kp1[8]; float bc0 = off0, bc1 = off1;
#pragma unroll
                for (int j = 0; j < 16; j += 2) {
                    float kv0[2], kv1[2];
#pragma unroll
                    for (int e = 0; e < 2; ++e) { const int jj = j + e;
                        bc0 += bflo(g[jj]); bc1 += bfhi(g[jj]);
                        const float qv0 = bflo(q[jj]) * __expf(fminf(bc0 - mid0, 80.f)), qv1 = bfhi(q[jj]) * __expf(fminf(bc1 - mid1, 80.f));
                        kv0[e] = (1.f - __expf(bflo(g[jj]))) * __expf(fminf(mid0 - bc0, 80.f)); kv1[e] = (1.f - __expf(bfhi(g[jj]))) * __expf(fminf(mid1 - bc1, 80.f));
                        const int t = qtr * 16 + jj;
                        *(LAS unsigned*)(qd + t * 136 + k0) = cvt_pk_bf16(qv0, qv1); *(LAS unsigned*)(kd + t * 136 + k0) = cvt_pk_bf16(kv0[e], kv1[e]); }
                    kp0[j >> 1] = cvt_pk_bf16(kv0[0], kv0[1]); kp1[j >> 1] = cvt_pk_bf16(kv1[0], kv1[1]);
                }
                *(LAS u32x4*)(kdT + k0 * 72 + qtr * 16) = (u32x4){kp0[0], kp0[1], kp0[2], kp0[3]};
                *(LAS u32x4*)(kdT + k0 * 72 + qtr * 16 + 8) = (u32x4){kp0[4], kp0[5], kp0[6], kp0[7]};
                *(LAS u32x4*)(kdT + (k0 + 1) * 72 + qtr * 16) = (u32x4){kp1[0], kp1[1], kp1[2], kp1[3]};
                *(LAS u32x4*)(kdT + (k0 + 1) * 72 + qtr * 16 + 8) = (u32x4){kp1[4], kp1[5], kp1[6], kp1[7]};
#pragma unroll
                for (int kt = 0; kt < 2; ++kt) { const int kb = 32 * wave + 16 * kt + fq * 4;
                    float em[4];
#pragma unroll
                    for (int j = 0; j < 4; ++j) em[j] = __expf(tot[kb + j] + tot[128 + kb + j]);
#pragma unroll
                    for (int nt = 0; nt < 4; ++nt) { u32x2 w; w.x = cvt_pk_bf16(S[kt][nt][0] * em[0], S[kt][nt][1] * em[1]); w.y = cvt_pk_bf16(S[kt][nt][2] * em[2], S[kt][nt][3] * em[3]);
                        *(LAS u32x2*)(ST + (nt * 16 + l15) * 136 + kb) = w; } }
                const unsigned vw[8] = {vC0.x, vC0.y, vC0.z, vC0.w, vC1.x, vC1.y, vC1.z, vC1.w};
#pragma unroll
                for (int i = 0; i < 8; ++i) { vT[(vq * 16 + 2 * i) * 72 + vs] = (bf16_t)(vw[i] & 0xffffu); vT[(vq * 16 + 2 * i + 1) * 72 + vs] = (bf16_t)(vw[i] >> 16); }
            }
            __syncthreads();
            const bool lat = c >= 4;
            if (lat) {
                const int tt = wave;
#pragma unroll
                for (int st = 0; st < 4; ++st) {
                    f32x4 a = (f32x4){0.f, 0.f, 0.f, 0.f};
                    if (st <= tt) {
#pragma unroll
                        for (int ks = 0; ks < 4; ++ks) { const bf16x8 A = *(const LAS bf16x8*)(qd + (tt * 16 + l15) * 136 + ks * 32 + fq * 8); const bf16x8 B = *(const LAS bf16x8*)(kd + (st * 16 + l15) * 136 + ks * 32 + fq * 8); a = mfma16(A, B, a); } }
#pragma unroll
                    for (int j = 0; j < 4; ++j) { const int t = tt * 16 + fq * 4 + j, s = st * 16 + l15; at[t * 72 + s] = f2bf(s <= t ? a[j] : 0.f); } }
            }
            __syncthreads();
            if (lat) {
                const int tt = wave;
#pragma unroll
                for (int nt = 0; nt < 4; ++nt) {
                    f32x4 o = (f32x4){0.f, 0.f, 0.f, 0.f};
#pragma unroll
                    for (int ks = 0; ks < 2; ++ks) { const bf16x8 A = *(const LAS bf16x8*)(at + (tt * 16 + l15) * 72 + ks * 32 + fq * 8); const bf16x8 B = *(const LAS bf16x8*)(vT + (nt * 16 + l15) * 72 + ks * 32 + fq * 8); o = mfma16(A, B, o); }
#pragma unroll
                    for (int ks = 0; ks < 4; ++ks) { const bf16x8 A = *(const LAS bf16x8*)(qd + (tt * 16 + l15) * 136 + ks * 32 + fq * 8); const bf16x8 B = *(const LAS bf16x8*)(ST + (nt * 16 + l15) * 136 + ks * 32 + fq * 8); o = mfma16(A, B, o); }
#pragma unroll
                    for (int j = 0; j < 4; ++j) { const long row = (long)rbase(c) + sgn * (tt * 16 + fq * 4 + j); O[row * 1024 + h * 128 + vh * 64 + nt * 16 + l15] = f2bf(o[j]); } }
            }
#pragma unroll
            for (int kt = 0; kt < 2; ++kt) { const int kb = 32 * wave + 16 * kt;
                float eb[4], e2[4];
#pragma unroll
                for (int j = 0; j < 4; ++j) { const int kj = kb + fq * 4 + j; const float m = tot[kj] + tot[128 + kj], bl = m + tot[256 + kj] + tot[384 + kj]; eb[j] = __expf(bl); e2[j] = __expf(bl - m); }
#pragma unroll
                for (int nt = 0; nt < 4; ++nt) { f32x4 tmp = (f32x4){0.f, 0.f, 0.f, 0.f};
#pragma unroll
                    for (int ks = 0; ks < 2; ++ks) { const bf16x8 A = *(const LAS bf16x8*)(kdT + (kb + l15) * 72 + ks * 32 + fq * 8); const bf16x8 B = *(const LAS bf16x8*)(vT + (nt * 16 + l15) * 72 + ks * 32 + fq * 8); tmp = mfma16(A, B, tmp); }
#pragma unroll
                    for (int j = 0; j < 4; ++j) S[kt][nt][j] = eb[j] * S[kt][nt][j] + e2[j] * tmp[j]; } }
            __syncthreads();
        }
    }
}

#define XB_TMO      128
#define XB_XCNT(j)  (256  + 64 * (j))
#define XB_XSUB(j)  (1280 + 64 * (j))
#define XB_XGEN(j)  (2304 + 64 * (j))
#define XB_TOP      3328
#define XB_TOPGEN   3392
#define XCD_BAR_WORDS 3456
#define XB_SPIN_CAP (1u << 18)

__device__ __forceinline__ unsigned xb_ld(unsigned* p)              { return __hip_atomic_load(p, __ATOMIC_RELAXED, __HIP_MEMORY_SCOPE_AGENT); }
__device__ __forceinline__ unsigned xb_add(unsigned* p, unsigned v) { return __hip_atomic_fetch_add(p, v, __ATOMIC_RELAXED, __HIP_MEMORY_SCOPE_AGENT); }
__device__ __forceinline__ unsigned xb_xcc_id() { return (unsigned)__builtin_amdgcn_s_getreg((3 << 11) | 20) & 0xFu; }
#define XB_SPIN(cond, bar) do { unsigned _sp = 0; while (cond) { __builtin_amdgcn_s_sleep(1); \
    if ((++_sp & 255u) == 0u) { if (xb_ld(&(bar)[XB_TMO])) break; if (_sp > XB_SPIN_CAP) { atomicAdd(&(bar)[XB_TMO], 1u); break; } } } } while (0)

struct XcdBarrier {
    unsigned* bar; unsigned x;
    volatile LAS unsigned* st;
};

__device__ __forceinline__ XcdBarrier xcd_barrier_post(unsigned* bar, volatile LAS unsigned* st) {
    XcdBarrier b; b.bar = bar; b.x = xb_xcc_id(); b.st = st;
    if (threadIdx.x == 0) (void)xb_add(&bar[XB_XCNT(b.x)], 1u);
    return b;
}
__device__ __forceinline__ void xcd_barrier_complete(unsigned* bar, unsigned x, unsigned& nloc, unsigned& nx) {
    const unsigned G = gridDim.x * gridDim.y * gridDim.z;
    unsigned sum, cnt, mine, sp = 0u;
    for (;;) {
        sum = 0u; cnt = 0u; mine = 0u;
#pragma unroll
        for (unsigned j = 0; j < 16; ++j) { const unsigned c = xb_ld(&bar[XB_XCNT(j)]); sum += c; cnt += (c > 0u) ? 1u : 0u; mine = (j == x) ? c : mine; }
        if (sum == G) break;
        __builtin_amdgcn_s_sleep(1);
        if ((++sp & 255u) == 0u) { if (xb_ld(&bar[XB_TMO])) break; if (sp > XB_SPIN_CAP) { atomicAdd(&bar[XB_TMO], 1u); break; } }
    }
    nloc = mine > 0u ? mine : 1u; nx = cnt > 0u ? cnt : 1u;
}

__device__ __forceinline__ void xcd_barrier(const XcdBarrier& b) {
    asm volatile("s_waitcnt vmcnt(0)" ::: "memory");
    __syncthreads();
    if (threadIdx.x == 0) {
        unsigned* bar = b.bar;
        __builtin_amdgcn_s_waitcnt(0);
        unsigned nloc = b.st[0], nx = b.st[1];
        if (nloc == 0u) { xcd_barrier_complete(bar, b.x, nloc, nx); b.st[0] = nloc; b.st[1] = nx; }
        const unsigned old = xb_add(&bar[XB_XSUB(b.x)], 1u);
        const unsigned gen = old / nloc;
        if (old + 1u == (gen + 1u) * nloc) {
            __builtin_amdgcn_fence(__ATOMIC_RELEASE, "agent");
            asm volatile("s_waitcnt vmcnt(0)" ::: "memory");
            const unsigned og = xb_add(&bar[XB_TOP], 1u);
            const unsigned tg = og / nx;
            if (og + 1u == (tg + 1u) * nx) xb_add(&bar[XB_TOPGEN], 1u);
            else XB_SPIN(xb_ld(&bar[XB_TOPGEN]) == tg, bar);
            __builtin_amdgcn_fence(__ATOMIC_ACQUIRE, "agent");
            xb_add(&bar[XB_XGEN(b.x)], 1u);
            asm volatile("s_waitcnt vmcnt(0)" ::: "memory");
        } else {
            XB_SPIN(xb_ld(&bar[XB_XGEN(b.x)]) == gen, bar);
            __builtin_amdgcn_fence(__ATOMIC_ACQUIRE, "agent");
            asm volatile("s_waitcnt vmcnt(0)" ::: "memory");
        }
    }
    __syncthreads();
}


#ifndef GA
#define GA true
#endif
#ifndef GS
#define GS true
#endif
#ifndef COMBINED
#define COMBINED 0
#endif

__global__ void __launch_bounds__(512, 2) mega(Params p) {
    extern __shared__ __attribute__((aligned(16))) unsigned char shm[];
    LAS unsigned char* lds = (LAS unsigned char*)shm;
    cg::grid_group grid = cg::this_grid();
    const int tid = threadIdx.x, wave = __builtin_amdgcn_readfirstlane(tid >> 6), lane = tid & 63;
    volatile LAS unsigned* xst = (volatile LAS unsigned*)(lds + 131072);
    if (tid == 0) { xst[0] = 0u; xst[1] = 0u; }
    __syncthreads();
    const XcdBarrier xb = xcd_barrier_post((unsigned*)(p.ws + WS_BAR), xst);
    phase0(p, lds, tid, wave, lane);
    if (p.ws == nullptr) grid.sync();
    xcd_barrier(xb);
    phase1(p, (bf16_t*)((unsigned char*)p.out + DO_H), MTOT, wave, lane);
    xcd_barrier(xb);
    { pg8::Gemm g{(const bf16_t*)((unsigned char*)p.out + DO_H), (const bf16_t*)((unsigned char*)p.out + DO_WTIN), MTOT, NC1, D};
      InOrder S{(int)gridDim.x, (int)blockIdx.x}; EpiProj E{p.ws};
      pg8::gemm_phase<EpiProj, InOrder, GA, GS>(lds, g, S, E); }
    xcd_barrier(xb);
    rw_prep(p, lds, wave, lane);
    xcd_barrier(xb);
#if COMBINED
    if (wave < 4) rw_scan4(p, lds, tid, wave, lane);
    else hg_scan4(p, lds + RW_LDS, tid - 256, wave - 4, lane);
#else
    hg_scan(p, lds, tid, wave, lane);
    rw_scan(p, lds, tid, wave, lane);
#endif
    xcd_barrier(xb);
    post_hg(p, wave, lane);
    post_rw(p, lds, wave, lane);
    phase1(p, (bf16_t*)(p.ws + WS_H2), MLAT, wave, lane);
    xcd_barrier(xb);
    { pg8::Gemm g{(const bf16_t*)(p.ws + WS_H2), (const bf16_t*)(p.ws + WS_WTG), MLAT, 4096, D};
      OrderPN S{(int)gridDim.x, (int)blockIdx.x, 16, 64 * 16}; EpiGate E{p.ws};
      pg8::gemm_phase<EpiGate, OrderPN, GA, GS>(lds, g, S, E); }
    xcd_barrier(xb);
    { pg8::Gemm g{(const bf16_t*)(p.ws + WS_YHG), (const bf16_t*)(p.ws + WS_WTO1), 0, 0, 1024};
      OrderOut1 S{(int)gridDim.x, (int)blockIdx.x}; EpiOut1 E{p.ws};
      pg8::gemm_phase<EpiOut1, OrderOut1, GA, GS>(lds, g, S, E); }
    xcd_barrier(xb);
    { pg8::Gemm g{(const bf16_t*)(p.ws + WS_MERGED), (const bf16_t*)(p.ws + WS_WTO2), MLAT, D, D};
      OrderPN S{(int)gridDim.x, (int)blockIdx.x, 8, 64 * 8}; EpiOut2 E{p.x, (const float*)(p.ws + WS_MOD), p.out};
      pg8::gemm_phase<EpiOut2, OrderPN, GA, GS>(lds, g, S, E); }
    xcd_barrier(xb);
    final_norm(p, wave, lane);
}
}

extern "C" void kernel_launch(void* const* d_in, const int* in_sizes, int n_in, void* d_out, int out_size, void* d_ws, size_t ws_size, hipStream_t stream) {
    static int grid = 0;
    if (grid == 0) {
        if (n_in != 24 || ws_size < mk::WS_END) { fprintf(stderr, "kernel_launch: unexpected inputs (n_in %d, ws %zu)\n", n_in, ws_size); grid = -1; return; }
        int dev = 0, cus = 0, per_cu = 0;
        (void)hipGetDevice(&dev); (void)hipDeviceGetAttribute(&cus, hipDeviceAttributeMultiprocessorCount, dev);
        if (hipFuncSetAttribute((const void*)mk::mega, hipFuncAttributeMaxDynamicSharedMemorySize, mk::LDS_BYTES) != hipSuccess) { fprintf(stderr, "kernel_launch: hipFuncSetAttribute failed\n"); }
        if (hipOccupancyMaxActiveBlocksPerMultiprocessor(&per_cu, (const void*)mk::mega, 512, mk::LDS_BYTES) != hipSuccess || per_cu < 1) per_cu = 1;
        (void)hipGetLastError();
        grid = cus * (per_cu > 1 ? 1 : per_cu);
        if (grid <= 0) grid = 256;
    }
    if (grid < 0) return;
    mk::Params p{};
    const float** f = (const float**)&p;
    for (int i = 0; i < 24; ++i) f[i] = (const float*)d_in[i];
    p.out = (float*)d_out; p.ws = (unsigned char*)d_ws;
    (void)hipMemsetAsync((unsigned char*)d_ws + mk::WS_BAR, 0, XCD_BAR_WORDS * sizeof(unsigned), stream);
    void* args[] = {&p};
    hipError_t e = hipLaunchCooperativeKernel((const void*)mk::mega, dim3(grid), dim3(512), args, mk::LDS_BYTES, stream);
    if (e != hipSuccess) fprintf(stderr, "cooperative launch failed: %s (grid %d)\n", hipGetErrorString(e), grid);
}
```
